# Optimizing an MI355X kernel written in HIP

```python
import math
import jax, jax.numpy as jnp
from jax import lax
import numpy as np

D_MODEL = 1024
BATCH = 16
SEQ = 256
DEPTH = 4
DEC_BATCH = 2
DEC_SEQ = 1024
PAST_LEN = 256

GRID_W = 64
MIX_W = D_MODEL
RET_HEADS = 4
RET_DH = 96
RET_W = RET_HEADS * RET_DH
HY_W = 256
HY_ORDER = 2
ML_HEADS = 4
ML_DH = 96
ML_W = ML_HEADS * ML_DH
IN_W = 4 * RET_W + 3 * HY_W + 4 * ML_W + 2 * 2 * ML_HEADS
SPLIT_POINTS = (4 * RET_W, 4 * RET_W + 3 * HY_W, 4 * RET_W + 3 * HY_W + 4 * ML_W)
D_FF = 4 * D_MODEL
CHUNK = 128
N_BANDS = 16
FEAT_W = 1 + 2 * N_BANDS
FILT_W = 64
HY_SHIFT = 0.05
HY_TARGET = 1e-2
HY_SHORT_DECAY_PCT = 0.3
HY_LONG_DECAY_PCT = 1.5
ROPE_BASE = 10000.0
EPS = 1e-6

kernel_name = "hybrid_diffusion_trunk_step"


def rmsnorm(x, g):
    xf = x.astype(jnp.float32)
    return xf * lax.rsqrt(jnp.mean(xf * xf, axis=-1, keepdims=True) + EPS) * g


def head_norm(x, g):
    xn = x * lax.rsqrt(jnp.mean(x * x, axis=-1, keepdims=True) + EPS)
    return xn.reshape(x.shape[:2] + (-1,)) * g


def dwconv3(x, w, b):
    xpad = jnp.pad(x, ((0, 0), (1, 1), (0, 0)))
    return xpad[:, :-2] * w[0] + xpad[:, 1:-1] * w[1] + xpad[:, 2:] * w[2] + b


def rope_2d(x):
    L, dh = x.shape[1], x.shape[-1]
    rows = L // GRID_W
    row = jnp.repeat(jnp.arange(rows, dtype=jnp.float32), GRID_W)
    col = jnp.tile(jnp.arange(GRID_W, dtype=jnp.float32), rows)
    half = dh // 2
    n_freq = half // 2
    freqs = ROPE_BASE ** (-jnp.arange(n_freq, dtype=jnp.float32) / n_freq)
    ang = jnp.concatenate([row[:, None] * freqs, col[:, None] * freqs], axis=-1)
    cos = jnp.cos(ang)[None, :, None, :]
    sin = jnp.sin(ang)[None, :, None, :]
    x1, x2 = x[..., :half], x[..., half:]
    return jnp.concatenate([x1 * cos - x2 * sin, x2 * cos + x1 * sin], axis=-1)


def _chunks(x):
    B, L, H = x.shape[:3]
    xr = x.reshape((B, L // CHUNK, CHUNK, H) + x.shape[3:])
    return jnp.moveaxis(xr, (1, 3), (0, 2))


def _unchunks(y):
    yr = jnp.moveaxis(y, (0, 2), (1, 3))
    n, c = yr.shape[1], yr.shape[2]
    return yr.reshape((yr.shape[0], n * c) + yr.shape[3:])


def retention_chunked(q, k, v, log_gamma, s0):
    idx = jnp.arange(CHUNK, dtype=jnp.float32)
    rel = idx[:, None] - idx[None, :]
    causal = rel >= 0
    decay_mask = jnp.where(causal[None], jnp.exp(jnp.maximum(rel, 0.0)[None] * log_gamma[:, None, None]), 0.0)
    q_decay = jnp.exp((idx + 1.0)[None, :] * log_gamma[:, None])
    k_decay = jnp.exp((CHUNK - 1.0 - idx)[None, :] * log_gamma[:, None])
    chunk_decay = jnp.exp(CHUNK * log_gamma)

    def step(s, inp):
        qb, kb, vb = inp
        scores = jnp.einsum('bhid,bhjd->bhij', qb, kb) * decay_mask
        intra = jnp.einsum('bhij,bhjd->bhid', scores, vb)
        inter = jnp.einsum('bhid,bhde->bhie', qb, s) * q_decay[None, :, :, None]
        s_new = s * chunk_decay[None, :, None, None] + jnp.einsum('bhjd,bhje->bhde', kb * k_decay[None, :, :, None], vb)
        return s_new, intra + inter

    s_fin, out = lax.scan(step, s0, (_chunks(q), _chunks(k), _chunks(v)))
    return _unchunks(out), s_fin


def mlstm_chunked(q, k, v, i_pre, log_f, c0, n0, m0):
    idx = jnp.arange(CHUNK)
    causal = idx[:, None] >= idx[None, :]

    def step(carry, inp):
        c, nv, m = carry
        qb, kb, vb, ib, fb = inp
        b = jnp.cumsum(fb, axis=-1)
        d_log = jnp.where(causal, b[..., :, None] - b[..., None, :] + ib[..., None, :], -jnp.inf)
        a = b + m[..., None]
        m_t = jnp.maximum(a, jnp.max(d_log, axis=-1))
        w_intra = jnp.exp(d_log - m_t[..., None])
        w_inter = jnp.exp(a - m_t)
        s = jnp.einsum('bhid,bhjd->bhij', qb, kb) * w_intra
        num = jnp.einsum('bhij,bhjd->bhid', s, vb) + w_inter[..., None] * jnp.einsum('bhid,bhde->bhie', qb, c)
        den = jnp.sum(s, axis=-1) + w_inter * jnp.einsum('bhid,bhd->bhi', qb, nv)
        h = num / jnp.maximum(jnp.abs(den), jnp.exp(-m_t))[..., None]
        b_last = b[..., -1]
        g_log = b_last[..., None] - b + ib
        m_new = jnp.maximum(b_last + m, jnp.max(g_log, axis=-1))
        w_prev = jnp.exp(b_last + m - m_new)
        kw = kb * jnp.exp(g_log - m_new[..., None])[..., None]
        c_new = w_prev[..., None, None] * c + jnp.einsum('bhjd,bhje->bhde', kw, vb)
        n_new = w_prev[..., None] * nv + jnp.sum(kw, axis=-2)
        return (c_new, n_new, m_new), h

    fin, out = lax.scan(step, (c0, n0, m0), (_chunks(q), _chunks(k), _chunks(v), _chunks(i_pre), _chunks(log_f)))
    return _unchunks(out), fin


def hyena_filter_spectra(L, lp):
    tn = jnp.arange(L, dtype=jnp.float32) / L
    bands = jnp.linspace(1e-4, N_BANDS - 1, N_BANDS, dtype=jnp.float32)
    ang = 2.0 * math.pi * tn[:, None] * bands[None, :]
    feat = jnp.concatenate([tn[:, None], jnp.cos(ang), jnp.sin(ang)], axis=-1)
    fr = lp['hy_sin_freq']
    hdn = jnp.sin(fr * (feat @ lp['hy_f_w1'] + lp['hy_f_b1']))
    hdn = jnp.sin(fr * (hdn @ lp['hy_f_w2'] + lp['hy_f_b2']))
    filt = (hdn @ lp['hy_f_w3'] + lp['hy_f_b3']).astype(jnp.float32).reshape(L, 2, HY_ORDER, HY_W)
    deltas = jnp.abs(jnp.linspace(math.log(HY_TARGET) / HY_LONG_DECAY_PCT,
                                  math.log(HY_TARGET) / HY_SHORT_DECAY_PCT, HY_W, dtype=jnp.float32))
    window = jnp.exp(-tn[:, None] * deltas[None, :]) + HY_SHIFT
    filt = filt * window[:, None, None, :]
    fwd, bwd = filt[:, 0], filt[:, 1]
    full = jnp.concatenate([fwd, jnp.zeros((1, HY_ORDER, HY_W), jnp.float32), bwd[:0:-1]], axis=0)
    return jnp.fft.rfft(full, axis=0)


def long_conv(z, kf):
    L = z.shape[1]
    zf = jnp.fft.rfft(z, n=2 * L, axis=1)
    return jnp.fft.irfft(zf * kf[None], n=2 * L, axis=1)[:, :L]


def mixer(h, lp, init, latent):
    B, L, _ = h.shape
    s_ret0, c0, n0, m0 = [t.astype(jnp.float32) for t in init]
    proj = jnp.einsum('bld,de->ble', h, lp['w_in']).astype(jnp.float32)
    r_part, hy_part, ml_part, g_part = jnp.split(proj, SPLIT_POINTS, axis=-1)

    rq, rk, rv, rg = jnp.split(r_part, 4, axis=-1)
    rq = rq.reshape(B, L, RET_HEADS, RET_DH)
    rk = rk.reshape(B, L, RET_HEADS, RET_DH)
    rv = rv.reshape(B, L, RET_HEADS, RET_DH)
    if latent:
        rq, rk = rope_2d(rq), rope_2d(rk)
    rk = rk * RET_DH ** -0.5
    log_gamma = jax.nn.log_sigmoid(lp['ret_decay_logit'].astype(jnp.float32))
    o_f, s_f = retention_chunked(rq, rk, rv, log_gamma[0], s_ret0[:, 0])
    o_b, s_b = retention_chunked(rq[:, ::-1], rk[:, ::-1], rv[:, ::-1], log_gamma[1], s_ret0[:, 1])
    ret = head_norm(o_f + o_b[:, ::-1], lp['ret_norm_g']) * jax.nn.silu(rg)

    hy = dwconv3(hy_part, lp['hy_conv_w'], lp['hy_conv_b'])
    hv, hx1, hx2 = jnp.split(hy, 3, axis=-1)
    kf = hyena_filter_spectra(L, lp)
    z = hx1 * (long_conv(hv, kf[:, 0]) + lp['hy_bias'][0] * hv)
    hy_out = hx2 * (long_conv(z, kf[:, 1]) + lp['hy_bias'][1] * z)

    mq, mk, mv, mo = jnp.split(ml_part, 4, axis=-1)
    mq = mq.reshape(B, L, ML_HEADS, ML_DH)
    mk = mk.reshape(B, L, ML_HEADS, ML_DH) * ML_DH ** -0.5
    mv = mv.reshape(B, L, ML_HEADS, ML_DH)
    gates = g_part.reshape(B, L, 2, 2, ML_HEADS) + lp['ml_gate_bias']
    i_pre = gates[:, :, :, 0]
    log_f = jax.nn.log_sigmoid(gates[:, :, :, 1])
    h_f, st_f = mlstm_chunked(mq, mk, mv, i_pre[:, :, 0], log_f[:, :, 0], c0[:, 0], n0[:, 0], m0[:, 0])
    h_b, st_b = mlstm_chunked(mq[:, ::-1], mk[:, ::-1], mv[:, ::-1], i_pre[:, ::-1, 1], log_f[:, ::-1, 1],
                              c0[:, 1], n0[:, 1], m0[:, 1])
    ml = head_norm(h_f + h_b[:, ::-1], lp['ml_norm_g']) * jax.nn.sigmoid(mo)

    mixed = jnp.concatenate([ret, hy_out, ml], axis=-1)
    out = jnp.einsum('ble,ed->bld', mixed, lp['w_out'])
    states = (jnp.stack([s_f, s_b], axis=1), jnp.stack([st_f[0], st_b[0]], axis=1),
              jnp.stack([st_f[1], st_b[1]], axis=1), jnp.stack([st_f[2], st_b[2]], axis=1))
    return out, states


def conv_ffn(h, lp):
    up = jnp.einsum('bld,df->blf', h, lp['w_up'])
    a, b = jnp.split(up, 2, axis=-1)
    a = dwconv3(a, lp['ffn_conv_w'], lp['ffn_conv_b'])
    return jnp.einsum('blf,fd->bld', jax.nn.gelu(a, approximate=True) * b, lp['w_down'])


def trunk_layer(x, cvec, lp, init, latent):
    mod = jax.nn.silu(cvec.astype(jnp.float32)) @ lp['w_mod'] + lp['b_mod']
    sh1, sc1, g1, sh2, sc2, g2 = jnp.split(mod[:, None, :], 6, axis=-1)
    h = rmsnorm(x, lp['norm_mix_pre']) * (1.0 + sc1) + sh1
    mix, states = mixer(h, lp, init, latent)
    x1 = x + g1 * rmsnorm(mix, lp['norm_mix_post'])
    h = rmsnorm(x1, lp['norm_ffn_pre']) * (1.0 + sc2) + sh2
    out = x1 + g2 * rmsnorm(conv_ffn(h, lp), lp['norm_ffn_post'])
    return out.astype(x.dtype), states


def setup_inputs(seed: int = 0) -> dict:
    key = jax.random.key(seed)
    keys = jax.random.split(key, 48)
    counter = [0]

    def nrm(shape, scale):
        k = keys[counter[0]]
        counter[0] += 1
        return jax.random.normal(k, shape, jnp.float32) * scale

    D = D_MODEL
    gain = lambda shape: 1.0 + nrm(shape, 0.05)
    ret_logit = jnp.log(2.0 ** (5.0 + jnp.arange(RET_HEADS, dtype=jnp.float32)) - 1.0)
    gate_base = jnp.stack([jnp.zeros((ML_HEADS,), jnp.float32), jnp.linspace(3.0, 6.0, ML_HEADS, dtype=jnp.float32)])
    return {
        'x_prompt': nrm((BATCH, SEQ, D), 1.0),
        'x_sample': nrm((DEC_BATCH, DEC_SEQ, D), 1.0),
        'c': nrm((DEC_BATCH, D), 1.0),
        'state_ret': nrm((DEC_BATCH, DEPTH, 2, RET_HEADS, RET_DH, RET_DH), 0.5),
        'state_mlstm_c': nrm((DEC_BATCH, DEPTH, 2, ML_HEADS, ML_DH, ML_DH), 0.5),
        'state_mlstm_n': nrm((DEC_BATCH, DEPTH, 2, ML_HEADS, ML_DH), 0.5),
        'state_mlstm_m': nrm((DEC_BATCH, DEPTH, 2, ML_HEADS), 0.5),
        'c_ctx': nrm((D,), 1.0),
        'norm_mix_pre': gain((DEPTH, D)),
        'norm_mix_post': gain((DEPTH, D)),
        'norm_ffn_pre': gain((DEPTH, D)),
        'norm_ffn_post': gain((DEPTH, D)),
        'w_mod': nrm((DEPTH, D, 6 * D), 0.3 * D ** -0.5),
        'b_mod': nrm((DEPTH, 6 * D), 0.02),
        'w_in': nrm((DEPTH, D, IN_W), D ** -0.5),
        'w_out': nrm((DEPTH, MIX_W, D), MIX_W ** -0.5),
        'ret_decay_logit': jnp.broadcast_to(ret_logit, (DEPTH, 2, RET_HEADS)) + nrm((DEPTH, 2, RET_HEADS), 0.1),
        'ret_norm_g': gain((DEPTH, RET_W)),
        'hy_conv_w': nrm((DEPTH, 3, 3 * HY_W), 0.5),
        'hy_conv_b': nrm((DEPTH, 3 * HY_W), 0.02),
        'hy_f_w1': nrm((DEPTH, FEAT_W, FILT_W), FEAT_W ** -0.5),
        'hy_f_b1': nrm((DEPTH, FILT_W), 0.1),
        'hy_f_w2': nrm((DEPTH, FILT_W, FILT_W), FILT_W ** -0.5),
        'hy_f_b2': nrm((DEPTH, FILT_W), 0.1),
        'hy_f_w3': nrm((DEPTH, FILT_W, 2 * HY_ORDER * HY_W), 0.1 * FILT_W ** -0.5),
        'hy_f_b3': nrm((DEPTH, 2 * HY_ORDER * HY_W), 0.01),
        'hy_sin_freq': 1.0 + nrm((DEPTH, FILT_W), 0.1),
        'hy_bias': nrm((DEPTH, HY_ORDER, HY_W), 0.5),
        'ml_gate_bias': jnp.broadcast_to(gate_base, (DEPTH, 2, 2, ML_HEADS)) + nrm((DEPTH, 2, 2, ML_HEADS), 0.1),
        'ml_norm_g': gain((DEPTH, ML_W)),
        'w_up': nrm((DEPTH, D, 2 * D_FF), D ** -0.5),
        'ffn_conv_w': nrm((DEPTH, 3, D_FF), 0.5),
        'ffn_conv_b': nrm((DEPTH, D_FF), 0.02),
        'w_down': nrm((DEPTH, D_FF, D), D_FF ** -0.5),
    }


def reference(x_prompt, x_sample, c, state_ret, state_mlstm_c, state_mlstm_n, state_mlstm_m, c_ctx,
              norm_mix_pre, norm_mix_post, norm_ffn_pre, norm_ffn_post, w_mod, b_mod, w_in, w_out,
              ret_decay_logit, ret_norm_g, hy_conv_w, hy_conv_b, hy_f_w1, hy_f_b1, hy_f_w2, hy_f_b2,
              hy_f_w3, hy_f_b3, hy_sin_freq, hy_bias, ml_gate_bias, ml_norm_g,
              w_up, ffn_conv_w, ffn_conv_b, w_down):
    f32 = jnp.float32
    bp = x_prompt.shape[0]
    c_prompt = jnp.broadcast_to(c_ctx[None, :], (bp, D_MODEL))
    zero_init = (jnp.zeros((bp, 2, RET_HEADS, RET_DH, RET_DH), f32),
                 jnp.zeros((bp, 2, ML_HEADS, ML_DH, ML_DH), f32),
                 jnp.zeros((bp, 2, ML_HEADS, ML_DH), f32),
                 jnp.zeros((bp, 2, ML_HEADS), f32))
    xp, xs = x_prompt, x_sample
    new_ret, new_c, new_n, new_m = [], [], [], []
    for l in range(DEPTH):
        lp = {
            'norm_mix_pre': norm_mix_pre[l], 'norm_mix_post': norm_mix_post[l],
            'norm_ffn_pre': norm_ffn_pre[l], 'norm_ffn_post': norm_ffn_post[l],
            'w_mod': w_mod[l], 'b_mod': b_mod[l], 'w_in': w_in[l], 'w_out': w_out[l],
            'ret_decay_logit': ret_decay_logit[l], 'ret_norm_g': ret_norm_g[l],
            'hy_conv_w': hy_conv_w[l], 'hy_conv_b': hy_conv_b[l],
            'hy_f_w1': hy_f_w1[l], 'hy_f_b1': hy_f_b1[l], 'hy_f_w2': hy_f_w2[l], 'hy_f_b2': hy_f_b2[l],
            'hy_f_w3': hy_f_w3[l], 'hy_f_b3': hy_f_b3[l], 'hy_sin_freq': hy_sin_freq[l], 'hy_bias': hy_bias[l],
            'ml_gate_bias': ml_gate_bias[l], 'ml_norm_g': ml_norm_g[l],
            'w_up': w_up[l], 'ffn_conv_w': ffn_conv_w[l], 'ffn_conv_b': ffn_conv_b[l], 'w_down': w_down[l],
        }
        xp, st = trunk_layer(xp, c_prompt, lp, zero_init, False)
        new_ret.append(st[0])
        new_c.append(st[1])
        new_n.append(st[2])
        new_m.append(st[3])
        cache_init = (state_ret[:, l], state_mlstm_c[:, l], state_mlstm_n[:, l], state_mlstm_m[:, l])
        xs, _ = trunk_layer(xs, c, lp, cache_init, True)
    return (xp, xs, jnp.stack(new_ret, axis=1), jnp.stack(new_c, axis=1), jnp.stack(new_n, axis=1), jnp.stack(new_m, axis=1))
```

```cpp
#include <hip/hip_runtime.h>
#include <stdint.h>
#include <stdio.h>

#define NT 512
typedef unsigned short bf16_t;
typedef short bf16x8 __attribute__((ext_vector_type(8)));
typedef float f32x4 __attribute__((ext_vector_type(4)));

constexpr int D = 1024, T = 6144, TC = 4096, DEPTH = 4;
constexpr int INW = 3856, INWP = 3968, DFF = 4096;
constexpr float EPS = 1e-6f;
constexpr size_t O_YP = 0, O_YS = 4194304, O_SR = 6291456, O_MC = 11010048, O_MN = 15728640, O_MM = 15777792;

#ifndef NAIVE_GEMM
#define NAIVE_GEMM 0
#endif

struct Params {
  const float *x_prompt, *x_sample, *c, *state_ret, *state_c, *state_n, *state_m, *c_ctx;
  const float *norm_mix_pre, *norm_mix_post, *norm_ffn_pre, *norm_ffn_post, *w_mod, *b_mod, *w_in, *w_out;
  const float *ret_decay_logit, *ret_norm_g, *hy_conv_w, *hy_conv_b, *hy_f_w1, *hy_f_b1, *hy_f_w2, *hy_f_b2, *hy_f_w3, *hy_f_b3, *hy_sin_freq, *hy_bias, *ml_gate_bias, *ml_norm_g;
  const float *w_up, *ffn_conv_w, *ffn_conv_b, *w_down;
  float* out;
  bf16_t *wt_in, *wt_out, *wt_up, *wt_down;
  float *mod, *rope_cos, *rope_sin, *filt;
  float *xbuf, *x1buf, *raw;
  bf16_t *hbuf, *proj, *ktr, *vtr, *ktm, *vtm, *hyt, *mixed, *abuf, *bbuf, *ubuf;
  float *gates, *hvc, *z1;
};

__device__ __forceinline__ bf16_t f2bf(float f) {
  unsigned u = __float_as_uint(f);
  u += 0x7fffu + ((u >> 16) & 1u);
  return (bf16_t)(u >> 16);
}
__device__ __forceinline__ float bf2f(bf16_t h) { return __uint_as_float(((unsigned)h) << 16); }
__device__ __forceinline__ unsigned pack2(float a, float b) { return (unsigned)f2bf(a) | ((unsigned)f2bf(b) << 16); }
__device__ __forceinline__ float wave_sum(float v) {
#pragma unroll
  for (int o = 32; o > 0; o >>= 1) v += __shfl_xor(v, o);
  return v;
}
__device__ __forceinline__ float sigmoidf_(float x) { return 1.f / (1.f + __expf(-x)); }
__device__ __forceinline__ float log_sigmoidf_(float x) { return fminf(x, 0.f) - log1pf(__expf(-fabsf(x))); }
__device__ __forceinline__ float gelu_tanh(float x) {
  const float k = 0.7978845608028654f;
  float u = k * (x + 0.044715f * x * x * x);
  return 0.5f * x * (1.f + tanhf(u));
}
__device__ __forceinline__ int seq_len(int s) { return s < 16 ? 256 : 1024; }
__device__ __forceinline__ int seq_row0(int s) { return s < 16 ? s * 256 : TC + (s - 16) * 1024; }
__device__ __forceinline__ int row_mod(int row) { return row < TC ? 0 : 1 + ((row - TC) >> 10); }

__device__ void tr_tile(const float* __restrict__ src, int K, int N, int k0, int n0, bf16_t* __restrict__ dst, int drow0, float* lds) {
  const int tid = threadIdx.x;
#pragma unroll
  for (int i = 0; i < 2; i++) {
    int k = (tid >> 4) + 32 * i, n4 = (tid & 15) * 4;
    float4 v = make_float4(0.f, 0.f, 0.f, 0.f);
    if (n0 + n4 < N) v = *(const float4*)(src + (size_t)(k0 + k) * N + n0 + n4);
    lds[(n4 + 0) * 65 + k] = v.x; lds[(n4 + 1) * 65 + k] = v.y; lds[(n4 + 2) * 65 + k] = v.z; lds[(n4 + 3) * 65 + k] = v.w;
  }
  __syncthreads();
  {
    int n = tid >> 3, kc = (tid & 7) * 8;
    const float* r = lds + n * 65 + kc;
    uint4 o;
    o.x = pack2(r[0], r[1]); o.y = pack2(r[2], r[3]); o.z = pack2(r[4], r[5]); o.w = pack2(r[6], r[7]);
    *(uint4*)(dst + (size_t)(drow0 + n) * K + k0 + kc) = o;
  }
  __syncthreads();
}

constexpr int TR_IN = 16 * 62, TR_OUT = 16 * 16, TR_UP = 16 * 128, TR_DN = 64 * 16, TR_L = TR_IN + TR_OUT + TR_UP + TR_DN;
__device__ void phase_transpose(const Params& p, int bid, int nb, char* smem) {
  float* lds = (float*)smem;
  for (int u = bid; u < DEPTH * TR_L; u += nb) {
    int l = u / TR_L, r = u % TR_L;
    if (r < TR_IN) {
      int kt = r / 62, nt = r % 62;
      tr_tile(p.w_in + (size_t)l * D * INW, D, INW, kt * 64, nt * 64, p.wt_in + (size_t)l * INWP * D, nt * 64, lds);
    } else if ((r -= TR_IN) < TR_OUT) {
      int kt = r / 16, nt = r % 16;
      tr_tile(p.w_out + (size_t)l * D * D, D, D, kt * 64, nt * 64, p.wt_out + (size_t)l * D * D, nt * 64, lds);
    } else if ((r -= TR_OUT) < TR_UP) {
      int kt = r / 128, nt = r % 128;
      int drow0 = nt < 64 ? nt * 128 : (nt - 64) * 128 + 64;
      tr_tile(p.w_up + (size_t)l * D * 2 * DFF, D, 2 * DFF, kt * 64, nt * 64, p.wt_up + (size_t)l * 2 * DFF * D, drow0, lds);
    } else {
      r -= TR_UP;
      int kt = r / 16, nt = r % 16;
      tr_tile(p.w_down + (size_t)l * DFF * D, DFF, D, kt * 64, nt * 64, p.wt_down + (size_t)l * D * DFF, nt * 64, lds);
    }
  }
}

__device__ void phase_mod(const Params& p, int bid, int nb, char* smem) {
  float* sv = (float*)smem;
  float* red = sv + 3 * 1024;
  const int tid = threadIdx.x, lane = tid & 63, wid = tid >> 6;
  for (int i = tid; i < 3 * 1024; i += NT) {
    int v = i >> 10, k = i & 1023;
    float x = v == 0 ? p.c_ctx[k] : p.c[(v - 1) * 1024 + k];
    sv[i] = x * sigmoidf_(x);
  }
  __syncthreads();
  for (int u = bid; u < DEPTH * 48; u += nb) {
    int l = u / 48, cb = u % 48;
    int kg = wid * 2 + (lane >> 5), cl = lane & 31;
    const float* w = p.w_mod + (size_t)l * D * 6144 + cb * 128 + cl * 4;
    float acc[3][4] = {};
    for (int k = kg * 64; k < kg * 64 + 64; k++) {
      float4 wv = *(const float4*)(w + (size_t)k * 6144);
#pragma unroll
      for (int v = 0; v < 3; v++) {
        float s = sv[v * 1024 + k];
        acc[v][0] += s * wv.x; acc[v][1] += s * wv.y; acc[v][2] += s * wv.z; acc[v][3] += s * wv.w;
      }
    }
#pragma unroll
    for (int v = 0; v < 3; v++)
#pragma unroll
      for (int j = 0; j < 4; j++) red[(kg * 3 + v) * 128 + cl * 4 + j] = acc[v][j];
    __syncthreads();
    if (tid < 384) {
      int v = tid >> 7, cidx = tid & 127;
      float s = 0.f;
      for (int g = 0; g < 16; g++) s += red[(g * 3 + v) * 128 + cidx];
      int col = cb * 128 + cidx;
      p.mod[((size_t)l * 3 + v) * 6144 + col] = s + p.b_mod[(size_t)l * 6144 + col];
    }
    __syncthreads();
  }
}

__device__ void phase_rope(const Params& p, int bid, int nb) {
  for (int i = bid * NT + threadIdx.x; i < 1024 * 48; i += nb * NT) {
    int pos = i / 48, j = i % 48;
    int f = j < 24 ? j : j - 24;
    float base = j < 24 ? (float)(pos >> 6) : (float)(pos & 63);
    float freq = powf(10000.f, -(float)f / 24.f);
    float a = base * freq;
    p.rope_cos[i] = cosf(a); p.rope_sin[i] = sinf(a);
  }
}

constexpr int FILT_L = 1280 * 1024;
__device__ void phase_filt(const Params& p, int bid, int nb, char* smem) {
  float* feat = (float*)smem;
  float* h1 = feat + 16 * 33;
  float* h2 = h1 + 16 * 64;
  const int tid = threadIdx.x;
  for (int u = bid; u < DEPTH * 80; u += nb) {
    int l = u / 80, pb = u % 80;
    int path = pb < 16 ? 0 : 1;
    int Lp = path ? 1024 : 256;
    int pos0 = path ? (pb - 16) * 16 : pb * 16;
    for (int i = tid; i < 16 * 33; i += NT) {
      int pp = i / 33, j = i % 33;
      float tn = (float)(pos0 + pp) / (float)Lp;
      float v;
      if (j == 0) v = tn;
      else {
        int bi = (j - 1) & 15;
        float band = 1e-4f + (float)bi * ((15.f - 1e-4f) / 15.f);
        float ang = 6.283185307179586f * tn * band;
        v = j <= 16 ? cosf(ang) : sinf(ang);
      }
      feat[i] = v;
    }
    __syncthreads();
    for (int i = tid; i < 16 * 64; i += NT) {
      int pp = i >> 6, j = i & 63;
      float s = p.hy_f_b1[l * 64 + j];
      for (int k = 0; k < 33; k++) s += feat[pp * 33 + k] * p.hy_f_w1[((size_t)l * 33 + k) * 64 + j];
      h1[i] = sinf(p.hy_sin_freq[l * 64 + j] * s);
    }
    __syncthreads();
    for (int i = tid; i < 16 * 64; i += NT) {
      int pp = i >> 6, j = i & 63;
      float s = p.hy_f_b2[l * 64 + j];
      for (int k = 0; k < 64; k++) s += h1[pp * 64 + k] * p.hy_f_w2[((size_t)l * 64 + k) * 64 + j];
      h2[i] = sinf(p.hy_sin_freq[l * 64 + j] * s);
    }
    __syncthreads();
    for (int n = tid; n < 1024; n += NT) {
      float acc[16];
      float b3 = p.hy_f_b3[l * 1024 + n];
#pragma unroll
      for (int pp = 0; pp < 16; pp++) acc[pp] = b3;
      for (int k = 0; k < 64; k++) {
        float w = p.hy_f_w3[((size_t)l * 64 + k) * 1024 + n];
#pragma unroll
        for (int pp = 0; pp < 16; pp++) acc[pp] += h2[pp * 64 + k] * w;
      }
      int ch = n & 255;
      float lo = logf(0.01f) / 1.5f, hi = logf(0.01f) / 0.3f;
      float delta = fabsf(lo + (hi - lo) * (float)ch / 255.f);
      float* dst = p.filt + (size_t)l * FILT_L + (path ? 256 * 1024 : 0) + (size_t)n * Lp + pos0;
#pragma unroll
      for (int pp = 0; pp < 16; pp++) {
        float tn = (float)(pos0 + pp) / (float)Lp;
        dst[pp] = acc[pp] * (__expf(-tn * delta) + 0.05f);
      }
    }
    __syncthreads();
  }
}

__device__ void phase_rowpass(const Params& p, int layer, int which, int bid, int nb) {
  const int lane = threadIdx.x & 63, wid = threadIdx.x >> 6;
  for (int row = bid * 8 + wid; row < T; row += nb * 8) {
    const int mi = row_mod(row);
    const float* xs;
    const float* gate = nullptr; const float* gpost = nullptr;
    float* xd; bf16_t* hd = nullptr; const float *gpre = nullptr, *sc = nullptr, *sh = nullptr;
    bool has_raw;
    if (which == 0) {
      if (layer == 0) { xs = row < TC ? p.x_prompt + (size_t)row * D : p.x_sample + (size_t)(row - TC) * D; has_raw = false; }
      else { xs = p.x1buf + (size_t)row * D; has_raw = true; gate = p.mod + ((size_t)(layer - 1) * 3 + mi) * 6144 + 5 * 1024; gpost = p.norm_ffn_post + (layer - 1) * D; }
      if (layer < DEPTH) { xd = p.xbuf + (size_t)row * D; hd = p.hbuf + (size_t)row * D; gpre = p.norm_mix_pre + layer * D;
        sh = p.mod + ((size_t)layer * 3 + mi) * 6144; sc = sh + 1024; }
      else xd = p.out + (size_t)row * D;
    } else {
      xs = p.xbuf + (size_t)row * D; has_raw = true; gate = p.mod + ((size_t)layer * 3 + mi) * 6144 + 2 * 1024; gpost = p.norm_mix_post + layer * D;
      xd = p.x1buf + (size_t)row * D; hd = p.hbuf + (size_t)row * D; gpre = p.norm_ffn_pre + layer * D;
      sh = p.mod + ((size_t)layer * 3 + mi) * 6144 + 3 * 1024; sc = sh + 1024;
    }
    float4 x[4];
#pragma unroll
    for (int i = 0; i < 4; i++) x[i] = *(const float4*)(xs + lane * 4 + 256 * i);
    if (has_raw) {
      float4 r[4]; float ss = 0.f;
      const float* rp = p.raw + (size_t)row * D;
#pragma unroll
      for (int i = 0; i < 4; i++) { r[i] = *(const float4*)(rp + lane * 4 + 256 * i); ss += r[i].x * r[i].x + r[i].y * r[i].y + r[i].z * r[i].z + r[i].w * r[i].w; }
      ss = wave_sum(ss);
      float rs = rsqrtf(ss * (1.f / 1024.f) + EPS);
#pragma unroll
      for (int i = 0; i < 4; i++) {
        float4 g = *(const float4*)(gate + lane * 4 + 256 * i), gp = *(const float4*)(gpost + lane * 4 + 256 * i);
        x[i].x += g.x * gp.x * r[i].x * rs; x[i].y += g.y * gp.y * r[i].y * rs; x[i].z += g.z * gp.z * r[i].z * rs; x[i].w += g.w * gp.w * r[i].w * rs;
      }
    }
#pragma unroll
    for (int i = 0; i < 4; i++) *(float4*)(xd + lane * 4 + 256 * i) = x[i];
    if (hd) {
      float ss = 0.f;
#pragma unroll
      for (int i = 0; i < 4; i++) ss += x[i].x * x[i].x + x[i].y * x[i].y + x[i].z * x[i].z + x[i].w * x[i].w;
      ss = wave_sum(ss);
      float rs = rsqrtf(ss * (1.f / 1024.f) + EPS);
#pragma unroll
      for (int i = 0; i < 4; i++) {
        int e = lane * 4 + 256 * i;
        float4 g = *(const float4*)(gpre + e), s1 = *(const float4*)(sc + e), s0 = *(const float4*)(sh + e);
        float h0 = x[i].x * rs * g.x * (1.f + s1.x) + s0.x, h1 = x[i].y * rs * g.y * (1.f + s1.y) + s0.y;
        float h2 = x[i].z * rs * g.z * (1.f + s1.z) + s0.z, h3 = x[i].w * rs * g.w * (1.f + s1.w) + s0.w;
        uint2 o; o.x = pack2(h0, h1); o.y = pack2(h2, h3);
        *(uint2*)(hd + e) = o;
      }
    }
  }
}

struct EpiProj {
  bf16_t *proj, *ktr, *vtr, *ktm, *vtm, *hyt; float* gates;
  __device__ __forceinline__ void operator()(int row, int col, f32x4 v) const {
    if (col >= INW) return;
    uint2 o; o.x = pack2(v[0], v[1]); o.y = pack2(v[2], v[3]);
    *(uint2*)(proj + (size_t)row * INW + col) = o;
    bf16_t* tp = nullptr; int tc = 0;
    if (col >= 384 && col < 768) { tp = ktr; tc = col - 384; }
    else if (col >= 768 && col < 1152) { tp = vtr; tc = col - 768; }
    else if (col >= 1536 && col < 2304) { tp = hyt; tc = col - 1536; }
    else if (col >= 2688 && col < 3072) { tp = ktm; tc = col - 2688; }
    else if (col >= 3072 && col < 3456) { tp = vtm; tc = col - 3072; }
    if (tp) {
#pragma unroll
      for (int r = 0; r < 4; r++) tp[(size_t)(tc + r) * T + row] = f2bf(v[r]);
    }
    if (col >= 3840) *(float4*)(gates + (size_t)row * 16 + (col - 3840)) = make_float4(v[0], v[1], v[2], v[3]);
  }
};
struct EpiF32 {
  float* out; int ld;
  __device__ __forceinline__ void operator()(int row, int col, f32x4 v) const {
    *(float4*)(out + (size_t)row * ld + col) = make_float4(v[0], v[1], v[2], v[3]);
  }
};
struct EpiUp {
  bf16_t *a, *b;
  __device__ __forceinline__ void operator()(int row, int col, f32x4 v) const {
    int j = col >> 7, r = col & 127;
    bf16_t* dst = a + (r < 64 ? (size_t)0 : (size_t)T * DFF) + (size_t)row * DFF + j * 64 + (r & 63);
    uint2 o; o.x = pack2(v[0], v[1]); o.y = pack2(v[2], v[3]);
    *(uint2*)dst = o;
  }
};

template <int BM, class Epi>
__device__ __forceinline__ void gemm_tile(const bf16_t* __restrict__ A, const bf16_t* __restrict__ Bt, int K, int m0, int n0, char* smem, const Epi& epi) {
  constexpr int MT = BM / 64;
  constexpr int ACH = BM * 8 / NT;
  constexpr int ABYTES = BM * 128, BBYTES = 128 * 128, STAGE = ABYTES + BBYTES;
  const int tid = threadIdx.x, lane = tid & 63, wid = tid >> 6;
  const int wm = wid >> 1, wn = wid & 1;
  const int lr = lane & 15, lg = lane >> 4;
  uint4 ra[ACH], rb[2];
  const bf16_t* Ab = A + (size_t)m0 * K;
  const bf16_t* Bb = Bt + (size_t)n0 * K;
  f32x4 acc[MT][4];
#pragma unroll
  for (int i = 0; i < MT; i++)
#pragma unroll
    for (int j = 0; j < 4; j++) acc[i][j] = (f32x4){0.f, 0.f, 0.f, 0.f};
  auto gload = [&](int kt) {
#pragma unroll
    for (int i = 0; i < ACH; i++) { int c = tid + i * NT, row = c >> 3, ch = c & 7; ra[i] = *(const uint4*)(Ab + (size_t)row * K + kt * 64 + ch * 8); }
#pragma unroll
    for (int i = 0; i < 2; i++) { int c = tid + i * NT, row = c >> 3, ch = c & 7; rb[i] = *(const uint4*)(Bb + (size_t)row * K + kt * 64 + ch * 8); }
  };
  auto swrite = [&](int buf) {
    char* sa = smem + buf * STAGE; char* sb = sa + ABYTES;
#pragma unroll
    for (int i = 0; i < ACH; i++) { int c = tid + i * NT, row = c >> 3, ch = c & 7; *(uint4*)(sa + row * 128 + ((ch ^ (row & 7)) << 4)) = ra[i]; }
#pragma unroll
    for (int i = 0; i < 2; i++) { int c = tid + i * NT, row = c >> 3, ch = c & 7; *(uint4*)(sb + row * 128 + ((ch ^ (row & 7)) << 4)) = rb[i]; }
  };
  const int nk = K / 64;
  gload(0); swrite(0); __syncthreads();
  for (int kt = 0; kt < nk; kt++) {
    const int cur = kt & 1;
    if (kt + 1 < nk) gload(kt + 1);
    const char* sa = smem + cur * STAGE; const char* sb = sa + ABYTES;
#pragma unroll
    for (int ks = 0; ks < 2; ks++) {
      bf16x8 af[MT], bfr[4];
#pragma unroll
      for (int mi = 0; mi < MT; mi++) { int row = wm * (BM / 4) + mi * 16 + lr, ch = ks * 4 + lg; af[mi] = *(const bf16x8*)(sa + row * 128 + ((ch ^ (row & 7)) << 4)); }
#pragma unroll
      for (int ni = 0; ni < 4; ni++) { int row = wn * 64 + ni * 16 + lr, ch = ks * 4 + lg; bfr[ni] = *(const bf16x8*)(sb + row * 128 + ((ch ^ (row & 7)) << 4)); }
#pragma unroll
      for (int mi = 0; mi < MT; mi++)
#pragma unroll
        for (int ni = 0; ni < 4; ni++) acc[mi][ni] = __builtin_amdgcn_mfma_f32_16x16x32_bf16(bfr[ni], af[mi], acc[mi][ni], 0, 0, 0);
    }
    if (kt + 1 < nk) swrite(cur ^ 1);
    __syncthreads();
  }
#pragma unroll
  for (int mi = 0; mi < MT; mi++)
#pragma unroll
    for (int ni = 0; ni < 4; ni++) epi(m0 + wm * (BM / 4) + mi * 16 + lr, n0 + wn * 64 + ni * 16 + lg * 4, acc[mi][ni]);
}

template <class Epi>
__device__ void gemm_naive(const bf16_t* __restrict__ A, const bf16_t* __restrict__ Bt, int M, int N, int K, int bid, int nb, const Epi& epi) {
  const int ng = N / 4;
  for (size_t idx = (size_t)bid * NT + threadIdx.x; idx < (size_t)M * ng; idx += (size_t)nb * NT) {
    int row = (int)(idx / ng), col = (int)(idx % ng) * 4;
    f32x4 acc = {0.f, 0.f, 0.f, 0.f};
    const bf16_t* a = A + (size_t)row * K;
    for (int k = 0; k < K; k++) {
      float av = bf2f(a[k]);
#pragma unroll
      for (int j = 0; j < 4; j++) acc[j] += av * bf2f(Bt[(size_t)(col + j) * K + k]);
    }
    epi(row, col, acc);
  }
}

template <int BM, class Epi>
__device__ void phase_gemm(const bf16_t* A, const bf16_t* Bt, int M, int N, int K, int bid, int nb, char* smem, const Epi& epi) {
#if NAIVE_GEMM
  gemm_naive(A, Bt, M, N, K, bid, nb, epi);
#else
  const int nm = M / BM, nn = N / 128;
  for (int t = bid; t < nm * nn; t += nb) {
    int tm = t % nm, tn = t / nm;
    gemm_tile<BM, Epi>(A, Bt, K, tm * BM, tn * 128, smem, epi);
  }
#endif
}

constexpr int MIX_UNITS = 16 * 4 * 8 + 2 * 4 * 32;
__device__ __forceinline__ void mix_unit_decode(int u, int& s, int& h, int& qb) {
  if (u < 512) { s = u >> 5; h = (u >> 3) & 3; qb = u & 7; }
  else { u -= 512; s = 16 + (u >> 7); h = (u >> 5) & 3; qb = u & 31; }
}

template <bool ML>
__device__ void phase_mix_naive(const Params& p, int layer, int bid, int nb, char* smem) {
  float* sq = (float*)smem;
  float* sk = sq + 32 * 97;
  float* sv = sk + 64 * 97;
  float* sSf = sv + 64 * 97;
  float* sSb = sSf + 32 * 65;
  float* so = sSb + 32 * 65;
  float* gB = so + 32 * 97;
  const int tid = threadIdx.x;
  const int QOFF = ML ? 2304 : 0, KOFF = ML ? 2688 : 384, VOFF = ML ? 3072 : 768, GOFF = ML ? 3456 : 1152;
  for (int u = bid; u < MIX_UNITS; u += nb) {
    int s, h, qb; mix_unit_decode(u, s, h, qb);
    const int L = seq_len(s), row0 = seq_row0(s);
    const bool latent = s >= 16;
    const int lb = s - 16;
    float lgf = 0.f, lgb = 0.f, m0f = 0.f, m0b = 0.f;
    if (!ML) {
      lgf = log_sigmoidf_(p.ret_decay_logit[layer * 8 + h]) * 1.4426950408889634f;
      lgb = log_sigmoidf_(p.ret_decay_logit[layer * 8 + 4 + h]) * 1.4426950408889634f;
    } else {
      float *Bf = gB, *If = gB + 1024, *Xf = gB + 2048, *Bb = gB + 3072, *Ib = gB + 4096, *Xb = gB + 5120;
      if (latent) { m0f = p.state_m[((lb * DEPTH + layer) * 2 + 0) * 4 + h]; m0b = p.state_m[((lb * DEPTH + layer) * 2 + 1) * 4 + h]; }
      for (int t = tid; t < L; t += NT) {
        const float* g = p.gates + (size_t)(row0 + t) * 16;
        const float* gbias = p.ml_gate_bias + layer * 16;
        If[t] = g[0 + h] + gbias[0 + h];
        Bf[t] = log_sigmoidf_(g[4 + h] + gbias[4 + h]);
        Ib[t] = g[8 + h] + gbias[8 + h];
        Bb[t] = log_sigmoidf_(g[12 + h] + gbias[12 + h]);
      }
      __syncthreads();
      if (tid == 0) {
        float b = 0.f, x = m0f;
        for (int t = 0; t < L; t++) { b += Bf[t]; Bf[t] = b; x = fmaxf(x, If[t] - b); Xf[t] = x; }
      } else if (tid == 64) {
        float b = 0.f, x = m0b;
        for (int t = L - 1; t >= 0; t--) { b += Bb[t]; Bb[t] = b; x = fmaxf(x, Ib[t] - b); Xb[t] = x; }
      }
      __syncthreads();
    }
    for (int i = tid; i < 32 * 96; i += NT) {
      int r = i / 96, d = i % 96;
      int pos = qb * 32 + r;
      const bf16_t* pr = p.proj + (size_t)(row0 + pos) * INW + QOFF + h * 96;
      float v = bf2f(pr[d]);
      if (!ML && latent) {
        int dd = d < 48 ? d : d - 48;
        float c = p.rope_cos[pos * 48 + dd], sn = p.rope_sin[pos * 48 + dd];
        float o = bf2f(pr[d < 48 ? d + 48 : d - 48]);
        v = d < 48 ? v * c - o * sn : v * c + o * sn;
      }
      sq[r * 97 + d] = v;
    }
    const int qi = tid & 31, grp = tid >> 5;
    float numf[6] = {}, numb[6] = {}, denf = 0.f, denb = 0.f;
    const int pi = qb * 32 + qi;
    for (int jt = 0; jt < L / 64; jt++) {
      __syncthreads();
      for (int i = tid; i < 64 * 96; i += NT) {
        int r = i / 96, d = i % 96;
        int pos = jt * 64 + r;
        const bf16_t* pr = p.proj + (size_t)(row0 + pos) * INW;
        float kv = bf2f(pr[KOFF + h * 96 + d]);
        if (!ML && latent) {
          int dd = d < 48 ? d : d - 48;
          float c = p.rope_cos[pos * 48 + dd], sn = p.rope_sin[pos * 48 + dd];
          float o = bf2f(pr[KOFF + h * 96 + (d < 48 ? d + 48 : d - 48)]);
          kv = d < 48 ? kv * c - o * sn : kv * c + o * sn;
        }
        sk[r * 97 + d] = kv * 0.10206207261596577f;
        sv[r * 97 + d] = bf2f(pr[VOFF + h * 96 + d]);
      }
      __syncthreads();
#pragma unroll
      for (int jj = 0; jj < 4; jj++) {
        int j = grp * 4 + jj;
        float dot = 0.f;
        for (int d = 0; d < 96; d++) dot += sq[qi * 97 + d] * sk[j * 97 + d];
        int pj = jt * 64 + j;
        float wf, wb;
        if (!ML) {
          wf = pj <= pi ? exp2f((float)(pi - pj) * lgf) : 0.f;
          wb = pj >= pi ? exp2f((float)(pj - pi) * lgb) : 0.f;
        } else {
          float *Bf = gB, *If = gB + 1024, *Xf = gB + 2048, *Bb = gB + 3072, *Ib = gB + 4096, *Xb = gB + 5120;
          wf = pj <= pi ? __expf(If[pj] - Bf[pj] - Xf[pi]) : 0.f;
          wb = pj >= pi ? __expf(Ib[pj] - Bb[pj] - Xb[pi]) : 0.f;
        }
        sSf[qi * 65 + j] = dot * wf; sSb[qi * 65 + j] = dot * wb;
      }
      __syncthreads();
      for (int j = 0; j < 64; j++) {
        float sf = sSf[qi * 65 + j], sb = sSb[qi * 65 + j];
        denf += sf; denb += sb;
#pragma unroll
        for (int e = 0; e < 6; e++) { float vv = sv[j * 97 + grp * 6 + e]; numf[e] += sf * vv; numb[e] += sb * vv; }
      }
    }
    if (latent) {
      const float* S0f; const float* S0b;
      size_t sidx = ((size_t)(lb * DEPTH + layer) * 2) * 4;
      if (!ML) { S0f = p.state_ret + (sidx + 0 * 4 + h) * 9216; S0b = p.state_ret + (sidx + 1 * 4 + h) * 9216; }
      else { S0f = p.state_c + (sidx + 0 * 4 + h) * 9216; S0b = p.state_c + (sidx + 1 * 4 + h) * 9216; }
      float wf, wb;
      if (!ML) { wf = exp2f((float)(pi + 1) * lgf); wb = exp2f((float)(L - pi) * lgb); }
      else { float* Xf = gB + 2048; float* Xb = gB + 5120; wf = __expf(m0f - Xf[pi]); wb = __expf(m0b - Xb[pi]); }
      float af[6] = {}, ab[6] = {};
      for (int d = 0; d < 96; d++) {
        float qv = sq[qi * 97 + d];
#pragma unroll
        for (int e = 0; e < 6; e++) { af[e] += qv * S0f[d * 96 + grp * 6 + e]; ab[e] += qv * S0b[d * 96 + grp * 6 + e]; }
      }
#pragma unroll
      for (int e = 0; e < 6; e++) { numf[e] += wf * af[e]; numb[e] += wb * ab[e]; }
      if (ML) {
        const float* n0f = p.state_n + (sidx + 0 * 4 + h) * 96; const float* n0b = p.state_n + (sidx + 1 * 4 + h) * 96;
        float df = 0.f, db = 0.f;
        for (int d = 0; d < 96; d++) { float qv = sq[qi * 97 + d]; df += qv * n0f[d]; db += qv * n0b[d]; }
        denf += wf * df; denb += wb * db;
      }
    }
    float o[6];
    if (!ML) {
#pragma unroll
      for (int e = 0; e < 6; e++) o[e] = numf[e] + numb[e];
    } else {
      float *Bf = gB, *Xf = gB + 2048, *Bb = gB + 3072, *Xb = gB + 5120;
      float Mf = Bf[pi] + Xf[pi], Mb = Bb[pi] + Xb[pi];
      float nf = 1.f / fmaxf(fabsf(denf), __expf(-Mf)), nbk = 1.f / fmaxf(fabsf(denb), __expf(-Mb));
#pragma unroll
      for (int e = 0; e < 6; e++) o[e] = numf[e] * nf + numb[e] * nbk;
    }
    __syncthreads();
#pragma unroll
    for (int e = 0; e < 6; e++) so[qi * 97 + grp * 6 + e] = o[e];
    __syncthreads();
    float ms = 0.f;
    for (int d = 0; d < 96; d++) { float v = so[qi * 97 + d]; ms += v * v; }
    float rs = rsqrtf(ms * (1.f / 96.f) + EPS);
    const float* ng = (ML ? p.ml_norm_g : p.ret_norm_g) + layer * 384 + h * 96;
    const bf16_t* gp = p.proj + (size_t)(row0 + pi) * INW + GOFF + h * 96;
    bf16_t* mo = p.mixed + (size_t)(row0 + pi) * D + (ML ? 640 : 0) + h * 96;
#pragma unroll
    for (int e = 0; e < 6; e++) {
      int ee = grp * 6 + e;
      float g = bf2f(gp[ee]);
      float gv = ML ? sigmoidf_(g) : g * sigmoidf_(g);
      mo[ee] = f2bf(o[e] * rs * ng[ee] * gv);
    }
    __syncthreads();
  }
}

template <bool ML>
__device__ void phase_state_naive(const Params& p, int layer, int bid, int nb, char* smem) {
  float* w = (float*)smem;
  float* red = w + 256;
  const int tid = threadIdx.x;
  const int KOFF = ML ? 2688 : 384, VOFF = ML ? 3072 : 768;
  for (int u = bid; u < 128; u += nb) {
    int s = u >> 3, h = (u >> 1) & 3, dir = u & 1;
    int row0 = s * 256;
    float mfin = 0.f;
    if (!ML) {
      float lg = log_sigmoidf_(p.ret_decay_logit[layer * 8 + dir * 4 + h]) * 1.4426950408889634f;
      if (tid < 256) w[tid] = exp2f((float)(dir == 0 ? 255 - tid : tid) * lg);
      __syncthreads();
    } else {
      float* If = w + 512; float* Bc = w + 768;
      if (tid < 256) {
        const float* g = p.gates + (size_t)(row0 + tid) * 16; const float* gbias = p.ml_gate_bias + layer * 16;
        If[tid] = g[dir * 8 + h] + gbias[dir * 8 + h];
        Bc[tid] = log_sigmoidf_(g[dir * 8 + 4 + h] + gbias[dir * 8 + 4 + h]);
      }
      __syncthreads();
      if (tid == 0) {
        float b = 0.f;
        if (dir == 0) for (int t = 0; t < 256; t++) { b += Bc[t]; Bc[t] = b; }
        else for (int t = 255; t >= 0; t--) { b += Bc[t]; Bc[t] = b; }
        float btot = b;
        float m = btot + 0.f;
        for (int t = 0; t < 256; t++) m = fmaxf(m, btot - Bc[t] + If[t]);
        red[0] = m; red[1] = btot;
      }
      __syncthreads();
      mfin = red[0];
      float btot = red[1];
      if (tid < 256) w[tid] = __expf(btot - Bc[tid] + If[tid] - mfin);
      __syncthreads();
    }
    const int eg = tid & 15, dq = tid >> 4;
    float acc[3][6] = {};
    float nacc[3] = {};
    for (int t = 0; t < 256; t++) {
      const bf16_t* pr = p.proj + (size_t)(row0 + t) * INW;
      float wt = w[t] * 0.10206207261596577f;
      float vv[6];
#pragma unroll
      for (int e = 0; e < 6; e++) vv[e] = bf2f(pr[VOFF + h * 96 + eg * 6 + e]);
#pragma unroll
      for (int a = 0; a < 3; a++) {
        float kv = bf2f(pr[KOFF + h * 96 + dq + 32 * a]) * wt;
        nacc[a] += kv;
#pragma unroll
        for (int e = 0; e < 6; e++) acc[a][e] += kv * vv[e];
      }
    }
    size_t sidx = (((size_t)s * DEPTH + layer) * 2 + dir) * 4 + h;
    float* dst = p.out + (ML ? O_MC : O_SR) + sidx * 9216;
#pragma unroll
    for (int a = 0; a < 3; a++)
#pragma unroll
      for (int e = 0; e < 6; e++) dst[(dq + 32 * a) * 96 + eg * 6 + e] = acc[a][e];
    if (ML) {
      if (eg == 0) {
#pragma unroll
        for (int a = 0; a < 3; a++) p.out[O_MN + sidx * 96 + dq + 32 * a] = nacc[a];
      }
      if (tid == 0) p.out[O_MM + sidx] = mfin;
    }
    __syncthreads();
  }
}

__device__ void phase_hy1_naive(const Params& p, int layer, int bid, int nb) {
  for (size_t idx = (size_t)bid * NT + threadIdx.x; idx < (size_t)T * 768; idx += (size_t)nb * NT) {
    int row = (int)(idx / 768), c = (int)(idx % 768);
    int L = row < TC ? 256 : 1024;
    int t = row < TC ? (row & 255) : ((row - TC) & 1023);
    const float* w = p.hy_conv_w + (size_t)layer * 3 * 768;
    const bf16_t* pr = p.proj + (size_t)row * INW + 1536 + c;
    float v = bf2f(pr[0]) * w[768 + c] + p.hy_conv_b[layer * 768 + c];
    if (t > 0) v += bf2f(pr[-INW]) * w[c];
    if (t < L - 1) v += bf2f(pr[INW]) * w[2 * 768 + c];
    p.hvc[idx] = v;
  }
}
__device__ void phase_hy2_naive(const Params& p, int layer, int order, int bid, int nb, char* smem) {
  float* sz = (float*)smem;
  float* sf = sz + 1024;
  float* sb = sf + 1024;
  const int tid = threadIdx.x;
  for (int u = bid; u < 18 * 256; u += nb) {
    int s = u >> 8, c = u & 255;
    int L = seq_len(s), row0 = seq_row0(s);
    int path = s >= 16;
    const float* fb = p.filt + (size_t)layer * FILT_L + (path ? 256 * 1024 : 0);
    const float* ff = fb + (size_t)((0 * 2 + order) * 256 + c) * L;
    const float* fbk = fb + (size_t)((1 * 2 + order) * 256 + c) * L;
    for (int t = tid; t < L; t += NT) {
      sz[t] = order == 0 ? p.hvc[(size_t)(row0 + t) * 768 + c] : p.z1[(size_t)(row0 + t) * 256 + c];
      sf[t] = ff[t]; sb[t] = fbk[t];
    }
    __syncthreads();
    for (int t = tid; t < L; t += NT) {
      float acc = 0.f;
      for (int sI = 0; sI <= t; sI++) acc += sf[t - sI] * sz[sI];
      for (int sI = t + 1; sI < L; sI++) acc += sb[sI - t] * sz[sI];
      float zt = sz[t];
      float r = acc + p.hy_bias[(layer * 2 + order) * 256 + c] * zt;
      if (order == 0) p.z1[(size_t)(row0 + t) * 256 + c] = p.hvc[(size_t)(row0 + t) * 768 + 256 + c] * r;
      else p.mixed[(size_t)(row0 + t) * D + 384 + c] = f2bf(p.hvc[(size_t)(row0 + t) * 768 + 512 + c] * r);
    }
    __syncthreads();
  }
}

__device__ void phase_ffn_act(const Params& p, int layer, int bid, int nb) {
  for (size_t idx = (size_t)bid * NT + threadIdx.x; idx < (size_t)T * (DFF / 4); idx += (size_t)nb * NT) {
    int row = (int)(idx / (DFF / 4)), f = (int)(idx % (DFF / 4)) * 4;
    int L = row < TC ? 256 : 1024;
    int t = row < TC ? (row & 255) : ((row - TC) & 1023);
    const bf16_t* ap = p.abuf + (size_t)row * DFF + f;
    const float* w = p.ffn_conv_w + (size_t)layer * 3 * DFF + f;
    uint2 a1 = *(const uint2*)ap;
    uint2 a0 = make_uint2(0, 0), a2 = make_uint2(0, 0);
    if (t > 0) a0 = *(const uint2*)(ap - DFF);
    if (t < L - 1) a2 = *(const uint2*)(ap + DFF);
    uint2 bb = *(const uint2*)(p.bbuf + (size_t)row * DFF + f);
    float o[4];
#pragma unroll
    for (int j = 0; j < 4; j++) {
      unsigned w0 = j < 2 ? a0.x : a0.y, w1 = j < 2 ? a1.x : a1.y, w2 = j < 2 ? a2.x : a2.y, wb = j < 2 ? bb.x : bb.y;
      int sft = (j & 1) * 16;
      float x0 = bf2f((bf16_t)(w0 >> sft)), x1 = bf2f((bf16_t)(w1 >> sft)), x2 = bf2f((bf16_t)(w2 >> sft)), bv = bf2f((bf16_t)(wb >> sft));
      float a = x0 * w[j] + x1 * w[DFF + j] + x2 * w[2 * DFF + j] + p.ffn_conv_b[layer * DFF + f + j];
      o[j] = gelu_tanh(a) * bv;
    }
    uint2 ov; ov.x = pack2(o[0], o[1]); ov.y = pack2(o[2], o[3]);
    *(uint2*)(p.ubuf + (size_t)row * DFF + f) = ov;
  }
}

enum { PH_TRANSPOSE = 0, PH_MOD, PH_ROPE, PH_FILT, PH_S0, PH_INPROJ, PH_RET, PH_ML, PH_RETST, PH_MLST, PH_HY1, PH_HY2A, PH_HY2B, PH_OUTPROJ, PH_S1, PH_UP, PH_ACT, PH_DOWN };

template <int ph>
__device__ __forceinline__ void run_phase(const Params& p, int layer, int bid, int nb, char* smem) {
  switch (ph) {
    case PH_TRANSPOSE: phase_transpose(p, bid, nb, smem); break;
    case PH_MOD: phase_mod(p, bid, nb, smem); break;
    case PH_ROPE: phase_rope(p, bid, nb); break;
    case PH_FILT: phase_filt(p, bid, nb, smem); break;
    case PH_S0: phase_rowpass(p, layer, 0, bid, nb); break;
    case PH_S1: phase_rowpass(p, layer, 1, bid, nb); break;
    case PH_INPROJ: {
      EpiProj e{p.proj, p.ktr, p.vtr, p.ktm, p.vtm, p.hyt, p.gates};
      phase_gemm<256, EpiProj>(p.hbuf, p.wt_in + (size_t)layer * INWP * D, T, INWP, D, bid, nb, smem, e);
    } break;
    case PH_RET: phase_mix_naive<false>(p, layer, bid, nb, smem); break;
    case PH_ML: phase_mix_naive<true>(p, layer, bid, nb, smem); break;
    case PH_RETST: phase_state_naive<false>(p, layer, bid, nb, smem); break;
    case PH_MLST: phase_state_naive<true>(p, layer, bid, nb, smem); break;
    case PH_HY1: phase_hy1_naive(p, layer, bid, nb); break;
    case PH_HY2A: phase_hy2_naive(p, layer, 0, bid, nb, smem); break;
    case PH_HY2B: phase_hy2_naive(p, layer, 1, bid, nb, smem); break;
    case PH_OUTPROJ: {
      EpiF32 e{p.raw, D};
      phase_gemm<192, EpiF32>(p.mixed, p.wt_out + (size_t)layer * D * D, T, D, D, bid, nb, smem, e);
    } break;
    case PH_UP: {
      EpiUp e{p.abuf, p.bbuf};
      phase_gemm<256, EpiUp>(p.hbuf, p.wt_up + (size_t)layer * 2 * DFF * D, T, 2 * DFF, D, bid, nb, smem, e);
    } break;
    case PH_ACT: phase_ffn_act(p, layer, bid, nb); break;
    case PH_DOWN: {
      EpiF32 e{p.raw, D};
      phase_gemm<192, EpiF32>(p.ubuf, p.wt_down + (size_t)layer * D * DFF, T, D, DFF, bid, nb, smem, e);
    } break;
  }
}

constexpr int SMEM_BYTES = 122880;
template <int PH>
__global__ void __launch_bounds__(NT) k_phase(Params p, int layer) {
  extern __shared__ __attribute__((aligned(16))) char smem[];
  run_phase<PH>(p, layer, blockIdx.x, gridDim.x, smem);
}

static inline size_t align_up(size_t x) { return (x + 255) & ~(size_t)255; }

extern "C" void kernel_launch(void* const* d_in, const int* in_sizes, int n_in, void* d_out, int out_size, void* d_ws, size_t ws_size, hipStream_t stream) {
  Params p{};
  const float* const* in = (const float* const*)d_in;
  p.x_prompt = in[0]; p.x_sample = in[1]; p.c = in[2]; p.state_ret = in[3]; p.state_c = in[4]; p.state_n = in[5]; p.state_m = in[6]; p.c_ctx = in[7];
  p.norm_mix_pre = in[8]; p.norm_mix_post = in[9]; p.norm_ffn_pre = in[10]; p.norm_ffn_post = in[11]; p.w_mod = in[12]; p.b_mod = in[13]; p.w_in = in[14]; p.w_out = in[15];
  p.ret_decay_logit = in[16]; p.ret_norm_g = in[17]; p.hy_conv_w = in[18]; p.hy_conv_b = in[19]; p.hy_f_w1 = in[20]; p.hy_f_b1 = in[21]; p.hy_f_w2 = in[22]; p.hy_f_b2 = in[23];
  p.hy_f_w3 = in[24]; p.hy_f_b3 = in[25]; p.hy_sin_freq = in[26]; p.hy_bias = in[27]; p.ml_gate_bias = in[28]; p.ml_norm_g = in[29];
  p.w_up = in[30]; p.ffn_conv_w = in[31]; p.ffn_conv_b = in[32]; p.w_down = in[33];
  p.out = (float*)d_out;
  char* w = (char*)d_ws; size_t off = 0;
  auto take = [&](size_t bytes) { char* r = w + off; off = align_up(off + bytes); return r; };
  p.wt_in = (bf16_t*)take((size_t)DEPTH * INWP * D * 2);
  p.wt_out = (bf16_t*)take((size_t)DEPTH * D * D * 2);
  p.wt_up = (bf16_t*)take((size_t)DEPTH * 2 * DFF * D * 2);
  p.wt_down = (bf16_t*)take((size_t)DEPTH * D * DFF * 2);
  p.mod = (float*)take((size_t)DEPTH * 3 * 6144 * 4);
  p.rope_cos = (float*)take(1024 * 48 * 4); p.rope_sin = (float*)take(1024 * 48 * 4);
  p.filt = (float*)take((size_t)DEPTH * FILT_L * 4);
  p.xbuf = (float*)take((size_t)T * D * 4); p.x1buf = (float*)take((size_t)T * D * 4); p.raw = (float*)take((size_t)T * D * 4);
  p.hbuf = (bf16_t*)take((size_t)T * D * 2);
  p.ubuf = (bf16_t*)take((size_t)T * DFF * 2);
  size_t arena = off;
  p.proj = (bf16_t*)take((size_t)T * INW * 2);
  p.ktr = (bf16_t*)take((size_t)384 * T * 2); p.vtr = (bf16_t*)take((size_t)384 * T * 2);
  p.ktm = (bf16_t*)take((size_t)384 * T * 2); p.vtm = (bf16_t*)take((size_t)384 * T * 2);
  p.hyt = (bf16_t*)take((size_t)768 * T * 2);
  p.mixed = (bf16_t*)take((size_t)T * D * 2);
  p.gates = (float*)take((size_t)T * 16 * 4);
  p.hvc = (float*)take((size_t)T * 768 * 4);
  p.z1 = (float*)take((size_t)T * 256 * 4);
  size_t endA = off;
  off = arena;
  p.abuf = (bf16_t*)take((size_t)T * DFF * 2 * 2);
  p.bbuf = p.abuf + (size_t)T * DFF;
  size_t endB = off;
  off = endA > endB ? endA : endB;
  if (off > ws_size) { fprintf(stderr, "workspace too small: need %zu have %zu\n", off, ws_size); return; }

  const int G = 1024;
  static bool attr_done = false;
#define SETATTR(ph) (void)hipFuncSetAttribute((const void*)k_phase<ph>, hipFuncAttributeMaxDynamicSharedMemorySize, SMEM_BYTES)
  if (!attr_done) {
    SETATTR(PH_TRANSPOSE); SETATTR(PH_MOD); SETATTR(PH_ROPE); SETATTR(PH_FILT); SETATTR(PH_S0); SETATTR(PH_INPROJ); SETATTR(PH_RET); SETATTR(PH_ML); SETATTR(PH_RETST);
    SETATTR(PH_MLST); SETATTR(PH_HY1); SETATTR(PH_HY2A); SETATTR(PH_HY2B); SETATTR(PH_OUTPROJ); SETATTR(PH_S1); SETATTR(PH_UP); SETATTR(PH_ACT); SETATTR(PH_DOWN);
    attr_done = true;
  }
#define launch(ph, layer, grid) hipLaunchKernelGGL(k_phase<ph>, dim3(grid), dim3(NT), SMEM_BYTES, stream, p, layer)
  launch(PH_TRANSPOSE, 0, G); launch(PH_MOD, 0, 192); launch(PH_ROPE, 0, 96); launch(PH_FILT, 0, 320);
  for (int l = 0; l < DEPTH; l++) {
    launch(PH_S0, l, 768);
    launch(PH_INPROJ, l, 768);
    launch(PH_RET, l, 768); launch(PH_ML, l, 768); launch(PH_RETST, l, 128); launch(PH_MLST, l, 128);
    launch(PH_HY1, l, G); launch(PH_HY2A, l, G); launch(PH_HY2B, l, G);
    launch(PH_OUTPROJ, l, 256);
    launch(PH_S1, l, 768);
    launch(PH_UP, l, 768);
    launch(PH_ACT, l, G);
    launch(PH_DOWN, l, 256);
  }
  launch(PH_S0, DEPTH, 768);
}
```

```cpp
#include <hip/hip_runtime.h>
#include <stdint.h>
#include <stdio.h>

#define NT 512
#define LAS __attribute__((address_space(3)))
constexpr int SMEM_BYTES = 147456;
typedef unsigned short bf16_t;
typedef short bf16x8 __attribute__((ext_vector_type(8)));
typedef float f32x4 __attribute__((ext_vector_type(4)));
typedef unsigned u32x4 __attribute__((ext_vector_type(4)));

constexpr int D = 1024, T = 6144, TC = 4096, DEPTH = 4;
constexpr int INW = 3856, INWP = 4096, DFF = 4096;
constexpr float EPS = 1e-6f;
constexpr size_t O_YP = 0, O_YS = 4194304, O_SR = 6291456, O_MC = 11010048, O_MN = 15728640, O_MM = 15777792;

#ifndef REP_MIX
#define REP_MIX 1
#endif
#ifndef REP_ELT
#define REP_ELT 1
#endif
#ifndef REP_BAR
#define REP_BAR 0
#endif
#ifndef REP_TR
#define REP_TR 1
#endif
#ifndef REP_MOD
#define REP_MOD 1
#endif
#ifndef REP_FILT
#define REP_FILT 1
#endif
#ifndef REP_STATE
#define REP_STATE 1
#endif
#ifndef REP_OUT
#define REP_OUT 1
#endif
#ifndef UP8
#define UP8 1
#endif
#ifndef USE_GLDS
#define USE_GLDS 1
#endif
#ifndef PROBE_KIND
#define PROBE_KIND 9
#endif
#ifndef REP_EPI
#define REP_EPI 1
#endif
#ifndef REP_G1
#define REP_G1 1
#endif
#ifndef REP_G2
#define REP_G2 1
#endif
#ifndef REP_G3
#define REP_G3 1
#endif
#ifndef REP_G4
#define REP_G4 1
#endif
#ifndef NAIVE_MIX
#define NAIVE_MIX 0
#endif
#ifndef NAIVE_GEMM
#define NAIVE_GEMM 0
#endif

struct Params {
  const float *x_prompt, *x_sample, *c, *state_ret, *state_c, *state_n, *state_m, *c_ctx;
  const float *norm_mix_pre, *norm_mix_post, *norm_ffn_pre, *norm_ffn_post, *w_mod, *b_mod, *w_in, *w_out;
  const float *ret_decay_logit, *ret_norm_g, *hy_conv_w, *hy_conv_b, *hy_f_w1, *hy_f_b1, *hy_f_w2, *hy_f_b2, *hy_f_w3, *hy_f_b3, *hy_sin_freq, *hy_bias, *ml_gate_bias, *ml_norm_g;
  const float *w_up, *ffn_conv_w, *ffn_conv_b, *w_down;
  float* out;
  bf16_t *wt_in, *wt_out, *wt_up, *wt_down;
  float *mod, *rope_cos, *rope_sin, *rope_cosT, *rope_sinT;
  float *xbuf, *x1buf, *raw;
  bf16_t *hbuf, *proj, *ktr, *vtr, *ktm, *vtm, *hyt, *mixed, *ubuf;
  float *gates;
  bf16_t* ft;
  unsigned* bar;
  unsigned long long* rstats;
  int fuse_rows; int pad_;
};

#define CONSTAS __attribute__((address_space(4)))
typedef const CONSTAS Params& PR;
__device__ __forceinline__ const CONSTAS Params* get_params() {
  const CONSTAS Params* pp = (const CONSTAS Params*)__builtin_amdgcn_kernarg_segment_ptr();
  asm volatile("" : "+s"(pp));
  return pp;
}
__device__ __forceinline__ int opaque_tid() { int t = threadIdx.x; asm volatile("" : "+v"(t)); return t; }
#define TIDX opaque_tid()

__device__ __forceinline__ unsigned cvt_pk_bf16(float lo, float hi) { unsigned r; asm("v_cvt_pk_bf16_f32 %0, %1, %2" : "=v"(r) : "v"(lo), "v"(hi)); return r; }
__device__ __forceinline__ bf16_t f2bf(float f) { return (bf16_t)(cvt_pk_bf16(f, 0.f) & 0xffffu); }
__device__ __forceinline__ float bf2f(bf16_t h) { return __uint_as_float(((unsigned)h) << 16); }
__device__ __forceinline__ float bflo(unsigned u) { return __uint_as_float(u << 16); }
__device__ __forceinline__ float bfhi(unsigned u) { return __uint_as_float(u & 0xffff0000u); }
__device__ __forceinline__ unsigned pack2(float a, float b) { return cvt_pk_bf16(a, b); }
__device__ __forceinline__ f32x4 zero4() { float z = 0.f; asm volatile("" : "+v"(z)); return (f32x4){z, z, z, z}; }
__device__ __forceinline__ float row16_sum(float v) {
  v += __int_as_float(__builtin_amdgcn_update_dpp(0, __float_as_int(v), 0xB1, 0xF, 0xF, false));
  v += __int_as_float(__builtin_amdgcn_update_dpp(0, __float_as_int(v), 0x4E, 0xF, 0xF, false));
  v += __int_as_float(__builtin_amdgcn_update_dpp(0, __float_as_int(v), 0x141, 0xF, 0xF, false));
  v += __int_as_float(__builtin_amdgcn_update_dpp(0, __float_as_int(v), 0x140, 0xF, 0xF, false));
  return v;
}
__device__ __forceinline__ float wave_sum(float v) {
  v = row16_sum(v);
  v += __shfl_xor(v, 16); v += __shfl_xor(v, 32);
  return v;
}
__device__ __forceinline__ float sigmoidf_(float x) { return __builtin_amdgcn_rcpf(1.f + __expf(-x)); }
__device__ __forceinline__ float log_sigmoidf_(float x) { return fminf(x, 0.f) - log1pf(__expf(-fabsf(x))); }
__device__ __forceinline__ float gelu_tanh(float x) {
  const float k = 0.7978845608028654f;
  float u = k * (x + 0.044715f * x * x * x);
  return 0.5f * x * (1.f + tanhf(u));
}
__device__ __forceinline__ int seq_len(int s) { return s < 16 ? 256 : 1024; }
__device__ __forceinline__ int seq_row0(int s) { return s < 16 ? s * 256 : TC + (s - 16) * 1024; }
__device__ __forceinline__ int row_mod(int row) { return row < TC ? 0 : 1 + ((row - TC) >> 10); }

template <class RowFn>
__device__ __forceinline__ void tr_batch(const float* __restrict__ src, int K, int N, int k0, int nt0, int cnt, bf16_t* __restrict__ dst, RowFn drow, float* lds) {
  const int tid = TIDX;
  float4 v[4][2];
#pragma unroll
  for (int b = 0; b < 4; b++)
#pragma unroll
    for (int i = 0; i < 2; i++) {
      const int k = (tid >> 4) + 32 * i, n = (nt0 + b) * 64 + (tid & 15) * 4;
      v[b][i] = make_float4(0.f, 0.f, 0.f, 0.f);
      if (b < cnt && n < N) { const f32x4 t_ = __builtin_nontemporal_load((const f32x4*)(src + (size_t)(k0 + k) * N + n)); v[b][i] = make_float4(t_[0], t_[1], t_[2], t_[3]); }
    }
  __syncthreads();
#pragma unroll
  for (int b = 0; b < 4; b++)
#pragma unroll
    for (int i = 0; i < 2; i++) {
      const int k = (tid >> 4) + 32 * i, n4 = (tid & 15) * 4;
      float* l = lds + b * 64 * 65;
      l[(n4 + 0) * 65 + k] = v[b][i].x; l[(n4 + 1) * 65 + k] = v[b][i].y; l[(n4 + 2) * 65 + k] = v[b][i].z; l[(n4 + 3) * 65 + k] = v[b][i].w;
    }
  __syncthreads();
#pragma unroll
  for (int b = 0; b < 4; b++) if (b < cnt) {
    const int n = tid >> 3, kc = (tid & 7) * 8;
    const float* r = lds + b * 64 * 65 + n * 65 + kc;
    uint4 o;
    o.x = pack2(r[0], r[1]); o.y = pack2(r[2], r[3]); o.z = pack2(r[4], r[5]); o.w = pack2(r[6], r[7]);
    __builtin_nontemporal_store((u32x4){o.x, o.y, o.z, o.w}, (u32x4*)(dst + (size_t)(drow(nt0 + b) + n) * K + k0 + kc));
  }
}

constexpr int TR_IN = 16 * 16, TR_OUT = 16 * 4, TR_UP = 16 * 32, TR_DN = 64 * 4, TR_L = TR_IN + TR_OUT + TR_UP + TR_DN;
__device__ __forceinline__ void phase_transpose(PR p, int bid, int nb, char* smem) {
  float* lds = (float*)smem;
  {
    const int u = bid;
    int l = u / TR_L, r = u % TR_L;
    if (r < TR_IN) {
      int kt = r >> 4, nb4 = r & 15;
      tr_batch(p.w_in + (size_t)l * D * INW, D, INW, kt * 64, nb4 * 4, 4, p.wt_in + (size_t)l * INWP * D, [](int nt) { return nt * 64; }, lds);
    } else if ((r -= TR_IN) < TR_OUT) {
      int kt = r >> 2, nb4 = r & 3;
      tr_batch(p.w_out + (size_t)l * D * D, D, D, kt * 64, nb4 * 4, 4, p.wt_out + (size_t)l * D * D, [](int nt) { return nt * 64; }, lds);
    } else if ((r -= TR_OUT) < TR_UP) {
      int kt = r >> 5, nb4 = r & 31;
      tr_batch(p.w_up + (size_t)l * D * 2 * DFF, D, 2 * DFF, kt * 64, nb4 * 4, 4, p.wt_up + (size_t)l * 2 * DFF * D, [](int nt) { return nt < 64 ? (nt >> 1) * 256 + (nt & 1) * 64 : ((nt - 64) >> 1) * 256 + 128 + (nt & 1) * 64; }, lds);
    } else {
      r -= TR_UP;
      int kt = r >> 2, nb4 = r & 3;
      tr_batch(p.w_down + (size_t)l * DFF * D, DFF, D, kt * 64, nb4 * 4, 4, p.wt_down + (size_t)l * D * DFF, [](int nt) { return nt * 64; }, lds);
    }
  }
}

__device__ __forceinline__ void phase_mod(PR p, int bid, int nb, char* smem) {
  float* sv = (float*)smem;
  float* red = sv + 3 * 1024;
  const int tid = TIDX, lane = tid & 63, wid = tid >> 6;
  for (int i = tid; i < 3 * 1024; i += NT) {
    int v = i >> 10, k = i & 1023;
    float x = v == 0 ? p.c_ctx[k] : p.c[(v - 1) * 1024 + k];
    sv[i] = x * sigmoidf_(x);
  }
  __syncthreads();
  {
    const int u = bid;
    int l = u / 48, cb = u % 48;
    int kg = wid * 2 + (lane >> 5), cl = lane & 31;
    const float* w = p.w_mod + (size_t)l * D * 6144 + cb * 128 + cl * 4;
    float acc[3][4] = {};
#pragma unroll 16
    for (int k = kg * 64; k < kg * 64 + 64; k++) {
      const f32x4 wv_ = __builtin_nontemporal_load((const f32x4*)(w + (size_t)k * 6144)); const float4 wv = make_float4(wv_[0], wv_[1], wv_[2], wv_[3]);
#pragma unroll
      for (int v = 0; v < 3; v++) {
        float s = sv[v * 1024 + k];
        acc[v][0] += s * wv.x; acc[v][1] += s * wv.y; acc[v][2] += s * wv.z; acc[v][3] += s * wv.w;
      }
    }
#pragma unroll
    for (int v = 0; v < 3; v++)
#pragma unroll
      for (int j = 0; j < 4; j++) red[(kg * 3 + v) * 128 + cl * 4 + j] = acc[v][j];
    __syncthreads();
    if (tid < 384) {
      int v = tid >> 7, cidx = tid & 127;
      float s = 0.f;
      for (int g = 0; g < 16; g++) s += red[(g * 3 + v) * 128 + cidx];
      int col = cb * 128 + cidx;
      p.mod[((size_t)l * 3 + v) * 6144 + col] = s + p.b_mod[(size_t)l * 6144 + col];
    }
    __syncthreads();
  }
}

__device__ __forceinline__ void phase_rope(PR p, int bid, int nb) {
  for (int i = bid * NT + TIDX; i < 1024 * 48; i += nb * NT) {
    int pos = i / 48, j = i % 48;
    int f = j < 24 ? j : j - 24;
    float base = j < 24 ? (float)(pos >> 6) : (float)(pos & 63);
    float freq = __builtin_amdgcn_exp2f(-(float)f * (13.287712379549449f / 24.f));
    float a = base * freq;
    float cv = cosf(a), sv = sinf(a);
    p.rope_cos[i] = cv; p.rope_sin[i] = sv; p.rope_cosT[j * 1024 + pos] = cv; p.rope_sinT[j * 1024 + pos] = sv;
  }
}

constexpr int FT_CTX_ = 2 * 256 * 2 * 512, FT_L_ = FT_CTX_ + 2 * 256 * 2 * 2048;
__device__ __forceinline__ void phase_filt(PR p, int bid, int nb, char* smem) {
  float* feat = (float*)smem;
  float* h1 = feat + 128 * 33;
  float* h2 = h1 + 128 * 64;
  float* w3s = h2 + 128 * 65;
  float* w1s = w3s + 64 * 128;
  float* w2s = w1s + 33 * 64;
  const int tid = TIDX, lane = tid & 63, wid = tid >> 6;
  {
    const int u = bid;
    const int l = u / 80, r = u % 80;
    const int path = r < 16 ? 0 : 1;
    const int Lp = path ? 1024 : 256;
    const int pb = path ? (r - 16) >> 3 : r >> 3, nblk = r & 7;
    const int pos0 = pb * 128;
    __syncthreads();
    for (int i = tid; i < 128 * 33; i += NT) {
      int pp = i / 33, j = i % 33;
      float tn = (float)(pos0 + pp) / (float)Lp;
      float v;
      if (j == 0) v = tn;
      else {
        int bi = (j - 1) & 15;
        float band = 1e-4f + (float)bi * ((15.f - 1e-4f) / 15.f);
        float ang = 6.283185307179586f * tn * band;
        v = j <= 16 ? cosf(ang) : sinf(ang);
      }
      feat[i] = v;
    }
    {
      float4 t3[4], t1[2], t2[2];
#pragma unroll
      for (int j = 0; j < 4; j++) { const int i4 = tid + j * NT, k = i4 >> 5, n4 = i4 & 31; t3[j] = *(const float4*)(p.hy_f_w3 + ((size_t)l * 64 + k) * 1024 + nblk * 128 + n4 * 4); }
#pragma unroll
      for (int j = 0; j < 2; j++) { const int i4 = tid + j * NT; t1[j] = i4 < 528 ? *(const float4*)(p.hy_f_w1 + (size_t)l * 33 * 64 + i4 * 4) : make_float4(0.f, 0.f, 0.f, 0.f); t2[j] = *(const float4*)(p.hy_f_w2 + (size_t)l * 64 * 64 + i4 * 4); }
#pragma unroll
      for (int j = 0; j < 4; j++) *(float4*)(w3s + (tid + j * NT) * 4) = t3[j];
#pragma unroll
      for (int j = 0; j < 2; j++) { const int i4 = tid + j * NT; if (i4 < 528) *(float4*)(w1s + i4 * 4) = t1[j]; *(float4*)(w2s + i4 * 4) = t2[j]; }
    }
    __syncthreads();
    {
      const int jq = tid & 15, pg = tid >> 4;
      float acc[4][4];
      {
        const float4 b1 = *(const float4*)(p.hy_f_b1 + l * 64 + 4 * jq);
#pragma unroll
        for (int pp = 0; pp < 4; pp++) { acc[pp][0] = b1.x; acc[pp][1] = b1.y; acc[pp][2] = b1.z; acc[pp][3] = b1.w; }
      }
#pragma unroll 3
      for (int k = 0; k < 33; k++) {
        const float4 w = *(const float4*)(w1s + k * 64 + 4 * jq);
#pragma unroll
        for (int pp = 0; pp < 4; pp++) { const float f = feat[(pg * 4 + pp) * 33 + k]; acc[pp][0] += f * w.x; acc[pp][1] += f * w.y; acc[pp][2] += f * w.z; acc[pp][3] += f * w.w; }
      }
      const float4 fr = *(const float4*)(p.hy_sin_freq + l * 64 + 4 * jq);
#pragma unroll
      for (int pp = 0; pp < 4; pp++)
        *(float4*)(h1 + (pg * 4 + pp) * 64 + 4 * jq) = make_float4(sinf(fr.x * acc[pp][0]), sinf(fr.y * acc[pp][1]), sinf(fr.z * acc[pp][2]), sinf(fr.w * acc[pp][3]));
    }
    __syncthreads();
    {
      const int jq = tid & 15, pg = tid >> 4;
      float acc[4][4];
      {
        const float4 b2 = *(const float4*)(p.hy_f_b2 + l * 64 + 4 * jq);
#pragma unroll
        for (int pp = 0; pp < 4; pp++) { acc[pp][0] = b2.x; acc[pp][1] = b2.y; acc[pp][2] = b2.z; acc[pp][3] = b2.w; }
      }
#pragma unroll 4
      for (int k = 0; k < 64; k++) {
        const float4 w = *(const float4*)(w2s + k * 64 + 4 * jq);
#pragma unroll
        for (int pp = 0; pp < 4; pp++) { const float f = h1[(pg * 4 + pp) * 64 + k]; acc[pp][0] += f * w.x; acc[pp][1] += f * w.y; acc[pp][2] += f * w.z; acc[pp][3] += f * w.w; }
      }
      const float4 fr = *(const float4*)(p.hy_sin_freq + l * 64 + 4 * jq);
#pragma unroll
      for (int pp = 0; pp < 4; pp++) {
        float* d = h2 + (pg * 4 + pp) * 65 + 4 * jq;
        d[0] = sinf(fr.x * acc[pp][0]); d[1] = sinf(fr.y * acc[pp][1]); d[2] = sinf(fr.z * acc[pp][2]); d[3] = sinf(fr.w * acc[pp][3]);
      }
    }
    __syncthreads();
    {
      const int pp = (wid & 1) * 64 + lane, ng = wid >> 1;
      float acc[32];
#pragma unroll
      for (int j = 0; j < 32; j++) acc[j] = 0.f;
#pragma unroll 2
      for (int k = 0; k < 64; k++) {
        const float hv = h2[pp * 65 + k];
        const float4* wr = (const float4*)(w3s + k * 128 + ng * 32);
#pragma unroll
        for (int j4 = 0; j4 < 8; j4++) { const float4 w = wr[j4]; acc[j4 * 4 + 0] += hv * w.x; acc[j4 * 4 + 1] += hv * w.y; acc[j4 * 4 + 2] += hv * w.z; acc[j4 * 4 + 3] += hv * w.w; }
      }
      const int pos = pos0 + pp;
      const float tn = (float)pos / (float)Lp;
      const float lo = logf(0.01f) / 1.5f, hi = logf(0.01f) / 0.3f;
      bf16_t* ftb = p.ft + (size_t)l * FT_L_ + (path ? FT_CTX_ : 0);
#pragma unroll
      for (int j = 0; j < 32; j++) {
        const int n = nblk * 128 + ng * 32 + j;
        const int ch = n & 255, fdir = n >> 9, ford = (n >> 8) & 1;
        const float delta = fabsf(lo + (hi - lo) * (float)ch / 255.f);
        const float v = (acc[j] + p.hy_f_b3[l * 1024 + n]) * (__expf(-tn * delta) + 0.05f);
        bf16_t* ftc = ftb + (size_t)((ford * 256 + ch) * 2) * 2 * Lp;
        if (fdir == 0 || pos > 0) {
          const int uu = fdir == 0 ? Lp - pos : Lp + pos;
          const bf16_t bv = f2bf(v);
          ftc[uu] = bv; ftc[2 * Lp + uu - 1] = bv;
        }
        if (fdir == 0 && pos == 0) { ftc[0] = 0; ftc[2 * Lp + 2 * Lp - 1] = 0; }
      }
    }
  }
}

__device__ __forceinline__ void phase_rowpass(PR p, int layer, int which, int bid, int nb) {
  const int lane = TIDX & 63, wid = TIDX >> 6;
  if (which == 0 && layer == 0 && nb * 8 * 3 == T) {
    f32x4 x[3][4];
#pragma unroll
    for (int k = 0; k < 3; k++) {
      const int row = bid * 8 + wid + k * nb * 8;
      const float* xs = row < TC ? p.x_prompt + (size_t)row * D : p.x_sample + (size_t)(row - TC) * D;
#pragma unroll
      for (int i = 0; i < 4; i++) x[k][i] = __builtin_nontemporal_load((const f32x4*)(xs + lane * 4 + 256 * i));
    }
    const float* gpre = p.norm_mix_pre;
#pragma unroll
    for (int k = 0; k < 3; k++) {
      const int row = bid * 8 + wid + k * nb * 8;
      const float* sh = p.mod + (size_t)row_mod(row) * 6144; const float* sc = sh + 1024;
      float ss = 0.f;
#pragma unroll
      for (int i = 0; i < 4; i++) { *(f32x4*)(p.xbuf + (size_t)row * D + lane * 4 + 256 * i) = x[k][i]; ss += x[k][i][0] * x[k][i][0] + x[k][i][1] * x[k][i][1] + x[k][i][2] * x[k][i][2] + x[k][i][3] * x[k][i][3]; }
      ss = wave_sum(ss);
      const float rs = rsqrtf(ss * (1.f / 1024.f) + EPS);
#pragma unroll
      for (int i = 0; i < 4; i++) {
        const int e = lane * 4 + 256 * i;
        const float4 g = *(const float4*)(gpre + e), s1 = *(const float4*)(sc + e), s0 = *(const float4*)(sh + e);
        uint2 o;
        o.x = pack2(x[k][i][0] * rs * g.x * (1.f + s1.x) + s0.x, x[k][i][1] * rs * g.y * (1.f + s1.y) + s0.y);
        o.y = pack2(x[k][i][2] * rs * g.z * (1.f + s1.z) + s0.z, x[k][i][3] * rs * g.w * (1.f + s1.w) + s0.w);
        *(uint2*)(p.hbuf + (size_t)row * D + e) = o;
      }
    }
    return;
  }
  for (int row = bid * 8 + wid; row < T; row += nb * 8) {
    const int mi = row_mod(row);
    const float* xs;
    const float* gate = nullptr; const float* gpost = nullptr;
    float* xd; bf16_t* hd = nullptr; const float *gpre = nullptr, *sc = nullptr, *sh = nullptr;
    bool has_raw;
    if (which == 0) {
      if (layer == 0) { xs = row < TC ? p.x_prompt + (size_t)row * D : p.x_sample + (size_t)(row - TC) * D; has_raw = false; }
      else { xs = p.x1buf + (size_t)row * D; has_raw = true; gate = p.mod + ((size_t)(layer - 1) * 3 + mi) * 6144 + 5 * 1024; gpost = p.norm_ffn_post + (layer - 1) * D; }
      if (layer < DEPTH) { xd = p.xbuf + (size_t)row * D; hd = p.hbuf + (size_t)row * D; gpre = p.norm_mix_pre + layer * D;
        sh = p.mod + ((size_t)layer * 3 + mi) * 6144; sc = sh + 1024; }
      else xd = p.out + (size_t)row * D;
    } else {
      xs = p.xbuf + (size_t)row * D; has_raw = true; gate = p.mod + ((size_t)layer * 3 + mi) * 6144 + 2 * 1024; gpost = p.norm_mix_post + layer * D;
      xd = p.x1buf + (size_t)row * D; hd = p.hbuf + (size_t)row * D; gpre = p.norm_ffn_pre + layer * D;
      sh = p.mod + ((size_t)layer * 3 + mi) * 6144 + 3 * 1024; sc = sh + 1024;
    }
    float4 x[4];
#pragma unroll
    for (int i = 0; i < 4; i++) x[i] = *(const float4*)(xs + lane * 4 + 256 * i);
    if (has_raw) {
      float4 r[4]; float ss = 0.f;
      const float* rp = p.raw + (size_t)row * D;
#pragma unroll
      for (int i = 0; i < 4; i++) { r[i] = *(const float4*)(rp + lane * 4 + 256 * i); ss += r[i].x * r[i].x + r[i].y * r[i].y + r[i].z * r[i].z + r[i].w * r[i].w; }
      ss = wave_sum(ss);
      float rs = rsqrtf(ss * (1.f / 1024.f) + EPS);
#pragma unroll
      for (int i = 0; i < 4; i++) {
        float4 g = *(const float4*)(gate + lane * 4 + 256 * i), gp = *(const float4*)(gpost + lane * 4 + 256 * i);
        x[i].x += g.x * gp.x * r[i].x * rs; x[i].y += g.y * gp.y * r[i].y * rs; x[i].z += g.z * gp.z * r[i].z * rs; x[i].w += g.w * gp.w * r[i].w * rs;
      }
    }
#pragma unroll
    for (int i = 0; i < 4; i++) *(float4*)(xd + lane * 4 + 256 * i) = x[i];
    if (hd) {
      float ss = 0.f;
#pragma unroll
      for (int i = 0; i < 4; i++) ss += x[i].x * x[i].x + x[i].y * x[i].y + x[i].z * x[i].z + x[i].w * x[i].w;
      ss = wave_sum(ss);
      float rs = rsqrtf(ss * (1.f / 1024.f) + EPS);
#pragma unroll
      for (int i = 0; i < 4; i++) {
        int e = lane * 4 + 256 * i;
        float4 g = *(const float4*)(gpre + e), s1 = *(const float4*)(sc + e), s0 = *(const float4*)(sh + e);
        float h0 = x[i].x * rs * g.x * (1.f + s1.x) + s0.x, h1 = x[i].y * rs * g.y * (1.f + s1.y) + s0.y;
        float h2 = x[i].z * rs * g.z * (1.f + s1.z) + s0.z, h3 = x[i].w * rs * g.w * (1.f + s1.w) + s0.w;
        uint2 o; o.x = pack2(h0, h1); o.y = pack2(h2, h3);
        *(uint2*)(hd + e) = o;
      }
    }
  }
}

struct EpiProj {
  bf16_t *proj, *ktr, *vtr, *ktm, *vtm, *hyt; float* gates;
  __device__ __forceinline__ void operator()(int row, int col, f32x4 v) const {
    if (col >= INW) return;
    uint2 o; o.x = pack2(v[0], v[1]); o.y = pack2(v[2], v[3]);
    *(uint2*)(proj + (size_t)row * INW + col) = o;
    bf16_t* tp = nullptr; int tc = 0;
    if (col >= 384 && col < 768) { tp = ktr; tc = col - 384; }
    else if (col >= 768 && col < 1152) { tp = vtr; tc = col - 768; }
    else if (col >= 1536 && col < 2304) { tp = hyt; tc = col - 1536; }
    else if (col >= 2688 && col < 3072) { tp = ktm; tc = col - 2688; }
    else if (col >= 3072 && col < 3456) { tp = vtm; tc = col - 3072; }
    if (tp) {
#pragma unroll
      for (int r = 0; r < 4; r++) tp[(size_t)(tc + r) * T + row] = f2bf(v[r]);
    }
    if (col >= 3840) *(float4*)(gates + (size_t)row * 16 + (col - 3840)) = make_float4(v[0], v[1], v[2], v[3]);
  }
};
struct EpiF32 {
  float* out; int ld;
  __device__ __forceinline__ void operator()(int row, int col, f32x4 v) const {
    *(float4*)(out + (size_t)row * ld + col) = make_float4(v[0], v[1], v[2], v[3]);
  }
};
struct EpiRow {
  const float* x; float* xo; bf16_t* ho;
  const float* modl; int goff; const float* gpost;
  const float* modn; int shoff; const float* gpre;
  unsigned long long* gran; unsigned epoch; unsigned* tmo;
  __device__ __forceinline__ void operator()(int, int, f32x4) const {}
};
template <class E> struct epi_proj { static constexpr bool value = false; };
template <> struct epi_proj<EpiProj> { static constexpr bool value = true; };
template <class E> struct epi_row { static constexpr bool value = false; };
template <> struct epi_row<EpiRow> { static constexpr bool value = true; };
struct EpiUp {
  static constexpr bool kFused = true;
  bf16_t* u; const bf16_t* h; const bf16_t* wt; const float* cw; const float* cb;
  __device__ __forceinline__ void operator()(int, int, f32x4) const {}
};
template <class E> struct epi_fused { static constexpr bool value = false; };
template <> struct epi_fused<EpiUp> { static constexpr bool value = true; };

typedef unsigned u32x2 __attribute__((ext_vector_type(2)));
typedef float f32x2 __attribute__((ext_vector_type(2)));
typedef __bf16 bf16x2_t __attribute__((ext_vector_type(2)));
#ifndef WT_AUX
#define WT_AUX 16
#endif
template <int BM, int BN, int GL, class Epi>
__device__ __forceinline__ void gemm_tiles(const bf16_t* __restrict__ A, const bf16_t* __restrict__ Bt, int M, int N, int K, int bid, int nb, char* smem, const Epi& epi) {
  constexpr int MT = BM / 64, NTW = BN / 32;
  constexpr int ACH = BM * 8 / NT, BCH = BN * 8 / NT;
  constexpr int ABYTES = BM * 128, BBYTES = BN * 128, STAGE = ABYTES + BBYTES;
  const int nm = M / BM, nn = N / BN;
  const int tid = TIDX, lane = tid & 63, wid = tid >> 6;
  const int wm = wid >> 1, wn = wid & 1;
  const int lr = lane & 15, lg = lane >> 4;
  u32x4 ra[ACH], rb[BCH];
  const unsigned voff = (unsigned)(((tid >> 3) * K + (tid & 7) * 8) * 2);
  const unsigned soff = (unsigned)((tid >> 3) * 128 + (((tid & 7) ^ ((tid >> 3) & 7)) << 4));
#define GLOAD(Ab, Bb) { \
    _Pragma("unroll") for (int i = 0; i < ACH; i++) ra[i] = *(const u32x4*)((const char*)((Ab) + (size_t)i * 64 * K) + voff); \
    _Pragma("unroll") for (int i = 0; i < BCH; i++) rb[i] = *(const u32x4*)((const char*)((Bb) + (size_t)i * 64 * K) + voff); }
#define SWRITE(buf) { char* sa_ = smem + (buf) * STAGE + soff; char* sb_ = sa_ + ABYTES; \
    _Pragma("unroll") for (int i = 0; i < ACH; i++) *(u32x4*)(sa_ + i * 8192) = ra[i]; \
    _Pragma("unroll") for (int i = 0; i < BCH; i++) *(u32x4*)(sb_ + i * 8192) = rb[i]; }
  const unsigned goff = (unsigned)(((tid >> 3) * K + (((tid & 7) ^ ((tid >> 3) & 7)) * 8)) * 2);
  const int wu = __builtin_amdgcn_readfirstlane(wid);
#define GLDS(buf, Ab, Bb) { \
    _Pragma("unroll") for (int i = 0; i < ACH; i++) __builtin_amdgcn_global_load_lds((const unsigned*)((const char*)((Ab) + (size_t)i * 64 * K) + goff), (LAS unsigned*)(smem + (buf) * STAGE + i * 8192 + wu * 1024), 16, 0, 0); \
    _Pragma("unroll") for (int i = 0; i < BCH; i++) __builtin_amdgcn_global_load_lds((const unsigned*)((const char*)((Bb) + (size_t)i * 64 * K) + goff), (LAS unsigned*)(smem + (buf) * STAGE + ABYTES + i * 8192 + wu * 1024), 16, 0, 0); }
#define GWAIT() { asm volatile("s_waitcnt vmcnt(0)" ::: "memory"); __syncthreads(); }
  const unsigned offA0 = (unsigned)((wm * (BM / 4) + lr) * 128 + ((lg ^ (lr & 7)) << 4));
  const unsigned offB0 = (unsigned)(ABYTES + (wn * (BN / 2) + lr) * 128 + ((lg ^ (lr & 7)) << 4));
  const int grp = bid & 7, jg = bid >> 3, ng = (nb + 7 - grp) >> 3;
  const int mpg = nm >> 3, tpg = mpg * nn;
  if (jg >= tpg) return;
#define TILE_M0(q) ((grp * mpg + (q) % mpg) * BM)
#define TILE_N0(q) (((q) / mpg) * BN)
  {
    const bf16_t* Ab = A + (size_t)TILE_M0(jg) * K; const bf16_t* Bb = Bt + (size_t)TILE_N0(jg) * K;
    if constexpr (GL == 2) {
    } else if constexpr (GL == 1) {
      __syncthreads();
      GLDS(0, Ab, Bb);
      GWAIT();
    } else {
      GLOAD(Ab, Bb);
      __syncthreads();
      SWRITE(0);
      GLOAD(Ab + 64, Bb + 64);
      __syncthreads();
    }
  }
  const int nk = K / 64;
  for (int q = jg; q < tpg; q += ng) {
    const int m0 = TILE_M0(q), n0 = TILE_N0(q);
    const int q2 = q + ng; const bool hn = q2 < tpg;
    const bf16_t* Ab = A + (size_t)m0 * K;
    const bf16_t* Bb = Bt + (size_t)n0 * K;
    const bf16_t* Abn = hn ? A + (size_t)TILE_M0(q2) * K : Ab;
    const bf16_t* Bbn = hn ? Bt + (size_t)TILE_N0(q2) * K : Bb;
    f32x4 acc[MT][NTW];
#pragma unroll
    for (int i = 0; i < MT; i++)
#pragma unroll
      for (int j = 0; j < NTW; j++) acc[i][j] = zero4();
    auto compute = [&](int buf) {
      const char* sa = smem + buf * STAGE;
#pragma unroll
      for (int ks = 0; ks < 2; ks++) {
        bf16x8 af[MT], bfr[NTW];
#pragma unroll
        for (int mi = 0; mi < MT; mi++) af[mi] = *(const bf16x8*)(sa + (offA0 ^ (ks << 6)) + mi * 2048);
#pragma unroll
        for (int ni = 0; ni < NTW; ni++) bfr[ni] = *(const bf16x8*)(sa + (offB0 ^ (ks << 6)) + ni * 2048);
        __builtin_amdgcn_sched_barrier(0);
#pragma unroll
        for (int ni = 0; ni < NTW; ni++)
#pragma unroll
          for (int mi = 0; mi < MT; mi++) acc[mi][ni] = __builtin_amdgcn_mfma_f32_16x16x32_bf16(bfr[ni], af[mi], acc[mi][ni], 0, 0, 0);
        __builtin_amdgcn_sched_barrier(0);
      }
    };
    f32x4 xv[epi_row<Epi>::value ? MT : 1][epi_row<Epi>::value ? NTW : 1];
    float* tabG = (float*)(smem + 3 * STAGE); float* tabP = tabG + 384; float* tabS = tabP + 384;
    if constexpr (epi_row<Epi>::value) {
      static_assert(3 * STAGE + 3 * 384 * 4 <= SMEM_BYTES - 64, "row tables");
      if (tid < 384) {
        const int v = tid >> 7, col = n0 + (tid & 127);
        tabG[tid] = epi.modl[v * 6144 + epi.goff + col] * epi.gpost[col];
        if (epi.ho) { tabP[tid] = epi.gpre[col] * (1.f + epi.modn[v * 6144 + epi.shoff + 1024 + col]); tabS[tid] = epi.modn[v * 6144 + epi.shoff + col]; }
      }
    }
    auto row_preload = [&]() {
      if constexpr (epi_row<Epi>::value) {
#pragma unroll
        for (int mi = 0; mi < MT; mi++) {
          const int row = m0 + wm * 48 + mi * 16 + lr;
#pragma unroll
          for (int ni = 0; ni < NTW; ni++) {
            const int col = n0 + wn * 64 + ni * 16 + lg * 4;
            xv[mi][ni] = __builtin_nontemporal_load((const f32x4*)(epi.x + (size_t)row * D + col));
          }
        }
      }
    };
    if constexpr (GL != 2) row_preload();
    if constexpr (GL == 2) {
      static_assert(3 * STAGE <= SMEM_BYTES - 64, "ring");
      constexpr int PL = ACH + BCH;
      __syncthreads();
      GLDS(0, Ab, Bb);
      GLDS(1, Ab + 64, Bb + 64);
      asm volatile("s_waitcnt vmcnt(%0)" :: "n"(PL) : "memory");
      __builtin_amdgcn_s_barrier();
      int cur = 0, nx2 = 2;
      const int ksplit = nk > 8 ? nk - 8 : 0;
#pragma unroll 1
      for (int kt = 0; kt < ksplit; kt++) {
        GLDS(nx2, Ab + (kt + 2) * 64, Bb + (kt + 2) * 64);
        __builtin_amdgcn_sched_barrier(0);
        compute(cur);
        __builtin_amdgcn_sched_barrier(0);
        asm volatile("s_waitcnt vmcnt(%0)" :: "n"(PL) : "memory");
        asm volatile("s_waitcnt lgkmcnt(0)" ::: "memory");
        __builtin_amdgcn_s_barrier();
        cur = cur == 2 ? 0 : cur + 1; nx2 = nx2 == 2 ? 0 : nx2 + 1;
      }
      row_preload();
#pragma unroll 1
      for (int kt = ksplit; kt < nk; kt++) {
        if (kt + 2 < nk) GLDS(nx2, Ab + (kt + 2) * 64, Bb + (kt + 2) * 64);
        __builtin_amdgcn_sched_barrier(0);
        compute(cur);
        __builtin_amdgcn_sched_barrier(0);
        if (kt + 2 < nk) asm volatile("s_waitcnt vmcnt(%0)" :: "n"(PL) : "memory");
        else asm volatile("s_waitcnt vmcnt(0)" ::: "memory");
        asm volatile("s_waitcnt lgkmcnt(0)" ::: "memory");
        __builtin_amdgcn_s_barrier();
        cur = cur == 2 ? 0 : cur + 1; nx2 = nx2 == 2 ? 0 : nx2 + 1;
      }
    } else if constexpr (GL == 1) {
      for (int kt = 0; kt < nk; kt += 2) {
        GLDS(1, Ab + (kt + 1) * 64, Bb + (kt + 1) * 64);
        __builtin_amdgcn_sched_barrier(0);
        compute(0);
        __builtin_amdgcn_sched_barrier(0);
        GWAIT();
        { const bool in = kt + 2 < nk; GLDS(0, in ? Ab + (kt + 2) * 64 : Abn, in ? Bb + (kt + 2) * 64 : Bbn); }
        __builtin_amdgcn_sched_barrier(0);
        compute(1);
        __builtin_amdgcn_sched_barrier(0);
        GWAIT();
      }
    } else
    for (int kt = 0; kt < nk; kt += 2) {
      SWRITE(1);
      { const bool in = kt + 2 < nk; GLOAD(in ? Ab + (kt + 2) * 64 : Abn, in ? Bb + (kt + 2) * 64 : Bbn); }
      __builtin_amdgcn_sched_barrier(0);
      compute(0);
      __builtin_amdgcn_sched_barrier(0);
      __syncthreads();
      SWRITE(0);
      { const bool in = kt + 3 < nk; GLOAD(in ? Ab + (kt + 3) * 64 : Abn + 64, in ? Bb + (kt + 3) * 64 : Bbn + 64); }
      __builtin_amdgcn_sched_barrier(0);
      compute(1);
      __builtin_amdgcn_sched_barrier(0);
      __syncthreads();
    }
    if constexpr (epi_row<Epi>::value) {
      static_assert(BM == 192 && BN == 128, "row-fused epilogue geometry");
      float* sst = (float*)(smem + STAGE);
      float* srr = sst + 2 * 192 * 4;
      const int mt = m0 / 192, ntile = n0 >> 7;
#pragma unroll
      for (int mi = 0; mi < MT; mi++) {
        const int mrow = row_mod(m0 + wm * 48 + mi * 16 + lr);
        float sA = 0.f, sB = 0.f, sC = 0.f, sD = 0.f;
#pragma unroll
        for (int ni = 0; ni < NTW; ni++) {
          const float4 g4 = *(const float4*)(tabG + mrow * 128 + wn * 64 + ni * 16 + lg * 4);
          const float gg[4] = {g4.x, g4.y, g4.z, g4.w};
#pragma unroll
          for (int r = 0; r < 4; r++) {
            const float raw = acc[mi][ni][r], gr = gg[r] * raw, xx = xv[mi][ni][r];
            sA += raw * raw; sB += xx * gr; sC += gr * gr; sD += xx * xx;
          }
        }
        sA += __shfl_xor(sA, 16); sA += __shfl_xor(sA, 32); sB += __shfl_xor(sB, 16); sB += __shfl_xor(sB, 32);
        sC += __shfl_xor(sC, 16); sC += __shfl_xor(sC, 32); sD += __shfl_xor(sD, 16); sD += __shfl_xor(sD, 32);
        if (lg == 0) *(float4*)(sst + (wn * 192 + wm * 48 + mi * 16 + lr) * 4) = make_float4(sA, sB, sC, sD);
      }
      __syncthreads();
      if (tid < 192) {
        unsigned long long* gbase = epi.gran + (size_t)mt * 8 * 4 * 192 + tid;
        const unsigned long long tag = (unsigned long long)epi.epoch << 32;
        {
          const float4 a = *(const float4*)(sst + tid * 4), b = *(const float4*)(sst + (192 + tid) * 4);
          unsigned long long* g = gbase + (size_t)ntile * 4 * 192;
          __hip_atomic_store(g + 0 * 192, tag | __float_as_uint(a.x + b.x), __ATOMIC_RELAXED, __HIP_MEMORY_SCOPE_AGENT);
          __hip_atomic_store(g + 1 * 192, tag | __float_as_uint(a.y + b.y), __ATOMIC_RELAXED, __HIP_MEMORY_SCOPE_AGENT);
          __hip_atomic_store(g + 2 * 192, tag | __float_as_uint(a.z + b.z), __ATOMIC_RELAXED, __HIP_MEMORY_SCOPE_AGENT);
          __hip_atomic_store(g + 3 * 192, tag | __float_as_uint(a.w + b.w), __ATOMIC_RELAXED, __HIP_MEMORY_SCOPE_AGENT);
        }
        float tA = 0.f, tB = 0.f, tC = 0.f, tD = 0.f;
        for (unsigned spins = 0;;) {
          bool ok = true; float q0 = 0.f, q1 = 0.f, q2 = 0.f, q3 = 0.f;
#pragma unroll 2
          for (int t = 0; t < 8; t++) {
            const unsigned long long w0 = __hip_atomic_load(gbase + (size_t)(t * 4 + 0) * 192, __ATOMIC_RELAXED, __HIP_MEMORY_SCOPE_AGENT);
            const unsigned long long w1 = __hip_atomic_load(gbase + (size_t)(t * 4 + 1) * 192, __ATOMIC_RELAXED, __HIP_MEMORY_SCOPE_AGENT);
            const unsigned long long w2 = __hip_atomic_load(gbase + (size_t)(t * 4 + 2) * 192, __ATOMIC_RELAXED, __HIP_MEMORY_SCOPE_AGENT);
            const unsigned long long w3 = __hip_atomic_load(gbase + (size_t)(t * 4 + 3) * 192, __ATOMIC_RELAXED, __HIP_MEMORY_SCOPE_AGENT);
            ok = ok && (unsigned)(w0 >> 32) == epi.epoch && (unsigned)(w1 >> 32) == epi.epoch && (unsigned)(w2 >> 32) == epi.epoch && (unsigned)(w3 >> 32) == epi.epoch;
            q0 += __uint_as_float((unsigned)w0); q1 += __uint_as_float((unsigned)w1); q2 += __uint_as_float((unsigned)w2); q3 += __uint_as_float((unsigned)w3);
          }
          if (ok) { tA = q0; tB = q1; tC = q2; tD = q3; break; }
          if (++spins > (1u << 18)) { __hip_atomic_store(epi.tmo, 1u, __ATOMIC_RELAXED, __HIP_MEMORY_SCOPE_AGENT); break; }
          __builtin_amdgcn_s_sleep(1);
        }
        const float r1 = rsqrtf(tA * (1.f / 1024.f) + EPS);
        const float ss = tD + 2.f * r1 * tB + r1 * r1 * tC;
        srr[tid * 2] = r1; srr[tid * 2 + 1] = rsqrtf(fmaxf(ss, 0.f) * (1.f / 1024.f) + EPS);
      }
      __syncthreads();
      const auto rsXo = __builtin_amdgcn_make_buffer_rsrc((void*)epi.xo, 0, 0x7fffffff, 0x00020000);
      const auto rsHo = __builtin_amdgcn_make_buffer_rsrc((void*)epi.ho, 0, 0x7fffffff, 0x00020000);
#pragma unroll
      for (int mi = 0; mi < MT; mi++) {
        const int rl = wm * 48 + mi * 16 + lr, row = m0 + rl;
        const int mrow = row_mod(row);
        const float r1 = srr[rl * 2], r2 = srr[rl * 2 + 1];
#pragma unroll
        for (int ni = 0; ni < NTW; ni++) {
          const int cl = wn * 64 + ni * 16 + lg * 4, col = n0 + cl;
          const float4 g4 = *(const float4*)(tabG + mrow * 128 + cl);
          const float gg[4] = {g4.x, g4.y, g4.z, g4.w};
          f32x4 xo;
#pragma unroll
          for (int r = 0; r < 4; r++) xo[r] = xv[mi][ni][r] + gg[r] * acc[mi][ni][r] * r1;
          __builtin_amdgcn_raw_buffer_store_b128((u32x4){__float_as_uint(xo[0]), __float_as_uint(xo[1]), __float_as_uint(xo[2]), __float_as_uint(xo[3])}, rsXo, (unsigned)((row * D + col) * 4), 0, WT_AUX);
          if (epi.ho) {
            const float4 pp = *(const float4*)(tabP + mrow * 128 + cl), s0 = *(const float4*)(tabS + mrow * 128 + cl);
            uint2 o;
            o.x = pack2(xo[0] * r2 * pp.x + s0.x, xo[1] * r2 * pp.y + s0.y);
            o.y = pack2(xo[2] * r2 * pp.z + s0.z, xo[3] * r2 * pp.w + s0.w);
            __builtin_amdgcn_raw_buffer_store_b64((u32x2){o.x, o.y}, rsHo, (unsigned)((row * D + col) * 2), 0, WT_AUX);
          }
        }
      }
    } else
    if constexpr (epi_fused<Epi>::value) {
     constexpr int UP_LA = STAGE, UP_LB = UP_LA + 258 * 144;
     static_assert(UP_LB + 256 * 144 <= SMEM_BYTES - 32, "fused epilogue images");
#pragma unroll
     for (int ph = 0; ph < NTW / 4; ph++) {
      {
        char* base = smem + (wn == 0 ? UP_LA + 144 : UP_LB);
#pragma unroll
        for (int mi = 0; mi < MT; mi++)
#pragma unroll
          for (int ni = 0; ni < 4; ni++) {
            const int r = wm * (BM / 4) + mi * 16 + lr, cidx = ni * 16 + lg * 4;
            uint2 o; o.x = pack2(acc[mi][ph * 4 + ni][0], acc[mi][ph * 4 + ni][1]); o.y = pack2(acc[mi][ph * 4 + ni][2], acc[mi][ph * 4 + ni][3]);
            *(uint2*)(base + r * 144 + cidx * 2) = o;
          }
      }
      {
        const int pos0 = m0 >= TC ? ((m0 - TC) & 1023) : 0;
        const bool top = m0 >= TC && pos0 != 0, bot = m0 >= TC && pos0 + BM != 1024;
        if (top || bot) {
          unsigned z0_ = 0u; asm volatile("" : "+v"(z0_)); uint4 ht0 = make_uint4(z0_, z0_, z0_, z0_), ht1 = ht0, hb0 = ht0, hb1 = ht0;
          if (top) { const bf16_t* hr = epi.h + (size_t)(m0 - 1) * K + lane * 8; ht0 = *(const uint4*)hr; ht1 = *(const uint4*)(hr + 512); }
          if (bot) { const bf16_t* hr = epi.h + (size_t)(m0 + BM) * K + lane * 8; hb0 = *(const uint4*)hr; hb1 = *(const uint4*)(hr + 512); }
#define DOT8(a, b) (bflo(a.x) * bflo(b.x) + bfhi(a.x) * bfhi(b.x) + bflo(a.y) * bflo(b.y) + bfhi(a.y) * bfhi(b.y) + bflo(a.z) * bflo(b.z) + bfhi(a.z) * bfhi(b.z) + bflo(a.w) * bflo(b.w) + bfhi(a.w) * bfhi(b.w))
#pragma unroll 1
          for (int fb = 0; fb < 2; fb++) {
            uint4 w0[4], w1[4];
#pragma unroll
            for (int fi = 0; fi < 4; fi++) { const bf16_t* wr = epi.wt + (size_t)(n0 + ph * 64 + wid * 8 + fb * 4 + fi) * K + lane * 8; w0[fi] = *(const uint4*)wr; w1[fi] = *(const uint4*)(wr + 512); }
#pragma unroll
            for (int fi = 0; fi < 4; fi++) {
              float st = DOT8(ht0, w0[fi]) + DOT8(ht1, w1[fi]), sb = DOT8(hb0, w0[fi]) + DOT8(hb1, w1[fi]);
              st = wave_sum(st); sb = wave_sum(sb);
              const int f = wid * 8 + fb * 4 + fi;
              if (lane == 0) { *(bf16_t*)(smem + UP_LA + f * 2) = f2bf(st); *(bf16_t*)(smem + UP_LA + 257 * 144 + f * 2) = f2bf(sb); }
            }
          }
#undef DOT8
        } else if (tid < 128) {
          *(bf16_t*)(smem + UP_LA + (tid >> 6) * 257 * 144 + (tid & 63) * 2) = 0;
        }
      }
      __syncthreads();
      {
        const int fc = tid & 7, f0 = (n0 >> 1) + ph * 64 + fc * 8;
        float w0[8], w1[8], w2[8], bb[8];
        {
          const float* cw = epi.cw + f0;
          const float4 a0 = *(const float4*)cw, a1 = *(const float4*)(cw + 4), b0 = *(const float4*)(cw + DFF), b1 = *(const float4*)(cw + DFF + 4);
          const float4 c0 = *(const float4*)(cw + 2 * DFF), c1 = *(const float4*)(cw + 2 * DFF + 4), d0 = *(const float4*)(epi.cb + f0), d1 = *(const float4*)(epi.cb + f0 + 4);
          w0[0] = a0.x; w0[1] = a0.y; w0[2] = a0.z; w0[3] = a0.w; w0[4] = a1.x; w0[5] = a1.y; w0[6] = a1.z; w0[7] = a1.w;
          w1[0] = b0.x; w1[1] = b0.y; w1[2] = b0.z; w1[3] = b0.w; w1[4] = b1.x; w1[5] = b1.y; w1[6] = b1.z; w1[7] = b1.w;
          w2[0] = c0.x; w2[1] = c0.y; w2[2] = c0.z; w2[3] = c0.w; w2[4] = c1.x; w2[5] = c1.y; w2[6] = c1.z; w2[7] = c1.w;
          bb[0] = d0.x; bb[1] = d0.y; bb[2] = d0.z; bb[3] = d0.w; bb[4] = d1.x; bb[5] = d1.y; bb[6] = d1.z; bb[7] = d1.w;
        }
#pragma unroll
        for (int j = 0; j < BM / 64; j++) {
          const int r = (tid >> 3) + 64 * j;
          const char* ap = smem + UP_LA + r * 144 + fc * 16;
          const uint4 x0 = *(const uint4*)ap, x1 = *(const uint4*)(ap + 144), x2 = *(const uint4*)(ap + 288);
          const uint4 bv = *(const uint4*)(smem + UP_LB + r * 144 + fc * 16);
          const unsigned xa[4] = {x0.x, x0.y, x0.z, x0.w}, xb[4] = {x1.x, x1.y, x1.z, x1.w}, xc[4] = {x2.x, x2.y, x2.z, x2.w}, bw[4] = {bv.x, bv.y, bv.z, bv.w};
          float o[8];
#pragma unroll
          for (int q = 0; q < 8; q++) {
            const float a0 = (q & 1) ? bfhi(xa[q >> 1]) : bflo(xa[q >> 1]), a1 = (q & 1) ? bfhi(xb[q >> 1]) : bflo(xb[q >> 1]), a2 = (q & 1) ? bfhi(xc[q >> 1]) : bflo(xc[q >> 1]);
            const float bq = (q & 1) ? bfhi(bw[q >> 1]) : bflo(bw[q >> 1]);
            const float a = a0 * w0[q] + a1 * w1[q] + a2 * w2[q] + bb[q];
            const float t2 = 1.5957691216057308f * (a + 0.044715f * a * a * a);
            o[q] = a * __builtin_amdgcn_rcpf(1.f + __expf(-t2)) * bq;
          }
          uint4 ov; ov.x = pack2(o[0], o[1]); ov.y = pack2(o[2], o[3]); ov.z = pack2(o[4], o[5]); ov.w = pack2(o[6], o[7]);
          *(uint4*)(epi.u + (size_t)(m0 + r) * DFF + f0) = ov;
        }
      }
      __syncthreads();
     }
    } else if constexpr (epi_proj<Epi>::value) {
      const auto rsP = __builtin_amdgcn_make_buffer_rsrc((void*)epi.proj, 0, 0x7fffffff, 0x00020000);
      const auto rsT = __builtin_amdgcn_make_buffer_rsrc((void*)epi.ktr, 0, 0x7fffffff, 0x00020000);
      const auto rsG = __builtin_amdgcn_make_buffer_rsrc((void*)epi.gates, 0, 0x7fffffff, 0x00020000);
      const int wns = wu & 1;
      const bool even = (lane & 1) == 0;
      unsigned voffP[MT], voffT[MT], voffG[MT];
#pragma unroll
      for (int mi = 0; mi < MT; mi++) {
        const int row = m0 + wm * (BM / 4) + mi * 16 + lr;
        voffP[mi] = (unsigned)((row * INW + lg * 4) * 2); voffT[mi] = (unsigned)(((lg * 4 + (lane & 1) * 2) * T + (row & ~1)) * 2); voffG[mi] = (unsigned)((row * 16 + lg * 4) * 4);
      }
#pragma unroll
      for (int ni = 0; ni < NTW; ni++) {
        const int col0 = n0 + wns * (BN / 2) + ni * 16;
        const bool tonly = (col0 >= 768 && col0 < 1152) || (col0 >= 1536 && col0 < 2304) || (col0 >= 3072 && col0 < 3456);
        long tel = -1;
        if (col0 >= 384 && col0 < 768) tel = (long)(col0 - 384) * T;
        else if (col0 >= 768 && col0 < 1152) tel = (epi.vtr - epi.ktr) + (long)(col0 - 768) * T;
        else if (col0 >= 1536 && col0 < 2304) tel = (epi.hyt - epi.ktr) + (long)(col0 - 1536) * T;
        else if (col0 >= 2688 && col0 < 3072) tel = (epi.ktm - epi.ktr) + (long)(col0 - 2688) * T;
        else if (col0 >= 3072 && col0 < 3456) tel = (epi.vtm - epi.ktr) + (long)(col0 - 3072) * T;
        const unsigned tso = (unsigned)(tel * 2);
#pragma unroll
        for (int mi = 0; mi < MT; mi++) {
          const f32x4 v = acc[mi][ni];
          const unsigned w01 = pack2(v[0], v[1]), w23 = pack2(v[2], v[3]);
          if (col0 < 3840 && !tonly) __builtin_amdgcn_raw_buffer_store_b64((u32x2){w01, w23}, rsP, voffP[mi], (unsigned)(col0 * 2), 0);
          if (col0 == 3840) __builtin_amdgcn_raw_buffer_store_b128((u32x4){__float_as_uint(v[0]), __float_as_uint(v[1]), __float_as_uint(v[2]), __float_as_uint(v[3])}, rsG, voffG[mi], 0, 0);
          if (tel >= 0) {
            float nb[4];
#pragma unroll
            for (int r = 0; r < 4; r++) nb[r] = __int_as_float(__builtin_amdgcn_update_dpp(0, __float_as_int(v[r]), 0xB1, 0xF, 0xF, false));
            const unsigned p0 = pack2(even ? v[0] : nb[2], even ? nb[0] : v[2]), p1 = pack2(even ? v[1] : nb[3], even ? nb[1] : v[3]);
            __builtin_amdgcn_raw_buffer_store_b32(p0, rsT, voffT[mi], tso, 0);
            __builtin_amdgcn_raw_buffer_store_b32(p1, rsT, voffT[mi], tso + (unsigned)(T * 2), 0);
          }
        }
      }
    } else {
#pragma unroll
      for (int mi = 0; mi < MT; mi++)
#pragma unroll
        for (int ni = 0; ni < NTW; ni++) epi(m0 + wm * (BM / 4) + mi * 16 + lr, n0 + wn * (BN / 2) + ni * 16 + lg * 4, acc[mi][ni]);
    }
  }
#undef GLOAD
#undef SWRITE
#undef GLDS
#undef GWAIT
#undef TILE_M0
#undef TILE_N0
}


namespace up8 {
constexpr int BM = 256, BK = 64, HALF = 128, HT = HALF * BK, SHM_B = 8 * HT * 2;
__device__ __forceinline__ int lds_byte(int r, int c) { int st = (r >> 4) * 2 + (c >> 5), rr = r & 15, cc = c & 31, ob = rr * 64 + cc * 2; return st * 1024 + (ob ^ (((ob >> 9) & 1) << 5)); }
__device__ __forceinline__ void stage_rc(int b, int& R, int& C) { int st = b / 1024, sb = b % 1024, swz = sb ^ (((sb >> 9) & 1) << 5); R = (st >> 1) * 16 + swz / 64; C = (st & 1) * 32 + (swz % 64) / 2; }
}
__device__ __forceinline__ void gemm_up8(const bf16_t* __restrict__ A, const bf16_t* __restrict__ Bt, int bid, int nb, char* smem, const EpiUp& epi) {
  using namespace up8;
  constexpr int K = D;
  static_assert(SHM_B <= SMEM_BYTES - 64, "LDS");
  const int tid = TIDX, wid = tid >> 6, lane = tid & 63, wr = wid >> 2, wc = wid & 3, fr = lane & 15, fq = lane >> 4;
  const int wu = __builtin_amdgcn_readfirstlane(wid);
  bf16_t* shm = (bf16_t*)smem;
#define SA(b, h) (shm + ((b) * 2 + (h)) * HT)
#define SB(b, h) (shm + (4 + (b) * 2 + (h)) * HT)
  int sR0, sC0, sR1, sC1; stage_rc(tid * 16, sR0, sC0); stage_rc(tid * 16 + 8192, sR1, sC1);
  const unsigned so0 = (unsigned)((sR0 * K + sC0) * 2), so1 = (unsigned)((sR1 * K + sC1) * 2);
  const auto rsA = __builtin_amdgcn_make_buffer_rsrc((void*)A, 0, 0x7fffffff, 0x00020000);
  const auto rsB = __builtin_amdgcn_make_buffer_rsrc((void*)Bt, 0, 0x7fffffff, 0x00020000);
  const auto rsU = __builtin_amdgcn_make_buffer_rsrc((void*)epi.u, 0, 0x7fffffff, 0x00020000);
#define rs_A rsA
#define rs_Bt rsB
#define STAGE(P, BASE, br, kt) do { const int so_ = ((br) * K + (kt) * BK) * 2; \
    __builtin_amdgcn_raw_ptr_buffer_load_lds(rs_##BASE, (LAS void*)((char*)(P) + wu * 1024), 16, so0, so_, 0, 0); \
    __builtin_amdgcn_raw_ptr_buffer_load_lds(rs_##BASE, (LAS void*)((char*)(P) + 8192 + wu * 1024), 16, so1, so_, 0, 0); } while (0)
#define LDA(dst, b, h) _Pragma("unroll") for (int m = 0; m < 4; ++m) _Pragma("unroll") for (int k = 0; k < 2; ++k) \
    dst[m][k] = *reinterpret_cast<const bf16x8*>((const char*)SA(b, h) + lds_byte(wr * 64 + m * 16 + fr, k * 32 + fq * 8))
#define LDB(dst, b, h) _Pragma("unroll") for (int n = 0; n < 2; ++n) _Pragma("unroll") for (int k = 0; k < 2; ++k) \
    dst[n][k] = *reinterpret_cast<const bf16x8*>((const char*)SB(b, h) + lds_byte(wc * 32 + n * 16 + fr, k * 32 + fq * 8))
#define MMA(ai, bj, At_, Bt_) do { __builtin_amdgcn_s_setprio(1); \
    _Pragma("unroll") for (int m = 0; m < 4; ++m) _Pragma("unroll") for (int n = 0; n < 2; ++n) _Pragma("unroll") for (int k = 0; k < 2; ++k) \
      acc[ai][bj][m][n] = __builtin_amdgcn_mfma_f32_16x16x32_bf16(Bt_[n][k], At_[m][k], acc[ai][bj][m][n], 0, 0, 0); \
    __builtin_amdgcn_s_setprio(0); } while (0)
#define WAIT_V(n) asm volatile("s_waitcnt vmcnt(" #n ")" ::: "memory")
#define WAIT_L(n) asm volatile("s_waitcnt lgkmcnt(" #n ")" ::: "memory")
#define BARX __builtin_amdgcn_s_barrier()
#define SCHED __builtin_amdgcn_sched_barrier(0)
  const int grp = bid & 7, jg = bid >> 3, ng = (nb + 7 - grp) >> 3;
  constexpr int mpg = 6, nn = 16, tpg = mpg * nn, nt = K / BK;
  for (int q = jg; q < tpg; q += ng) {
    const int mi_ = q % mpg, mt_ = mi_ < 4 ? (grp & 3) * 4 + mi_ : 16 + (grp & 3) * 2 + (mi_ - 4);
    const int m0 = mt_ * 256, n0 = ((grp >> 2) * nn + q / mpg) * 256;
    const int brow = m0, bcol = n0;
    f32x4 acc[2][2][4][2];
    { float zero_ = 0.f; asm volatile("" : "+v"(zero_));
#pragma unroll
      for (int a_ = 0; a_ < 2; a_++)
#pragma unroll
        for (int b_ = 0; b_ < 2; b_++)
#pragma unroll
          for (int m = 0; m < 4; m++)
#pragma unroll
            for (int n = 0; n < 2; n++) acc[a_][b_][m][n] = (f32x4){zero_, zero_, zero_, zero_}; }
    bf16x8 At[4][2], B0[2][2], B1[2][2];
    __syncthreads();
    STAGE(SB(0, 0), Bt, bcol, 0); STAGE(SA(0, 0), A, brow, 0);
    STAGE(SB(0, 1), Bt, bcol + HALF, 0); STAGE(SA(0, 1), A, brow + HALF, 0);
    if (wr == 1) BARX;
    WAIT_V(4); BARX;
    STAGE(SB(1, 0), Bt, bcol, 1); STAGE(SA(1, 0), A, brow, 1); STAGE(SB(1, 1), Bt, bcol + HALF, 1);
    WAIT_V(6); BARX;
#pragma unroll 1
    for (int t = 0; t < nt - 2; t += 2) {
      LDB(B0, 0, 0); SCHED; LDA(At, 0, 0); STAGE(SA(1, 1), A, brow + HALF, t + 1);
      WAIT_L(8); BARX; WAIT_L(0); MMA(0, 0, At, B0); BARX; SCHED;
      LDB(B1, 0, 1); STAGE(SB(0, 0), Bt, bcol, t + 2);
      BARX; WAIT_L(0); MMA(0, 1, At, B1); BARX;
      LDA(At, 0, 1); STAGE(SA(0, 0), A, brow, t + 2);
      BARX; WAIT_L(0); MMA(1, 0, At, B0); BARX; SCHED;
      STAGE(SB(0, 1), Bt, bcol + HALF, t + 2);
      WAIT_V(6); BARX; MMA(1, 1, At, B1); BARX;
      LDB(B0, 1, 0); SCHED; LDA(At, 1, 0); STAGE(SA(0, 1), A, brow + HALF, t + 2);
      WAIT_L(8); BARX; WAIT_L(0); MMA(0, 0, At, B0); BARX; SCHED;
      LDB(B1, 1, 1); STAGE(SB(1, 0), Bt, bcol, t + 3);
      BARX; WAIT_L(0); MMA(0, 1, At, B1); BARX;
      LDA(At, 1, 1); STAGE(SA(1, 0), A, brow, t + 3);
      BARX; WAIT_L(0); MMA(1, 0, At, B0); BARX; SCHED;
      STAGE(SB(1, 1), Bt, bcol + HALF, t + 3);
      WAIT_V(6); BARX; MMA(1, 1, At, B1); BARX;
    }
    { LDB(B0, 0, 0); LDA(At, 0, 0); STAGE(SA(1, 1), A, brow + HALF, nt - 1);
      BARX; WAIT_L(0); MMA(0, 0, At, B0); BARX;
      LDB(B1, 0, 1); BARX; WAIT_L(0); MMA(0, 1, At, B1); BARX;
      LDA(At, 0, 1); WAIT_V(4); BARX; WAIT_L(0); MMA(1, 0, At, B0); MMA(1, 1, At, B1); BARX; }
    { LDB(B0, 1, 0); LDA(At, 1, 0); WAIT_V(2); BARX; WAIT_L(0); MMA(0, 0, At, B0); BARX;
      LDB(B1, 1, 1); WAIT_V(0); BARX; WAIT_L(0); MMA(0, 1, At, B1); BARX;
      LDA(At, 1, 1); BARX; WAIT_L(0); MMA(1, 0, At, B0); MMA(1, 1, At, B1); BARX; }
    if (wr == 0) BARX;
    constexpr int RS = 272, UP_LA = 0, UP_LB = UP_LA + 258 * RS;
    static_assert(UP_LB + 256 * RS <= SMEM_BYTES - 64, "fused epilogue images");
    __syncthreads();
    int tid_e = tid; asm volatile("" : "+v"(tid_e));
    const int lane_e = tid_e & 63, wid_e = tid_e >> 6, wr_e = wid_e >> 2, wc_e = wid_e & 3, fr_e = lane_e & 15, fq_e = lane_e >> 4;
#pragma unroll
    for (int ai = 0; ai < 2; ai++)
#pragma unroll
      for (int m = 0; m < 4; m++)
#pragma unroll
        for (int n = 0; n < 2; n++) {
          const int r = ai * 128 + wr_e * 64 + m * 16 + fr_e, cidx = wc_e * 32 + n * 16 + fq_e * 4;
          uint2 oa, ob;
          oa.x = pack2(acc[ai][0][m][n][0], acc[ai][0][m][n][1]); oa.y = pack2(acc[ai][0][m][n][2], acc[ai][0][m][n][3]);
          ob.x = pack2(acc[ai][1][m][n][0], acc[ai][1][m][n][1]); ob.y = pack2(acc[ai][1][m][n][2], acc[ai][1][m][n][3]);
          *(uint2*)(smem + UP_LA + RS + r * RS + cidx * 2) = oa;
          *(uint2*)(smem + UP_LB + r * RS + cidx * 2) = ob;
        }
    {
      const int pos0 = m0 >= TC ? ((m0 - TC) & 1023) : 0;
      const bool top = m0 >= TC && pos0 != 0, bot = m0 >= TC && pos0 + 256 != 1024;
      if (top || bot) {
        unsigned z0_ = 0u; asm volatile("" : "+v"(z0_)); uint4 ht0 = make_uint4(z0_, z0_, z0_, z0_), ht1 = ht0, hb0 = ht0, hb1 = ht0;
        if (top) { const bf16_t* hr = epi.h + (size_t)(m0 - 1) * K + lane_e * 8; ht0 = *(const uint4*)hr; ht1 = *(const uint4*)(hr + 512); }
        if (bot) { const bf16_t* hr = epi.h + (size_t)(m0 + 256) * K + lane_e * 8; hb0 = *(const uint4*)hr; hb1 = *(const uint4*)(hr + 512); }
#define DOT2_(a, b, c) __builtin_amdgcn_fdot2_f32_bf16(__builtin_bit_cast(bf16x2_t, (a)), __builtin_bit_cast(bf16x2_t, (b)), (c), false)
#define DOT8A(acc, a, b) acc = DOT2_(a.x, b.x, DOT2_(a.y, b.y, DOT2_(a.z, b.z, DOT2_(a.w, b.w, acc))))
#define DOT8(a, b) (bflo(a.x) * bflo(b.x) + bfhi(a.x) * bfhi(b.x) + bflo(a.y) * bflo(b.y) + bfhi(a.y) * bfhi(b.y) + bflo(a.z) * bflo(b.z) + bfhi(a.z) * bfhi(b.z) + bflo(a.w) * bflo(b.w) + bfhi(a.w) * bfhi(b.w))
#pragma unroll 1
        for (int fb = 0; fb < 4; fb++) {
          uint4 w0[4], w1[4];
#pragma unroll
          for (int fi = 0; fi < 4; fi++) { const bf16_t* wrow = epi.wt + (size_t)(n0 + wid_e * 16 + fb * 4 + fi) * K + lane_e * 8; w0[fi] = *(const uint4*)wrow; w1[fi] = *(const uint4*)(wrow + 512); }
#pragma unroll
          for (int fi = 0; fi < 4; fi++) {
            float st = 0.f, sb = 0.f;
            DOT8A(st, ht0, w0[fi]); DOT8A(st, ht1, w1[fi]); DOT8A(sb, hb0, w0[fi]); DOT8A(sb, hb1, w1[fi]);
            st = wave_sum(st); sb = wave_sum(sb);
            const int f = wid_e * 16 + fb * 4 + fi;
            if (lane_e == 0) { *(bf16_t*)(smem + UP_LA + f * 2) = f2bf(st); *(bf16_t*)(smem + UP_LA + 257 * RS + f * 2) = f2bf(sb); }
          }
        }
#undef DOT8
#undef DOT8A
#undef DOT2_
      } else if (tid_e < 256) {
        *(bf16_t*)(smem + UP_LA + (tid_e >> 7) * 257 * RS + (tid_e & 127) * 2) = 0;
      }
    }
    __syncthreads();
    {
      const int fc = tid_e & 15, f0 = (n0 >> 1) + fc * 8;
      f32x2 w0[4], w1[4], w2[4], bb[4];
      {
        const float* cw = epi.cw + f0;
        const float4 a0 = *(const float4*)cw, a1 = *(const float4*)(cw + 4), b0 = *(const float4*)(cw + DFF), b1 = *(const float4*)(cw + DFF + 4);
        const float4 c0 = *(const float4*)(cw + 2 * DFF), c1 = *(const float4*)(cw + 2 * DFF + 4), d0 = *(const float4*)(epi.cb + f0), d1 = *(const float4*)(epi.cb + f0 + 4);
        w0[0] = (f32x2){a0.x, a0.y}; w0[1] = (f32x2){a0.z, a0.w}; w0[2] = (f32x2){a1.x, a1.y}; w0[3] = (f32x2){a1.z, a1.w};
        w1[0] = (f32x2){b0.x, b0.y}; w1[1] = (f32x2){b0.z, b0.w}; w1[2] = (f32x2){b1.x, b1.y}; w1[3] = (f32x2){b1.z, b1.w};
        w2[0] = (f32x2){c0.x, c0.y}; w2[1] = (f32x2){c0.z, c0.w}; w2[2] = (f32x2){c1.x, c1.y}; w2[3] = (f32x2){c1.z, c1.w};
        bb[0] = (f32x2){d0.x, d0.y}; bb[1] = (f32x2){d0.z, d0.w}; bb[2] = (f32x2){d1.x, d1.y}; bb[3] = (f32x2){d1.z, d1.w};
      }
      constexpr float GC0 = -1.5957691216057308f * 1.4426950408889634f, GC1 = GC0 * 0.044715f;
#pragma unroll 2
      for (int j = 0; j < 8; j++) {
        const int r = (tid_e >> 4) + 32 * j;
        const char* ap = smem + UP_LA + r * RS + fc * 16;
        const uint4 x0 = *(const uint4*)ap, x1 = *(const uint4*)(ap + RS), x2 = *(const uint4*)(ap + 2 * RS);
        const uint4 bv = *(const uint4*)(smem + UP_LB + r * RS + fc * 16);
        const unsigned xa[4] = {x0.x, x0.y, x0.z, x0.w}, xb[4] = {x1.x, x1.y, x1.z, x1.w}, xc[4] = {x2.x, x2.y, x2.z, x2.w}, bw[4] = {bv.x, bv.y, bv.z, bv.w};
        unsigned ow[4];
#pragma unroll
        for (int q = 0; q < 4; q++) {
          const f32x2 a0 = {bflo(xa[q]), bfhi(xa[q])}, a1 = {bflo(xb[q]), bfhi(xb[q])}, a2 = {bflo(xc[q]), bfhi(xc[q])}, bq = {bflo(bw[q]), bfhi(bw[q])};
          const f32x2 a = a0 * w0[q] + (a1 * w1[q] + (a2 * w2[q] + bb[q]));
          const f32x2 v = a * (a * a * GC1 + GC0);
          const f32x2 d = (f32x2){__builtin_amdgcn_exp2f(v[0]), __builtin_amdgcn_exp2f(v[1])} + 1.f;
          const f32x2 o = a * (f32x2){__builtin_amdgcn_rcpf(d[0]), __builtin_amdgcn_rcpf(d[1])} * bq;
          ow[q] = pack2(o[0], o[1]);
        }
        uint4 ov; ov.x = ow[0]; ov.y = ow[1]; ov.z = ow[2]; ov.w = ow[3];
        __builtin_amdgcn_raw_buffer_store_b128((u32x4){ov.x, ov.y, ov.z, ov.w}, rsU, (unsigned)(((m0 + r) * DFF + f0) * 2), 0, WT_AUX);
      }
    }
  }
#undef SA
#undef SB
#undef STAGE
#undef rs_A
#undef rs_Bt
#undef LDA
#undef LDB
#undef MMA
#undef WAIT_V
#undef WAIT_L
#undef BARX
#undef SCHED
}

template <int BM, int BN, int GL, class Epi>
__device__ __forceinline__ void phase_gemm(const bf16_t* A, const bf16_t* Bt, int M, int N, int K, int bid, int nb, char* smem, const Epi& epi) {
  gemm_tiles<BM, BN, GL, Epi>(A, Bt, M, N, K, bid, nb, smem, epi);
}

constexpr int LQ = 0, LK = 26624;
constexpr int LRED = 0;
constexpr int LKT = 36864;
constexpr int LVT = 61440;
constexpr int LST = 86016;
constexpr int LGT = 125952;
constexpr int MIX_LDS_END = LGT + (2048 + 256 + 256 + 16 + 192) * 4;
constexpr float KSCALE = 0.10206207261596577f;
constexpr float LOG2E = 1.4426950408889634f;


template <bool ML>
__device__ __forceinline__ void mix_unit(PR p, int layer, int s, int c, int h, char* smem) {
  const int tid = TIDX, lane = tid & 63, wid = tid >> 6, lr = lane & 15, lg = lane >> 4;
  const int L = seq_len(s), row0 = seq_row0(s), nc = L >> 7;
  const bool latent = s >= 16; const int lb = s - 16;
  const int P0 = c * 128;
  const int QOFF = ML ? 2304 : 0, KOFF = ML ? 2688 : 384, GOFF = ML ? 3456 : 1152, MOFF = ML ? 640 : 0;
  const bf16_t* ktg = (ML ? p.ktm : p.ktr) + (size_t)h * 96 * T + row0;
  const bf16_t* vtg = (ML ? p.vtm : p.vtr) + (size_t)h * 96 * T + row0;
  const bool rope = (!ML) && latent;
  float* red = (float*)(smem + LRED);
  float* Eg = (float*)(smem + LGT); float* Xo = Eg + 2048; float* Bo = Xo + 256; float* sc = Bo + 256; float* nin = sc + 16;
  float lgd0 = 0.f, lgd1 = 0.f;
  if (!ML) {
    lgd0 = log_sigmoidf_(p.ret_decay_logit[layer * 8 + h]) * LOG2E;
    lgd1 = log_sigmoidf_(p.ret_decay_logit[layer * 8 + 4 + h]) * LOG2E;
  }
  __syncthreads();
  if (ML) {
    for (int t = tid; t < L; t += NT) {
      const float4* g4 = (const float4*)(p.gates + (size_t)(row0 + t) * 16);
      const float4 gA = g4[0], gB = g4[1], gC = g4[2], gD = g4[3];
      const float ga[4] = {gA.x, gA.y, gA.z, gA.w}, gb[4] = {gB.x, gB.y, gB.z, gB.w}, gc[4] = {gC.x, gC.y, gC.z, gC.w}, gd[4] = {gD.x, gD.y, gD.z, gD.w};
      float gi0 = 0.f, gf0 = 0.f, gi1 = 0.f, gf1 = 0.f;
#pragma unroll
      for (int q = 0; q < 4; q++) if (q == h) { gi0 = ga[q]; gf0 = gb[q]; gi1 = gc[q]; gf1 = gd[q]; }
      const float* gbias = p.ml_gate_bias + layer * 16;
      Eg[t] = gi0 + gbias[h]; Eg[1024 + t] = gi1 + gbias[8 + h];
      red[t] = log_sigmoidf_(gf0 + gbias[4 + h]); red[1024 + t] = log_sigmoidf_(gf1 + gbias[12 + h]);
    }
    __syncthreads();
    if (wid < 2) {
      const int dir = wid; const int per = L >> 6;
      const float m0 = latent ? p.state_m[((lb * DEPTH + layer) * 2 + dir) * 4 + h] : 0.f;
      float ev[16], bv[16];
      float run = 0.f;
#pragma unroll
      for (int k = 0; k < 16; k++) {
        ev[k] = 0.f; bv[k] = 0.f;
        if (k < per) {
          int u = lane * per + k; int t = dir ? L - 1 - u : u;
          ev[k] = Eg[dir * 1024 + t];
          run += red[dir * 1024 + t];
          bv[k] = run;
        }
      }
      float incl = run;
#pragma unroll
      for (int o = 1; o < 64; o <<= 1) { float v = __shfl_up(incl, o); if (lane >= o) incl += v; }
      const float excl = incl - run;
      float xm = -3.0e38f;
#pragma unroll
      for (int k = 0; k < 16; k++) if (k < per) { bv[k] += excl; ev[k] -= bv[k]; xm = fmaxf(xm, ev[k]); }
      float inclm = xm;
#pragma unroll
      for (int o = 1; o < 64; o <<= 1) { float v = __shfl_up(inclm, o); if (lane >= o) inclm = fmaxf(inclm, v); }
      float xrun = __shfl_up(inclm, 1); if (lane == 0) xrun = -3.0e38f;
      xrun = fmaxf(xrun, m0);
      const int nprior = dir ? L - P0 - 128 : P0;
      if (lane == 0) { sc[6 + dir] = m0; if (nprior == 0) sc[0 + dir] = m0; }
#pragma unroll
      for (int k = 0; k < 16; k++) if (k < per) {
        int u = lane * per + k; int t = dir ? L - 1 - u : u;
        xrun = fmaxf(xrun, ev[k]);
        Eg[dir * 1024 + t] = ev[k];
        if (t >= P0 && t < P0 + 128) { Xo[dir * 128 + t - P0] = xrun; Bo[dir * 128 + t - P0] = bv[k]; }
        if (u == nprior - 1) sc[0 + dir] = xrun;
        if (u == L - 1) { sc[2 + dir] = xrun; sc[4 + dir] = bv[k]; }
      }
    }
    __syncthreads();
  }
  const int wq = wid & 3, kgrp = wid >> 2;
  const int dt0 = 3 * (wq >> 1), et0 = 3 * (wq & 1);
#pragma unroll 1
  for (int dirr = 0; dirr < 2 * REP_STATE; dirr++) {
    const int dir = dirr & 1;
    const int nprior_ch = dir ? nc - 1 - c : c;
    const bool need_final = (!latent) && (dir ? (c == 0) : (c == nc - 1));
    const float lgdir = dir ? lgd1 : lgd0;
    f32x4 acc[3][3];
    const float Xin = ML ? sc[0 + dir] : 0.f;
    {
      float f0 = 0.f;
      if (latent && kgrp == 0) f0 = ML ? __expf(sc[6 + dir] - Xin) : 1.f;
      const float* S0 = (ML ? p.state_c : p.state_ret) + ((size_t)((lb * DEPTH + layer) * 2 + dir) * 4 + h) * 9216;
#pragma unroll
      for (int a = 0; a < 3; a++)
#pragma unroll
        for (int b = 0; b < 3; b++)
#pragma unroll
          for (int r = 0; r < 4; r++) {
            float v = 0.f;
            if (latent && kgrp == 0) v = S0[((dt0 + a) * 16 + 4 * lg + r) * 96 + (et0 + b) * 16 + lr] * f0;
            acc[a][b][r] = v;
          }
    }
    float nacc[2][2] = {{0.f, 0.f}, {0.f, 0.f}};
    const int nsteps = nprior_ch + (need_final ? 1 : 0);
    float wret[2][8];
#pragma unroll
    for (int it = 0; it < 2; it++)
#pragma unroll
      for (int q = 0; q < 8; q++) { const int tl = ((tid + it * 512) & 15) * 8 + q; wret[it][q] = ML ? 0.f : __builtin_amdgcn_exp2f((float)(dir ? tl : 127 - tl) * lgdir) * KSCALE; }
    u32x4 pk1[2], pk2[2], pv[3];
#define MIX_PREFETCH(jj) { \
      _Pragma("unroll") for (int it = 0; it < 2; it++) { const int pi = tid + it * 512; if (pi < 768) { const int d = pi >> 4, cc = pi & 15; \
          pk1[it] = *(const u32x4*)(ktg + (size_t)d * T + (jj) * 128 + cc * 8); pk2[it] = *(const u32x4*)(ktg + (size_t)(d + 48) * T + (jj) * 128 + cc * 8); } } \
      _Pragma("unroll") for (int it = 0; it < 3; it++) { const int ci = tid + it * 512, e = ci >> 4, cc = ci & 15; pv[it] = *(const u32x4*)(vtg + (size_t)e * T + (jj) * 128 + cc * 8); } }
    if (nsteps > 0) { const int j0 = (0 == nprior_ch) ? c : (dir ? nc - 1 : 0); MIX_PREFETCH(j0); }
#pragma unroll 1
    for (int st = 0; st < nsteps; st++) {
      const bool fin = st == nprior_ch;
      const int j = fin ? c : (dir ? nc - 1 - st : st);
      const float Xref = ML ? (fin ? sc[2 + dir] : Xin) : 0.f;
      if (fin) {
        __syncthreads();
        if (kgrp == 1) {
#pragma unroll
          for (int a = 0; a < 3; a++)
#pragma unroll
            for (int b = 0; b < 3; b++)
#pragma unroll
              for (int r = 0; r < 4; r++) { red[(wq * 36 + (a * 3 + b) * 4 + r) * 64 + lane] = acc[a][b][r]; acc[a][b][r] = 0.f; }
        }
        __syncthreads();
        if (kgrp == 0) {
          const float resc = ML ? __expf(Xin - Xref) : 1.f;
#pragma unroll
          for (int a = 0; a < 3; a++)
#pragma unroll
            for (int b = 0; b < 3; b++) {
              f32x4 v = acc[a][b];
#pragma unroll
              for (int r = 0; r < 4; r++) v[r] += red[(wq * 36 + (a * 3 + b) * 4 + r) * 64 + lane];
              uint2 o; o.x = pack2(v[0], v[1]); o.y = pack2(v[2], v[3]);
              *(uint2*)(smem + LST + dir * 19968 + ((et0 + b) * 16 + lr) * 208 + ((dt0 + a) * 16 + 4 * lg) * 2) = o;
              acc[a][b] = v * resc;
            }
        }
        if (ML && (tid & 15) == 0) {
          const float resc = __expf(Xin - Xref);
#pragma unroll
          for (int it = 0; it < 2; it++) {
            int d = (tid >> 4) + 32 * it;
            if (d < 48) { nin[dir * 96 + d] = nacc[it][0]; nin[dir * 96 + d + 48] = nacc[it][1]; nacc[it][0] *= resc; nacc[it][1] *= resc; }
          }
        }
      }
      __syncthreads();
#pragma unroll
      for (int it = 0; it < 2; it++) {
        const int pi = tid + it * 512;
        if (pi < 768) {
          const int d = pi >> 4, cc = pi & 15;
          const int t0 = j * 128 + cc * 8;
          const u32x4 k1 = pk1[it], k2 = pk2[it];
          float w[8];
          if (ML) {
            const float4 e0 = *(const float4*)(Eg + dir * 1024 + t0), e1 = *(const float4*)(Eg + dir * 1024 + t0 + 4);
            w[0] = e0.x; w[1] = e0.y; w[2] = e0.z; w[3] = e0.w; w[4] = e1.x; w[5] = e1.y; w[6] = e1.z; w[7] = e1.w;
#pragma unroll
            for (int q = 0; q < 8; q++) w[q] = __expf(w[q] - Xref) * KSCALE;
          } else {
#pragma unroll
            for (int q = 0; q < 8; q++) w[q] = wret[it][q];
          }
          float x1[8], x2[8];
          x1[0] = bflo(k1.x); x1[1] = bfhi(k1.x); x1[2] = bflo(k1.y); x1[3] = bfhi(k1.y); x1[4] = bflo(k1.z); x1[5] = bfhi(k1.z); x1[6] = bflo(k1.w); x1[7] = bfhi(k1.w);
          x2[0] = bflo(k2.x); x2[1] = bfhi(k2.x); x2[2] = bflo(k2.y); x2[3] = bfhi(k2.y); x2[4] = bflo(k2.z); x2[5] = bfhi(k2.z); x2[6] = bflo(k2.w); x2[7] = bfhi(k2.w);
          if (rope) {
            const float* ct = p.rope_cosT + d * 1024 + t0; const float* sn = p.rope_sinT + d * 1024 + t0;
            const float4 c0 = *(const float4*)ct, c1 = *(const float4*)(ct + 4), s0 = *(const float4*)sn, s1 = *(const float4*)(sn + 4);
            const float cv[8] = {c0.x, c0.y, c0.z, c0.w, c1.x, c1.y, c1.z, c1.w}, sv[8] = {s0.x, s0.y, s0.z, s0.w, s1.x, s1.y, s1.z, s1.w};
#pragma unroll
            for (int q = 0; q < 8; q++) { float a1 = x1[q] * cv[q] - x2[q] * sv[q], a2 = x2[q] * cv[q] + x1[q] * sv[q]; x1[q] = a1; x2[q] = a2; }
          }
          float s1 = 0.f, s2 = 0.f;
#pragma unroll
          for (int q = 0; q < 8; q++) { x1[q] *= w[q]; x2[q] *= w[q]; s1 += x1[q]; s2 += x2[q]; }
          uint4 o1, o2;
          o1.x = pack2(x1[0], x1[1]); o1.y = pack2(x1[2], x1[3]); o1.z = pack2(x1[4], x1[5]); o1.w = pack2(x1[6], x1[7]);
          o2.x = pack2(x2[0], x2[1]); o2.y = pack2(x2[2], x2[3]); o2.z = pack2(x2[4], x2[5]); o2.w = pack2(x2[6], x2[7]);
          *(uint4*)(smem + LKT + d * 256 + ((cc ^ (d & 15)) << 4)) = o1;
          *(uint4*)(smem + LKT + (d + 48) * 256 + ((cc ^ ((d + 48) & 15)) << 4)) = o2;
          if (ML) {
            { s1 = row16_sum(s1); s2 = row16_sum(s2); }
            nacc[it][0] += s1; nacc[it][1] += s2;
          }
        }
      }
#pragma unroll
      for (int it = 0; it < 3; it++) {
        const int ci = tid + it * 512, e = ci >> 4, cc = ci & 15;
        *(u32x4*)(smem + LVT + e * 256 + ((cc ^ (e & 15)) << 4)) = pv[it];
      }
      __syncthreads();
      if (st + 1 < nsteps) { const int jn = (st + 1 == nprior_ch) ? c : (dir ? nc - 2 - st : st + 1); MIX_PREFETCH(jn); }
      if (!ML) {
        const float g128 = __builtin_amdgcn_exp2f(128.f * lgdir);
#pragma unroll
        for (int a = 0; a < 3; a++)
#pragma unroll
          for (int b = 0; b < 3; b++) acc[a][b] = acc[a][b] * g128;
      }
#pragma unroll
      for (int kk = 0; kk < 2; kk++) {
        const int ch = (kgrp * 2 + kk) * 4 + lg;
        bf16x8 af[3], bfr[3];
#pragma unroll
        for (int a = 0; a < 3; a++) { int row = (dt0 + a) * 16 + lr; af[a] = *(const bf16x8*)(smem + LKT + row * 256 + ((ch ^ (row & 15)) << 4)); }
#pragma unroll
        for (int b = 0; b < 3; b++) { int row = (et0 + b) * 16 + lr; bfr[b] = *(const bf16x8*)(smem + LVT + row * 256 + ((ch ^ (row & 15)) << 4)); }
#pragma unroll
        for (int a = 0; a < 3; a++)
#pragma unroll
          for (int b = 0; b < 3; b++) acc[a][b] = __builtin_amdgcn_mfma_f32_16x16x32_bf16(af[a], bfr[b], acc[a][b], 0, 0, 0);
      }
    }
#undef MIX_PREFETCH
    __syncthreads();
    if (kgrp == 1) {
#pragma unroll
      for (int a = 0; a < 3; a++)
#pragma unroll
        for (int b = 0; b < 3; b++)
#pragma unroll
          for (int r = 0; r < 4; r++) red[(wq * 36 + (a * 3 + b) * 4 + r) * 64 + lane] = acc[a][b][r];
    }
    __syncthreads();
    if (kgrp == 0) {
      const size_t sidx = ((size_t)(s * DEPTH + layer) * 2 + dir) * 4 + h;
#pragma unroll
      for (int a = 0; a < 3; a++)
#pragma unroll
        for (int b = 0; b < 3; b++) {
          f32x4 v = acc[a][b];
#pragma unroll
          for (int r = 0; r < 4; r++) v[r] += red[(wq * 36 + (a * 3 + b) * 4 + r) * 64 + lane];
          if (need_final) {
            float* dst = p.out + (ML ? O_MC : O_SR) + sidx * 9216;
#pragma unroll
            for (int r = 0; r < 4; r++) dst[((dt0 + a) * 16 + 4 * lg + r) * 96 + (et0 + b) * 16 + lr] = v[r];
          } else {
            uint2 o; o.x = pack2(v[0], v[1]); o.y = pack2(v[2], v[3]);
            *(uint2*)(smem + LST + dir * 19968 + ((et0 + b) * 16 + lr) * 208 + ((dt0 + a) * 16 + 4 * lg) * 2) = o;
          }
        }
    }
    if (ML && (tid & 15) == 0) {
      const size_t sidx = ((size_t)(s * DEPTH + layer) * 2 + dir) * 4 + h;
      float f0 = 0.f; const float* n0 = p.state_n;
      if (latent) { f0 = __expf(sc[6 + dir] - Xin); n0 = p.state_n + ((size_t)((lb * DEPTH + layer) * 2 + dir) * 4 + h) * 96; }
#pragma unroll
      for (int it = 0; it < 2; it++) {
        int d = (tid >> 4) + 32 * it;
        if (d < 48) {
          if (need_final) { p.out[O_MN + sidx * 96 + d] = nacc[it][0]; p.out[O_MN + sidx * 96 + d + 48] = nacc[it][1]; }
          else {
            float a0 = nacc[it][0], a1 = nacc[it][1];
            if (latent) { a0 += f0 * n0[d]; a1 += f0 * n0[d + 48]; }
            nin[dir * 96 + d] = a0; nin[dir * 96 + d + 48] = a1;
          }
        }
      }
      if (need_final && tid == 0) p.out[O_MM + sidx] = sc[4 + dir] + sc[2 + dir];
    }
  }
#pragma unroll 1
  for (int orep = 0; orep < REP_OUT; orep++) {
  __syncthreads();
#pragma unroll
  for (int it = 0; it < 2; it++) {
    const int pi = tid + it * 512;
    if (pi < 768) {
      const int r = pi / 6, cc = pi % 6;
      const int pos = P0 + r;
      const bf16_t* pr = p.proj + (size_t)(row0 + pos) * INW + h * 96 + cc * 8;
      uint4 q1 = *(const uint4*)(pr + QOFF), q2 = *(const uint4*)(pr + QOFF + 48);
      uint4 k1 = *(const uint4*)(pr + KOFF), k2 = *(const uint4*)(pr + KOFF + 48);
      float a1[8], a2[8], b1[8], b2[8];
      a1[0] = bflo(q1.x); a1[1] = bfhi(q1.x); a1[2] = bflo(q1.y); a1[3] = bfhi(q1.y); a1[4] = bflo(q1.z); a1[5] = bfhi(q1.z); a1[6] = bflo(q1.w); a1[7] = bfhi(q1.w);
      a2[0] = bflo(q2.x); a2[1] = bfhi(q2.x); a2[2] = bflo(q2.y); a2[3] = bfhi(q2.y); a2[4] = bflo(q2.z); a2[5] = bfhi(q2.z); a2[6] = bflo(q2.w); a2[7] = bfhi(q2.w);
      b1[0] = bflo(k1.x); b1[1] = bfhi(k1.x); b1[2] = bflo(k1.y); b1[3] = bfhi(k1.y); b1[4] = bflo(k1.z); b1[5] = bfhi(k1.z); b1[6] = bflo(k1.w); b1[7] = bfhi(k1.w);
      b2[0] = bflo(k2.x); b2[1] = bfhi(k2.x); b2[2] = bflo(k2.y); b2[3] = bfhi(k2.y); b2[4] = bflo(k2.z); b2[5] = bfhi(k2.z); b2[6] = bflo(k2.w); b2[7] = bfhi(k2.w);
      if (rope) {
        const float* ct = p.rope_cos + pos * 48 + cc * 8; const float* sn = p.rope_sin + pos * 48 + cc * 8;
        const float4 c0 = *(const float4*)ct, c1 = *(const float4*)(ct + 4), s0 = *(const float4*)sn, s1 = *(const float4*)(sn + 4);
        const float cv[8] = {c0.x, c0.y, c0.z, c0.w, c1.x, c1.y, c1.z, c1.w}, sv[8] = {s0.x, s0.y, s0.z, s0.w, s1.x, s1.y, s1.z, s1.w};
#pragma unroll
        for (int q = 0; q < 8; q++) {
          float t1 = a1[q] * cv[q] - a2[q] * sv[q], t2 = a2[q] * cv[q] + a1[q] * sv[q]; a1[q] = t1; a2[q] = t2;
          float u1 = b1[q] * cv[q] - b2[q] * sv[q], u2 = b2[q] * cv[q] + b1[q] * sv[q]; b1[q] = u1; b2[q] = u2;
        }
      }
      uint4 o;
      o.x = pack2(a1[0], a1[1]); o.y = pack2(a1[2], a1[3]); o.z = pack2(a1[4], a1[5]); o.w = pack2(a1[6], a1[7]);
      *(uint4*)(smem + LQ + r * 208 + cc * 16) = o;
      o.x = pack2(a2[0], a2[1]); o.y = pack2(a2[2], a2[3]); o.z = pack2(a2[4], a2[5]); o.w = pack2(a2[6], a2[7]);
      *(uint4*)(smem + LQ + r * 208 + (cc + 6) * 16) = o;
      o.x = pack2(b1[0] * KSCALE, b1[1] * KSCALE); o.y = pack2(b1[2] * KSCALE, b1[3] * KSCALE); o.z = pack2(b1[4] * KSCALE, b1[5] * KSCALE); o.w = pack2(b1[6] * KSCALE, b1[7] * KSCALE);
      *(uint4*)(smem + LK + r * 208 + cc * 16) = o;
      o.x = pack2(b2[0] * KSCALE, b2[1] * KSCALE); o.y = pack2(b2[2] * KSCALE, b2[3] * KSCALE); o.z = pack2(b2[4] * KSCALE, b2[5] * KSCALE); o.w = pack2(b2[6] * KSCALE, b2[7] * KSCALE);
      *(uint4*)(smem + LK + r * 208 + (cc + 6) * 16) = o;
    }
  }
#pragma unroll
  for (int it = 0; it < 3; it++) {
    const int ci = tid + it * 512, e = ci >> 4, cc = ci & 15;
    uint4 v = *(const uint4*)(vtg + (size_t)e * T + P0 + cc * 8);
    *(uint4*)(smem + LVT + e * 256 + ((cc ^ (e & 15)) << 4)) = v;
  }
  __syncthreads();
  {
    const int i0 = wid * 16, il = i0 + lr;
    bf16x8 qf[3];
#pragma unroll
    for (int ks = 0; ks < 3; ks++) qf[ks] = *(const bf16x8*)(smem + LQ + il * 208 + (ks * 4 + lg) * 16);
    f32x4 pt[8];
#pragma unroll
    for (int jt = 0; jt < 8; jt++) {
      f32x4 a4 = zero4();
#pragma unroll
      for (int ks = 0; ks < 3; ks++) {
        bf16x8 kf = *(const bf16x8*)(smem + LK + (jt * 16 + lr) * 208 + (ks * 4 + lg) * 16);
        a4 = __builtin_amdgcn_mfma_f32_16x16x32_bf16(kf, qf[ks], a4, 0, 0, 0);
      }
      pt[jt] = a4;
      __builtin_amdgcn_sched_barrier(0);
    }
    constexpr int ND = ML ? 2 : 1;
    f32x4 o[ND][6];
    float den[2] = {0.f, 0.f};
    float xo[2] = {0.f, 0.f};
    if (ML) { xo[0] = Xo[il]; xo[1] = Xo[128 + il]; }
#pragma unroll
    for (int dd = 0; dd < ND; dd++) {
      bf16x8 pop[4];
#pragma unroll
      for (int jt2 = 0; jt2 < 4; jt2++) {
        float v[8];
#pragma unroll
        for (int q = 0; q < 8; q++) {
          const int jt = jt2 * 2 + (q >> 2), r = q & 3;
          const int jl = jt * 16 + 4 * lg + r;
          float w;
          if (!ML) {
            const int df = il - jl;
            w = df > 0 ? __builtin_amdgcn_exp2f((float)df * lgd0) : (df < 0 ? __builtin_amdgcn_exp2f((float)(-df) * lgd1) : 2.f);
          } else {
            const float e = Eg[dd * 1024 + P0 + jl];
            const bool ok = dd == 0 ? (jl <= il) : (jl >= il);
            w = ok ? __expf(e - xo[dd]) : 0.f;
          }
          v[q] = pt[jt][r] * w;
          den[dd] += v[q];
        }
        union { bf16x8 v8; uint4 u; } cv;
        cv.u.x = pack2(v[0], v[1]); cv.u.y = pack2(v[2], v[3]); cv.u.z = pack2(v[4], v[5]); cv.u.w = pack2(v[6], v[7]);
        pop[jt2] = cv.v8;
        __builtin_amdgcn_sched_barrier(0);
      }
#pragma unroll
      for (int et = 0; et < 6; et++) {
        f32x4 a4 = zero4();
        const int row = et * 16 + lr;
#pragma unroll
        for (int jt2 = 0; jt2 < 4; jt2++) {
          const int ch0 = jt2 * 4 + (lg >> 1), ch1 = ch0 + 2;
          union { bf16x8 v8; uint2 h2[2]; } vf;
          vf.h2[0] = *(const uint2*)(smem + LVT + row * 256 + ((ch0 ^ (row & 15)) << 4) + (lg & 1) * 8);
          vf.h2[1] = *(const uint2*)(smem + LVT + row * 256 + ((ch1 ^ (row & 15)) << 4) + (lg & 1) * 8);
          a4 = __builtin_amdgcn_mfma_f32_16x16x32_bf16(vf.v8, pop[jt2], a4, 0, 0, 0);
        }
        o[dd][et] = a4;
        __builtin_amdgcn_sched_barrier(0);
      }
    }
#pragma unroll
    for (int dir = 0; dir < 2; dir++) {
      float scale;
      if (!ML) scale = dir == 0 ? __builtin_amdgcn_exp2f((float)(il + 1) * lgd0) : __builtin_amdgcn_exp2f((float)(128 - il) * lgd1);
      else scale = __expf(sc[0 + dir] - xo[dir]);
#pragma unroll
      for (int et = 0; et < 6; et++) {
        f32x4 a4 = zero4();
#pragma unroll
        for (int ks = 0; ks < 3; ks++) {
          bf16x8 sf = *(const bf16x8*)(smem + LST + dir * 19968 + (et * 16 + lr) * 208 + (ks * 4 + lg) * 16);
          a4 = __builtin_amdgcn_mfma_f32_16x16x32_bf16(sf, qf[ks], a4, 0, 0, 0);
        }
        o[ML ? dir : 0][et] = o[ML ? dir : 0][et] + a4 * scale;
        __builtin_amdgcn_sched_barrier(0);
      }
      if (ML) {
        float dq = 0.f;
#pragma unroll
        for (int ks = 0; ks < 3; ks++) {
          union { bf16x8 v8; uint4 u; } cv; cv.v8 = qf[ks];
          const float* nn = nin + dir * 96 + ks * 32 + lg * 8;
          dq += bflo(cv.u.x) * nn[0] + bfhi(cv.u.x) * nn[1] + bflo(cv.u.y) * nn[2] + bfhi(cv.u.y) * nn[3] + bflo(cv.u.z) * nn[4] + bfhi(cv.u.z) * nn[5] + bflo(cv.u.w) * nn[6] + bfhi(cv.u.w) * nn[7];
        }
        den[dir] += scale * dq;
      }
    }
    f32x4 of[6];
    if (ML) {
      float nrm[2];
#pragma unroll
      for (int dir = 0; dir < 2; dir++) {
        float dsum = den[dir];
        dsum += __shfl_xor(dsum, 16); dsum += __shfl_xor(dsum, 32);
        const float M = Bo[dir * 128 + il] + xo[dir];
        nrm[dir] = __builtin_amdgcn_rcpf(fmaxf(fabsf(dsum), __expf(-M)));
      }
#pragma unroll
      for (int et = 0; et < 6; et++) of[et] = o[0][et] * nrm[0] + o[ND - 1][et] * nrm[1];
    } else {
#pragma unroll
      for (int et = 0; et < 6; et++) of[et] = o[0][et];
    }
    float ss = 0.f;
#pragma unroll
    for (int et = 0; et < 6; et++) ss += of[et][0] * of[et][0] + of[et][1] * of[et][1] + of[et][2] * of[et][2] + of[et][3] * of[et][3];
    ss += __shfl_xor(ss, 16); ss += __shfl_xor(ss, 32);
    const float rs = rsqrtf(ss * (1.f / 96.f) + EPS);
    const int row = row0 + P0 + il;
    const float* ng = (ML ? p.ml_norm_g : p.ret_norm_g) + layer * 384 + h * 96;
#pragma unroll
    for (int et = 0; et < 6; et++) {
      const int e0 = et * 16 + 4 * lg;
      const uint2 gg = *(const uint2*)(p.proj + (size_t)row * INW + GOFF + h * 96 + e0);
      const float4 n4 = *(const float4*)(ng + e0);
      float g[4] = {bflo(gg.x), bfhi(gg.x), bflo(gg.y), bfhi(gg.y)};
      float r4[4];
      const float nv[4] = {n4.x, n4.y, n4.z, n4.w};
#pragma unroll
      for (int r = 0; r < 4; r++) {
        const float gv = ML ? sigmoidf_(g[r]) : g[r] * sigmoidf_(g[r]);
        r4[r] = of[et][r] * rs * nv[r] * gv;
      }
      uint2 ov; ov.x = pack2(r4[0], r4[1]); ov.y = pack2(r4[2], r4[3]);
      *(uint2*)(p.mixed + (size_t)row * D + MOFF + h * 96 + e0) = ov;
    }
  }
  }
}

constexpr int HZ = 0, HX = 61440, HF = 94208, HO = 127488;
constexpr int FT_CTX = 2 * 256 * 2 * 512, FT_L = FT_CTX + 2 * 256 * 2 * 2048;
typedef float f32x16 __attribute__((ext_vector_type(16)));

__device__ __forceinline__ void hyena_unit(PR p, int layer, int path, int cg, char* smem) {
  const int tid = TIDX, lane = tid & 63, wid = tid >> 6;
  const int L = path ? 1024 : 256, lgL = path ? 10 : 8, NB = path ? 2 : 16, CH = path ? 4 : 2;
  const int c0 = cg * CH, ntok = NB * L, lgnt8 = path ? 8 : 9, tok0 = path ? TC : 0;
  const int ZL = 3 * L + ((3 * L) >> 2), ZO = L - 32;
  __syncthreads();
  u32x4 cvv[6]; unsigned hl[6], hr[6]; float cw0[6], cw1[6], cw2[6], cbb[6];
#pragma unroll
  for (int it = 0; it < 6; it++) {
    const int ci = tid + it * NT;
    const int t8 = ci & ((ntok >> 3) - 1), rest = ci >> lgnt8, arr = rest % 3, ch = rest / 3;
    const int tk = t8 * 8, tl = tk & (L - 1);
    const int col = arr * 256 + c0 + ch;
    const bf16_t* src = p.hyt + (size_t)col * T + tok0 + tk;
    cvv[it] = __builtin_nontemporal_load((const u32x4*)src);
    hl[it] = *(const unsigned short*)(src + (tl > 0 ? -1 : 0)); hr[it] = *(const unsigned short*)(src + (tl + 8 < L ? 8 : 7));
    cw0[it] = p.hy_conv_w[(layer * 3 + 0) * 768 + col]; cw1[it] = p.hy_conv_w[(layer * 3 + 1) * 768 + col]; cw2[it] = p.hy_conv_w[(layer * 3 + 2) * 768 + col]; cbb[it] = p.hy_conv_b[layer * 768 + col];
  }
  u32x4 fv[4];
#define HY_FLOAD(order_) { const int nch_ = CH * 2 * (L >> 2); \
    _Pragma("unroll") for (int j = 0; j < 4; j++) { const int ci = tid + j * NT; fv[j] = (u32x4){0u, 0u, 0u, 0u}; \
      if (ci < nch_) { const int u8 = ci & ((L >> 2) - 1), rest = ci >> (lgL - 2), cp = rest & 1, fc = rest >> 1; \
        fv[j] = __builtin_nontemporal_load((const u32x4*)(p.ft + (size_t)layer * FT_L + (path ? FT_CTX : 0) + ((size_t)(((order_) * 256 + c0 + fc) * 2 + cp) * 2 * L) + u8 * 8)); } } }
  HY_FLOAD(0);
  { unsigned zz_ = 0u; asm volatile("" : "+v"(zz_)); const uint4 z4_ = make_uint4(zz_, zz_, zz_, zz_);
    for (int i = tid; i < 61440 / 16; i += NT) ((uint4*)(smem + HZ))[i] = z4_; }
  __syncthreads();
#pragma unroll
  for (int it = 0; it < 6; it++) {
    const int ci = tid + it * NT;
    const int t8 = ci & ((ntok >> 3) - 1), rest = ci >> lgnt8, arr = rest % 3, ch = rest / 3;
    const int tk = t8 * 8, tl = tk & (L - 1), b = tk >> lgL;
    const u32x4 v = cvv[it];
    float x[10];
    x[0] = tl > 0 ? __uint_as_float(hl[it] << 16) : 0.f; x[9] = tl + 8 < L ? __uint_as_float(hr[it] << 16) : 0.f;
    x[1] = bflo(v.x); x[2] = bfhi(v.x); x[3] = bflo(v.y); x[4] = bfhi(v.y); x[5] = bflo(v.z); x[6] = bfhi(v.z); x[7] = bflo(v.w); x[8] = bfhi(v.w);
    float y[8];
#pragma unroll
    for (int q = 0; q < 8; q++) y[q] = cw0[it] * x[q] + cw1[it] * x[q + 1] + cw2[it] * x[q + 2] + cbb[it];
    uint4 o; o.x = pack2(y[0], y[1]); o.y = pack2(y[2], y[3]); o.z = pack2(y[4], y[5]); o.w = pack2(y[6], y[7]);
    if (arr == 0) { const int idx = ZO + tl, phys = idx + 8 * (idx >> 5); *(uint4*)(smem + HZ + ((ch * NB + b) * ZL + phys) * 2) = o; }
    else *(uint4*)(smem + HX + ((ch * 2 + arr - 1) * ntok + tk) * 2) = o;
  }
  const int cl = lane & 31, hh = lane >> 5;
  int ch, b, I;
  if (path) { ch = wid >> 1; b = wid & 1; I = cl; } else { ch = wid >> 2; b = (wid & 3) * 4 + (cl >> 3); I = cl & 7; }
  char* zb = smem + HZ + ((ch * NB + b) * ZL) * 2;
  const char* fbase = smem + HF + ((ch * 2 + (cl & 1)) * (2 * L + 32)) * 2;
#pragma unroll 1
  for (int order = 0; order < 2; order++) {
    {
      const int nch = CH * 2 * (L >> 2);
#pragma unroll
      for (int j = 0; j < 4; j++) {
        const int ci = tid + j * NT;
        if (ci < nch) {
          const int u8 = ci & ((L >> 2) - 1), rest = ci >> (lgL - 2), cp = rest & 1, fc = rest >> 1;
          *(u32x4*)(smem + HF + ((fc * 2 + cp) * (2 * L + 32) + u8 * 8) * 2) = fv[j];
        }
      }
    }
    __syncthreads();
    if (order == 0) HY_FLOAD(1);
    f32x16 acc;
#pragma unroll
    for (int r = 0; r < 16; r++) acc[r] = 0.f;
#pragma unroll 2
    for (int dl = -L + 16; dl <= L - 32; dl += 16) {
      const int u0 = L - dl - cl + 8 * hh - (cl & 1);
      const unsigned* fp = (const unsigned*)(fbase + u0 * 2);
      union { bf16x8 v8; unsigned u[4]; } af;
      af.u[0] = fp[0]; af.u[1] = fp[1]; af.u[2] = fp[2]; af.u[3] = fp[3];
      const int idx = ZO + 32 * I - dl + 8 * hh, phys = idx + 8 * (idx >> 5);
      const bf16x8 bfr = *(const bf16x8*)(zb + phys * 2);
      acc = __builtin_amdgcn_mfma_f32_32x32x16_bf16(af.v8, bfr, acc, 0, 0, 0);
    }
    __syncthreads();
    const float bias = p.hy_bias[(layer * 2 + order) * 256 + c0 + ch];
#pragma unroll
    for (int g = 0; g < 4; g++) {
      const int t = 32 * I + 8 * g + 4 * hh;
      const int idx = ZO + t, phys = idx + 8 * (idx >> 5);
      const uint2 z4 = *(const uint2*)(zb + phys * 2);
      const uint2 h4 = *(const uint2*)(smem + HX + ((ch * 2 + order) * ntok + b * L + t) * 2);
      const float zz[4] = {bflo(z4.x), bfhi(z4.x), bflo(z4.y), bfhi(z4.y)};
      const float hx[4] = {bflo(h4.x), bfhi(h4.x), bflo(h4.y), bfhi(h4.y)};
      float r4[4];
#pragma unroll
      for (int r = 0; r < 4; r++) r4[r] = hx[r] * (acc[4 * g + r] + bias * zz[r]);
      if (order == 0) { uint2 o; o.x = pack2(r4[0], r4[1]); o.y = pack2(r4[2], r4[3]); *(uint2*)(zb + phys * 2) = o; }
      else {
#pragma unroll
        for (int r = 0; r < 4; r++) *(bf16_t*)(smem + HO + ((b * L + t + r) * CH + ch) * 2) = f2bf(r4[r]);
      }
    }
    __syncthreads();
  }
#undef HY_FLOAD
  for (int tk = tid; tk < ntok; tk += NT) {
    bf16_t* dst = p.mixed + (size_t)(tok0 + tk) * D + 384 + c0;
    if (path) *(uint2*)dst = *(const uint2*)(smem + HO + tk * 8);
    else *(unsigned*)dst = *(const unsigned*)(smem + HO + tk * 4);
  }
}

#define XB_TMO      128
#define XB_XCNT(j)  (256  + 64 * (j))
#define XB_XSUB(j)  (1280 + 64 * (j))
#define XB_XGEN(j)  (2304 + 64 * (j))
#define XB_TOP      3328
#define XB_TOPGEN   3392
#define XCD_BAR_WORDS 3456
#define XB_SPIN_CAP (1u << 22)
__device__ __forceinline__ unsigned xb_ld(unsigned* p)              { return __hip_atomic_load(p, __ATOMIC_RELAXED, __HIP_MEMORY_SCOPE_AGENT); }
__device__ __forceinline__ unsigned xb_add(unsigned* p, unsigned v) { return __hip_atomic_fetch_add(p, v, __ATOMIC_RELAXED, __HIP_MEMORY_SCOPE_AGENT); }
__device__ __forceinline__ unsigned xb_xcc_id() { return (unsigned)__builtin_amdgcn_s_getreg((3 << 11) | 20) & 0xFu; }
#define XB_SPIN(cond, bar) do { unsigned _sp = 0; while (cond) { __builtin_amdgcn_s_sleep(1); \
    if ((++_sp & 255u) == 0u) { if (xb_ld(&(bar)[XB_TMO])) break; if (_sp > XB_SPIN_CAP) { atomicAdd(&(bar)[XB_TMO], 1u); break; } } } } while (0)
struct XcdBarrier { unsigned* bar; unsigned x; volatile LAS unsigned* st; };
__device__ __forceinline__ XcdBarrier xcd_barrier_post(unsigned* bar, volatile LAS unsigned* st) {
    XcdBarrier b; b.bar = bar; b.x = xb_xcc_id(); b.st = st;
    if (threadIdx.x == 0) (void)xb_add(&bar[XB_XCNT(b.x)], 1u);
    return b;
}
__device__ __forceinline__ void xcd_barrier_complete(unsigned* bar, unsigned x, unsigned& nloc, unsigned& nx) {
    const unsigned G = gridDim.x * gridDim.y * gridDim.z;
    unsigned sum, cnt, mine, sp = 0u;
    for (;;) {
        sum = 0u; cnt = 0u; mine = 0u;
#pragma unroll
        for (unsigned j = 0; j < 16; ++j) { const unsigned c = xb_ld(&bar[XB_XCNT(j)]); sum += c; cnt += (c > 0u) ? 1u : 0u; mine = (j == x) ? c : mine; }
        if (sum == G) break;
        __builtin_amdgcn_s_sleep(1);
        if ((++sp & 255u) == 0u) { if (xb_ld(&bar[XB_TMO])) break; if (sp > XB_SPIN_CAP) { atomicAdd(&bar[XB_TMO], 1u); break; } }
    }
    nloc = mine > 0u ? mine : 1u; nx = cnt > 0u ? cnt : 1u;
}
__device__ __forceinline__ void xcd_barrier(const XcdBarrier& b) {
    asm volatile("s_waitcnt vmcnt(0)" ::: "memory");
    __syncthreads();
    if (TIDX == 0) {
        unsigned* bar = b.bar;
        __builtin_amdgcn_s_waitcnt(0);
        unsigned nloc = b.st[0], nx = b.st[1];
        if (nloc == 0u) { xcd_barrier_complete(bar, b.x, nloc, nx); b.st[0] = nloc; b.st[1] = nx; }
        const unsigned old = xb_add(&bar[XB_XSUB(b.x)], 1u);
        const unsigned gen = old / nloc;
        if (old + 1u == (gen + 1u) * nloc) {
            __builtin_amdgcn_fence(__ATOMIC_RELEASE, "agent");
            asm volatile("s_waitcnt vmcnt(0)" ::: "memory");
            const unsigned og = xb_add(&bar[XB_TOP], 1u);
            const unsigned tg = og / nx;
            if (og + 1u == (tg + 1u) * nx) xb_add(&bar[XB_TOPGEN], 1u);
            else XB_SPIN(xb_ld(&bar[XB_TOPGEN]) == tg, bar);
            __builtin_amdgcn_fence(__ATOMIC_ACQUIRE, "agent");
            xb_add(&bar[XB_XGEN(b.x)], 1u);
            asm volatile("s_waitcnt vmcnt(0)" ::: "memory");
        } else {
            XB_SPIN(xb_ld(&bar[XB_XGEN(b.x)]) == gen, bar);
            __builtin_amdgcn_fence(__ATOMIC_ACQUIRE, "agent");
            asm volatile("s_waitcnt vmcnt(0)" ::: "memory");
        }
    }
    __syncthreads();
}


constexpr int MIXALL_UNITS = 576;
__device__ __forceinline__ void phase_mix_all(PR p, int layer, int rep, int bid, int nb, char* smem) {
  volatile LAS unsigned* bc = (volatile LAS unsigned*)(smem + SMEM_BYTES - 32);
  unsigned* ctr = p.bar + XCD_BAR_WORDS + layer + 8 * rep;
  for (int first = 1;; first = 0) {
    int u = bid;
    if (!first) {
      __syncthreads();
      if (TIDX == 0) *bc = atomicAdd(ctr, 1u) + (unsigned)nb;
      __syncthreads();
      u = (int)*bc;
    }
    if (u >= MIXALL_UNITS) break;
    int kind, a0 = 0, a1 = 0, a2 = 0;
    if (u < 128) { int v = u & 63; a0 = 16 + (v >> 5); a1 = (v >> 2) & 7; a2 = v & 3; kind = u < 64 ? 0 : 1; }
    else if (u < 192) { kind = 2; a0 = 1; a1 = u - 128; }
    else if (u < 448) { int v = (u - 192) & 127; a0 = v >> 3; a1 = (v >> 2) & 1; a2 = v & 3; kind = u < 320 ? 0 : 1; }
    else { kind = 2; a0 = 0; a1 = u - 448; }
    for (int rr = 0; rr < ((kind == PROBE_KIND) ? 2 : 1); rr++) {
    if (kind == 0) mix_unit<true>(p, layer, a0, a1, a2, smem);
    else if (kind == 1) mix_unit<false>(p, layer, a0, a1, a2, smem);
    else hyena_unit(p, layer, a0, a1, smem);
    }
  }
}


__device__ __forceinline__ void phase_prologue(PR p, char* smem) {
  volatile LAS unsigned* bc = (volatile LAS unsigned*)(smem + SMEM_BYTES - 32);
  unsigned* ctr = p.bar + XCD_BAR_WORDS + 40;
  constexpr int NF = DEPTH * 80, NM = DEPTH * 48, NR = 8, NTR = DEPTH * TR_L, NU = NF + NM + NR + NTR, FSTEP = 10;
  static_assert((NF - 1) * FSTEP < NU, "filter slots");
  for (int first = 1;; first = 0) {
    int u = (int)blockIdx.x;
    if (!first) {
      __syncthreads();
      if (TIDX == 0) *bc = atomicAdd(ctr, 1u) + gridDim.x;
      __syncthreads();
      u = (int)*bc;
    }
    if (u >= NU) break;
    const int fs = u / FSTEP;
    if (u - fs * FSTEP == 0 && fs < NF) { phase_filt(p, fs, 1 << 30, smem); continue; }
    const int v = u - (fs + 1 < NF ? fs + 1 : NF);
    if (v < NM) phase_mod(p, v, 1 << 30, smem);
    else if (v < NM + NR) phase_rope(p, v - NM, NR);
    else phase_transpose(p, v - NM - NR, 1 << 30, smem);
  }
}

enum { PH_TRANSPOSE = 0, PH_MOD, PH_ROPE, PH_FILT, PH_S0, PH_INPROJ, PH_RET, PH_ML, PH_RETST, PH_MLST, PH_HY1, PH_HY2A, PH_HY2B, PH_OUTPROJ, PH_S1, PH_UP, PH_ACT, PH_DOWN, PH_MIXF, PH_MIXALL, PH_OUTPROJ_F, PH_DOWN_F };

template <int ph>
__device__ __forceinline__ void run_phase(PR p, int layer, int bid, int nb, char* smem) {
  switch (ph) {
    case PH_TRANSPOSE: phase_transpose(p, bid, nb, smem); break;
    case PH_MOD: phase_mod(p, bid, nb, smem); break;
    case PH_ROPE: phase_rope(p, bid, nb); break;
    case PH_FILT: phase_filt(p, bid, nb, smem); break;
    case PH_S0: phase_rowpass(p, layer, 0, bid, nb); break;
    case PH_S1: phase_rowpass(p, layer, 1, bid, nb); break;
    case PH_INPROJ: {
      EpiProj e{p.proj, p.ktr, p.vtr, p.ktm, p.vtm, p.hyt, p.gates};
      phase_gemm<192, 256, USE_GLDS, EpiProj>(p.hbuf, p.wt_in + (size_t)layer * INWP * D, T, INWP, D, bid, nb, smem, e);
    } break;
    case PH_MIXALL: phase_mix_all(p, layer & 7, layer >> 3, bid, nb, smem); break;
    case PH_OUTPROJ: {
      EpiF32 e{p.raw, D};
      phase_gemm<192, 128, USE_GLDS, EpiF32>(p.mixed, p.wt_out + (size_t)layer * D * D, T, D, D, bid, nb, smem, e);
    } break;
    case PH_OUTPROJ_F: {
      const int slotid = layer * 2;
      EpiRow e{p.xbuf, p.x1buf, p.hbuf, p.mod + (size_t)layer * 3 * 6144, 2 * 1024, p.norm_mix_post + layer * D,
               p.mod + (size_t)layer * 3 * 6144, 3 * 1024, p.norm_ffn_pre + layer * D,
               p.rstats, (unsigned)(slotid + 1), p.bar + XCD_BAR_WORDS + 64 + 8 * 32 * 16};
      phase_gemm<192, 128, 2, EpiRow>(p.mixed, p.wt_out + (size_t)layer * D * D, T, D, D, bid, nb, smem, e);
    } break;
    case PH_DOWN_F: {
      const int slotid = layer * 2 + 1;
      const bool last = layer + 1 >= DEPTH;
      const int ln = last ? layer : layer + 1;
      EpiRow e{p.x1buf, last ? p.out : p.xbuf, last ? (bf16_t*)nullptr : p.hbuf, p.mod + (size_t)layer * 3 * 6144, 5 * 1024, p.norm_ffn_post + layer * D,
               p.mod + (size_t)ln * 3 * 6144, 0, p.norm_mix_pre + ln * D,
               p.rstats, (unsigned)(slotid + 1), p.bar + XCD_BAR_WORDS + 64 + 8 * 32 * 16};
      phase_gemm<192, 128, 2, EpiRow>(p.ubuf, p.wt_down + (size_t)layer * D * DFF, T, D, DFF, bid, nb, smem, e);
    } break;
    case PH_UP: {
      EpiUp e{p.ubuf, p.hbuf, p.wt_up + (size_t)layer * 2 * DFF * D, p.ffn_conv_w + (size_t)layer * 3 * DFF, p.ffn_conv_b + (size_t)layer * DFF};
#if UP8
      gemm_up8(p.hbuf, p.wt_up + (size_t)layer * 2 * DFF * D, bid, nb, smem, e);
#else
      phase_gemm<256, 256, USE_GLDS, EpiUp>(p.hbuf, p.wt_up + (size_t)layer * 2 * DFF * D, T, 2 * DFF, D, bid, nb, smem, e);
#endif
    } break;
    case PH_DOWN: {
      EpiF32 e{p.raw, D};
      phase_gemm<192, 128, USE_GLDS, EpiF32>(p.ubuf, p.wt_down + (size_t)layer * D * DFF, T, D, DFF, bid, nb, smem, e);
    } break;
  }
}

#ifndef MULTI_LAUNCH
#define MULTI_LAUNCH 0
#endif
__global__ void __launch_bounds__(NT) k_mega(Params p_) {
  extern __shared__ __attribute__((aligned(16))) char smem[];
  const int bid = blockIdx.x, nb = gridDim.x;
  volatile LAS unsigned* st = (volatile LAS unsigned*)(smem + SMEM_BYTES - 16);
  if (TIDX == 0) { st[0] = 0u; st[1] = 0u; st[2] = 0u; st[3] = 0u; }
  __syncthreads();
  (void)xcd_barrier_post(get_params()->bar, st);
#define BAR() { XcdBarrier xb_; xb_.bar = get_params()->bar; xb_.x = xb_xcc_id(); xb_.st = st; xcd_barrier(xb_); }
  phase_prologue(*get_params(), smem);
  BAR();
  run_phase<PH_S0>(*get_params(), 0, bid, nb, smem);
  BAR();
  for (int l = 0; l < DEPTH; l++) {
    for (int rep = 0; rep < REP_G1; rep++) { run_phase<PH_INPROJ>(*get_params(), l, bid, nb, smem); BAR(); }
    for (int rep = 0; rep < REP_MIX; rep++) { run_phase<PH_MIXALL>(*get_params(), l + 8 * rep, bid, nb, smem); BAR(); }
    for (int rep = 0; rep < REP_BAR; rep++) BAR();
    for (int rep = 0; rep < REP_G2; rep++) { run_phase<PH_OUTPROJ_F>(*get_params(), l, bid, nb, smem); BAR(); }
    for (int rep = 0; rep < REP_G3; rep++) { run_phase<PH_UP>(*get_params(), l, bid, nb, smem); BAR(); }
    for (int rep = 0; rep < REP_G4; rep++) { run_phase<PH_DOWN_F>(*get_params(), l, bid, nb, smem); if (rep + 1 < REP_G4) BAR(); }
    if (l + 1 < DEPTH) BAR();
  }
}

static inline size_t align_up(size_t x) { return (x + 255) & ~(size_t)255; }

extern "C" void kernel_launch(void* const* d_in, const int* in_sizes, int n_in, void* d_out, int out_size, void* d_ws, size_t ws_size, hipStream_t stream) {
  Params p{};
  const float* const* in = (const float* const*)d_in;
  p.x_prompt = in[0]; p.x_sample = in[1]; p.c = in[2]; p.state_ret = in[3]; p.state_c = in[4]; p.state_n = in[5]; p.state_m = in[6]; p.c_ctx = in[7];
  p.norm_mix_pre = in[8]; p.norm_mix_post = in[9]; p.norm_ffn_pre = in[10]; p.norm_ffn_post = in[11]; p.w_mod = in[12]; p.b_mod = in[13]; p.w_in = in[14]; p.w_out = in[15];
  p.ret_decay_logit = in[16]; p.ret_norm_g = in[17]; p.hy_conv_w = in[18]; p.hy_conv_b = in[19]; p.hy_f_w1 = in[20]; p.hy_f_b1 = in[21]; p.hy_f_w2 = in[22]; p.hy_f_b2 = in[23];
  p.hy_f_w3 = in[24]; p.hy_f_b3 = in[25]; p.hy_sin_freq = in[26]; p.hy_bias = in[27]; p.ml_gate_bias = in[28]; p.ml_norm_g = in[29];
  p.w_up = in[30]; p.ffn_conv_w = in[31]; p.ffn_conv_b = in[32]; p.w_down = in[33];
  p.out = (float*)d_out;
  char* w = (char*)d_ws; size_t off = 0;
  auto take = [&](size_t bytes) { char* r = w + off; off = align_up(off + bytes); return r; };
  p.wt_in = (bf16_t*)take((size_t)DEPTH * INWP * D * 2);
  p.wt_out = (bf16_t*)take((size_t)DEPTH * D * D * 2);
  p.wt_up = (bf16_t*)take((size_t)DEPTH * 2 * DFF * D * 2);
  p.wt_down = (bf16_t*)take((size_t)DEPTH * D * DFF * 2);
  p.mod = (float*)take((size_t)DEPTH * 3 * 6144 * 4);
  p.rope_cos = (float*)take(1024 * 48 * 4); p.rope_sin = (float*)take(1024 * 48 * 4);
  p.rope_cosT = (float*)take(1024 * 48 * 4); p.rope_sinT = (float*)take(1024 * 48 * 4);
  p.xbuf = (float*)take((size_t)T * D * 4); p.x1buf = (float*)take((size_t)T * D * 4); p.raw = (float*)take((size_t)T * D * 4);
  p.hbuf = (bf16_t*)take((size_t)T * D * 2);
  p.ubuf = (bf16_t*)take((size_t)T * DFF * 2);
  p.proj = (bf16_t*)take((size_t)T * INW * 2);
  p.ktr = (bf16_t*)take((size_t)384 * T * 2); p.vtr = (bf16_t*)take((size_t)384 * T * 2);
  p.ktm = (bf16_t*)take((size_t)384 * T * 2); p.vtm = (bf16_t*)take((size_t)384 * T * 2);
  p.hyt = (bf16_t*)take((size_t)768 * T * 2);
  p.mixed = (bf16_t*)take((size_t)T * D * 2);
  p.gates = (float*)take((size_t)T * 16 * 4);
  p.ft = (bf16_t*)take((size_t)DEPTH * (2 * 256 * 2 * 512 + 2 * 256 * 2 * 2048) * 2);
  p.bar = (unsigned*)take((XCD_BAR_WORDS + 64 + 8 * 32 * 16 + 16) * 4);
  p.rstats = (unsigned long long*)take((size_t)8 * 32 * 192 * 8 * 2 * 8);
  if (off > ws_size) { fprintf(stderr, "workspace too small: need %zu have %zu\n", off, ws_size); return; }

  {
    static int grid = 0;
    if (grid == 0) {
      int dev = 0, cus = 0;
      if (hipGetDevice(&dev) != hipSuccess || hipDeviceGetAttribute(&cus, hipDeviceAttributeMultiprocessorCount, dev) != hipSuccess || cus <= 0) { fprintf(stderr, "device query failed\n"); grid = -1; return; }
      if (hipFuncSetAttribute((const void*)k_mega, hipFuncAttributeMaxDynamicSharedMemorySize, SMEM_BYTES) != hipSuccess) { fprintf(stderr, "hipFuncSetAttribute failed\n"); grid = -1; return; }
      grid = cus;
    }
    if (grid < 0) return;
    if (hipMemsetAsync(p.bar, 0, (XCD_BAR_WORDS + 64 + 8 * 32 * 16 + 16) * 4, stream) != hipSuccess) { fprintf(stderr, "memset failed\n"); return; }
    p.fuse_rows = 1; p.pad_ = 0;
    if (grid < 256) { fprintf(stderr, "this kernel needs >= 256 CUs (one resident workgroup per column tile of the fused residual epilogues)\n"); return; }
    hipLaunchKernelGGL(k_mega, dim3(grid), dim3(NT), SMEM_BYTES, stream, p);
  }
}
```

```cpp
#include <hip/hip_runtime.h>
#include <stdint.h>
#include <stdio.h>

#define NT 512
#define LAS __attribute__((address_space(3)))
constexpr int SMEM_BYTES = 147456;
typedef unsigned short bf16_t;
typedef short bf16x8 __attribute__((ext_vector_type(8)));
typedef float f32x4 __attribute__((ext_vector_type(4)));
typedef unsigned u32x4 __attribute__((ext_vector_type(4)));

constexpr int D = 1024, T = 6144, TC = 4096, DEPTH = 4;
constexpr int INW = 3856, INWP = 4096, DFF = 4096;
constexpr float EPS = 1e-6f;
constexpr size_t O_YP = 0, O_YS = 4194304, O_SR = 6291456, O_MC = 11010048, O_MN = 15728640, O_MM = 15777792;

#ifndef REP_MIX
#define REP_MIX 1
#endif
#ifndef REP_ELT
#define REP_ELT 1
#endif
#ifndef REP_BAR
#define REP_BAR 0
#endif
#ifndef REP_TR
#define REP_TR 1
#endif
#ifndef REP_MOD
#define REP_MOD 1
#endif
#ifndef REP_FILT
#define REP_FILT 1
#endif
#ifndef REP_STATE
#define REP_STATE 1
#endif
#ifndef REP_OUT
#define REP_OUT 1
#endif
#ifndef UP8
#define UP8 1
#endif
#ifndef USE_GLDS
#define USE_GLDS 1
#endif
#ifndef PROBE_KIND
#define PROBE_KIND 9
#endif
#ifndef REP_EPI
#define REP_EPI 1
#endif
#ifndef REP_G1
#define REP_G1 1
#endif
#ifndef REP_G2
#define REP_G2 1
#endif
#ifndef REP_G3
#define REP_G3 1
#endif
#ifndef REP_G4
#define REP_G4 1
#endif
#ifndef NAIVE_MIX
#define NAIVE_MIX 0
#endif
#ifndef NAIVE_GEMM
#define NAIVE_GEMM 0
#endif

struct Params {
  const float *x_prompt, *x_sample, *c, *state_ret, *state_c, *state_n, *state_m, *c_ctx;
  const float *norm_mix_pre, *norm_mix_post, *norm_ffn_pre, *norm_ffn_post, *w_mod, *b_mod, *w_in, *w_out;
  const float *ret_decay_logit, *ret_norm_g, *hy_conv_w, *hy_conv_b, *hy_f_w1, *hy_f_b1, *hy_f_w2, *hy_f_b2, *hy_f_w3, *hy_f_b3, *hy_sin_freq, *hy_bias, *ml_gate_bias, *ml_norm_g;
  const float *w_up, *ffn_conv_w, *ffn_conv_b, *w_down;
  float* out;
  bf16_t *wt_in, *wt_out, *wt_up, *wt_down;
  float *mod, *rope_cos, *rope_sin, *rope_cosT, *rope_sinT;
  float *xbuf, *x1buf, *raw;
  bf16_t *hbuf, *proj, *ktr, *vtr, *ktm, *vtm, *hyt, *mixed, *ubuf;
  float *gates;
  bf16_t* ft;
  unsigned* bar;
  unsigned long long* rstats;
  int fuse_rows; int pad_;
};

#define CONSTAS __attribute__((address_space(4)))
typedef const CONSTAS Params& PR;
__device__ __forceinline__ const CONSTAS Params* get_params() {
  const CONSTAS Params* pp = (const CONSTAS Params*)__builtin_amdgcn_kernarg_segment_ptr();
  asm volatile("" : "+s"(pp));
  return pp;
}
__device__ __forceinline__ int opaque_tid() { int t = threadIdx.x; asm volatile("" : "+v"(t)); return t; }
#define TIDX opaque_tid()

__device__ __forceinline__ unsigned cvt_pk_bf16(float lo, float hi) { unsigned r; asm("v_cvt_pk_bf16_f32 %0, %1, %2" : "=v"(r) : "v"(lo), "v"(hi)); return r; }
__device__ __forceinline__ bf16_t f2bf(float f) { return (bf16_t)(cvt_pk_bf16(f, 0.f) & 0xffffu); }
__device__ __forceinline__ float bf2f(bf16_t h) { return __uint_as_float(((unsigned)h) << 16); }
__device__ __forceinline__ float bflo(unsigned u) { return __uint_as_float(u << 16); }
__device__ __forceinline__ float bfhi(unsigned u) { return __uint_as_float(u & 0xffff0000u); }
__device__ __forceinline__ unsigned pack2(float a, float b) { return cvt_pk_bf16(a, b); }
__device__ __forceinline__ f32x4 zero4() { float z = 0.f; asm volatile("" : "+v"(z)); return (f32x4){z, z, z, z}; }
__device__ __forceinline__ float row16_sum(float v) {
  v += __int_as_float(__builtin_amdgcn_update_dpp(0, __float_as_int(v), 0xB1, 0xF, 0xF, false));
  v += __int_as_float(__builtin_amdgcn_update_dpp(0, __float_as_int(v), 0x4E, 0xF, 0xF, false));
  v += __int_as_float(__builtin_amdgcn_update_dpp(0, __float_as_int(v), 0x141, 0xF, 0xF, false));
  v += __int_as_float(__builtin_amdgcn_update_dpp(0, __float_as_int(v), 0x140, 0xF, 0xF, false));
  return v;
}
__device__ __forceinline__ float wave_sum(float v) {
  v = row16_sum(v);
  v += __shfl_xor(v, 16); v += __shfl_xor(v, 32);
  return v;
}
__device__ __forceinline__ float sigmoidf_(float x) { return __builtin_amdgcn_rcpf(1.f + __expf(-x)); }
__device__ __forceinline__ float log_sigmoidf_(float x) { return fminf(x, 0.f) - log1pf(__expf(-fabsf(x))); }
__device__ __forceinline__ float gelu_tanh(float x) {
  const float k = 0.7978845608028654f;
  float u = k * (x + 0.044715f * x * x * x);
  return 0.5f * x * (1.f + tanhf(u));
}
__device__ __forceinline__ int seq_len(int s) { return s < 16 ? 256 : 1024; }
__device__ __forceinline__ int seq_row0(int s) { return s < 16 ? s * 256 : TC + (s - 16) * 1024; }
__device__ __forceinline__ int row_mod(int row) { return row < TC ? 0 : 1 + ((row - TC) >> 10); }

template <class RowFn>
__device__ __forceinline__ void tr_batch(const float* __restrict__ src, int K, int N, int k0, int nt0, int cnt, bf16_t* __restrict__ dst, RowFn drow, float* lds) {
  const int tid = TIDX;
  float4 v[4][2];
#pragma unroll
  for (int b = 0; b < 4; b++)
#pragma unroll
    for (int i = 0; i < 2; i++) {
      const int k = (tid >> 4) + 32 * i, n = (nt0 + b) * 64 + (tid & 15) * 4;
      v[b][i] = make_float4(0.f, 0.f, 0.f, 0.f);
      if (b < cnt && n < N) { const f32x4 t_ = __builtin_nontemporal_load((const f32x4*)(src + (size_t)(k0 + k) * N + n)); v[b][i] = make_float4(t_[0], t_[1], t_[2], t_[3]); }
    }
  __syncthreads();
#pragma unroll
  for (int b = 0; b < 4; b++)
#pragma unroll
    for (int i = 0; i < 2; i++) {
      const int k = (tid >> 4) + 32 * i, n4 = (tid & 15) * 4;
      float* l = lds + b * 64 * 65;
      l[(n4 + 0) * 65 + k] = v[b][i].x; l[(n4 + 1) * 65 + k] = v[b][i].y; l[(n4 + 2) * 65 + k] = v[b][i].z; l[(n4 + 3) * 65 + k] = v[b][i].w;
    }
  __syncthreads();
#pragma unroll
  for (int b = 0; b < 4; b++) if (b < cnt) {
    const int n = tid >> 3, kc = (tid & 7) * 8;
    const float* r = lds + b * 64 * 65 + n * 65 + kc;
    uint4 o;
    o.x = pack2(r[0], r[1]); o.y = pack2(r[2], r[3]); o.z = pack2(r[4], r[5]); o.w = pack2(r[6], r[7]);
    __builtin_nontemporal_store((u32x4){o.x, o.y, o.z, o.w}, (u32x4*)(dst + (size_t)(drow(nt0 + b) + n) * K + k0 + kc));
  }
}

constexpr int TR_IN = 16 * 16, TR_OUT = 16 * 4, TR_UP = 16 * 32, TR_DN = 64 * 4, TR_L = TR_IN + TR_OUT + TR_UP + TR_DN;
__device__ __forceinline__ void phase_transpose(PR p, int bid, int nb, char* smem) {
  float* lds = (float*)smem;
  {
    const int u = bid;
    int l = u / TR_L, r = u % TR_L;
    if (r < TR_IN) {
      int kt = r >> 4, nb4 = r & 15;
      tr_batch(p.w_in + (size_t)l * D * INW, D, INW, kt * 64, nb4 * 4, 4, p.wt_in + (size_t)l * INWP * D, [](int nt) { return nt * 64; }, lds);
    } else if ((r -= TR_IN) < TR_OUT) {
      int kt = r >> 2, nb4 = r & 3;
      tr_batch(p.w_out + (size_t)l * D * D, D, D, kt * 64, nb4 * 4, 4, p.wt_out + (size_t)l * D * D, [](int nt) { return nt * 64; }, lds);
    } else if ((r -= TR_OUT) < TR_UP) {
      int kt = r >> 5, nb4 = r & 31;
      tr_batch(p.w_up + (size_t)l * D * 2 * DFF, D, 2 * DFF, kt * 64, nb4 * 4, 4, p.wt_up + (size_t)l * 2 * DFF * D, [](int nt) { return nt < 64 ? (nt >> 1) * 256 + (nt & 1) * 64 : ((nt - 64) >> 1) * 256 + 128 + (nt & 1) * 64; }, lds);
    } else {
      r -= TR_UP;
      int kt = r >> 2, nb4 = r & 3;
      tr_batch(p.w_down + (size_t)l * DFF * D, DFF, D, kt * 64, nb4 * 4, 4, p.wt_down + (size_t)l * D * DFF, [](int nt) { return nt * 64; }, lds);
    }
  }
}

__device__ __forceinline__ void phase_mod(PR p, int bid, int nb, char* smem) {
  float* sv = (float*)smem;
  float* red = sv + 3 * 1024;
  const int tid = TIDX, lane = tid & 63, wid = tid >> 6;
  for (int i = tid; i < 3 * 1024; i += NT) {
    int v = i >> 10, k = i & 1023;
    float x = v == 0 ? p.c_ctx[k] : p.c[(v - 1) * 1024 + k];
    sv[i] = x * sigmoidf_(x);
  }
  __syncthreads();
  {
    const int u = bid;
    int l = u / 48, cb = u % 48;
    int kg = wid * 2 + (lane >> 5), cl = lane & 31;
    const float* w = p.w_mod + (size_t)l * D * 6144 + cb * 128 + cl * 4;
    float acc[3][4] = {};
#pragma unroll 16
    for (int k = kg * 64; k < kg * 64 + 64; k++) {
      const f32x4 wv_ = __builtin_nontemporal_load((const f32x4*)(w + (size_t)k * 6144)); const float4 wv = make_float4(wv_[0], wv_[1], wv_[2], wv_[3]);
#pragma unroll
      for (int v = 0; v < 3; v++) {
        float s = sv[v * 1024 + k];
        acc[v][0] += s * wv.x; acc[v][1] += s * wv.y; acc[v][2] += s * wv.z; acc[v][3] += s * wv.w;
      }
    }
#pragma unroll
    for (int v = 0; v < 3; v++)
#pragma unroll
      for (int j = 0; j < 4; j++) red[(kg * 3 + v) * 128 + cl * 4 + j] = acc[v][j];
    __syncthreads();
    if (tid < 384) {
      int v = tid >> 7, cidx = tid & 127;
      float s = 0.f;
      for (int g = 0; g < 16; g++) s += red[(g * 3 + v) * 128 + cidx];
      int col = cb * 128 + cidx;
      p.mod[((size_t)l * 3 + v) * 6144 + col] = s + p.b_mod[(size_t)l * 6144 + col];
    }
    __syncthreads();
  }
}

__device__ __forceinline__ void phase_rope(PR p, int bid, int nb) {
  for (int i = bid * NT + TIDX; i < 1024 * 48; i += nb * NT) {
    int pos = i / 48, j = i % 48;
    int f = j < 24 ? j : j - 24;
    float base = j < 24 ? (float)(pos >> 6) : (float)(pos & 63);
    float freq = __builtin_amdgcn_exp2f(-(float)f * (13.287712379549449f / 24.f));
    float a = base * freq;
    float cv = cosf(a), sv = sinf(a);
    p.rope_cos[i] = cv; p.rope_sin[i] = sv; p.rope_cosT[j * 1024 + pos] = cv; p.rope_sinT[j * 1024 + pos] = sv;
  }
}

constexpr int FT_CTX_ = 2 * 256 * 2 * 512, FT_L_ = FT_CTX_ + 2 * 256 * 2 * 2048;
#define FSIN(x) __builtin_amdgcn_sinf((x) * 0.15915494309189535f)
__device__ __forceinline__ void phase_filt(PR p, int bid, int nb, char* smem) {
  float* feat = (float*)smem;
  float* h1 = feat + 128 * 33;
  float* h2 = h1 + 128 * 64;
  float* w3s = h2 + 128 * 65;
  float* w1s = w3s + 64 * 128;
  float* w2s = w1s + 33 * 64;
  const int tid = TIDX, lane = tid & 63, wid = tid >> 6;
  {
    const int u = bid;
    const int l = u / 80, r = u % 80;
    const int path = r < 16 ? 0 : 1;
    const int Lp = path ? 1024 : 256;
    const int pb = path ? (r - 16) >> 3 : r >> 3, nblk = r & 7;
    const int pos0 = pb * 128;
    __syncthreads();
    for (int i = tid; i < 128 * 33; i += NT) {
      int pp = i / 33, j = i % 33;
      float tn = (float)(pos0 + pp) / (float)Lp;
      float v;
      if (j == 0) v = tn;
      else {
        int bi = (j - 1) & 15;
        float band = 1e-4f + (float)bi * ((15.f - 1e-4f) / 15.f);
        const float rev = tn * band;
        v = j <= 16 ? __builtin_amdgcn_cosf(rev) : __builtin_amdgcn_sinf(rev);
      }
      feat[i] = v;
    }
    {
      float4 t3[4], t1[2], t2[2];
#pragma unroll
      for (int j = 0; j < 4; j++) { const int i4 = tid + j * NT, k = i4 >> 5, n4 = i4 & 31; t3[j] = *(const float4*)(p.hy_f_w3 + ((size_t)l * 64 + k) * 1024 + nblk * 128 + n4 * 4); }
#pragma unroll
      for (int j = 0; j < 2; j++) { const int i4 = tid + j * NT; t1[j] = i4 < 528 ? *(const float4*)(p.hy_f_w1 + (size_t)l * 33 * 64 + i4 * 4) : make_float4(0.f, 0.f, 0.f, 0.f); t2[j] = *(const float4*)(p.hy_f_w2 + (size_t)l * 64 * 64 + i4 * 4); }
#pragma unroll
      for (int j = 0; j < 4; j++) *(float4*)(w3s + (tid + j * NT) * 4) = t3[j];
#pragma unroll
      for (int j = 0; j < 2; j++) { const int i4 = tid + j * NT; if (i4 < 528) *(float4*)(w1s + i4 * 4) = t1[j]; *(float4*)(w2s + i4 * 4) = t2[j]; }
    }
    __syncthreads();
    {
      const int jq = tid & 15, pg = tid >> 4;
      float acc[4][4];
      {
        const float4 b1 = *(const float4*)(p.hy_f_b1 + l * 64 + 4 * jq);
#pragma unroll
        for (int pp = 0; pp < 4; pp++) { acc[pp][0] = b1.x; acc[pp][1] = b1.y; acc[pp][2] = b1.z; acc[pp][3] = b1.w; }
      }
#pragma unroll 3
      for (int k = 0; k < 33; k++) {
        const float4 w = *(const float4*)(w1s + k * 64 + 4 * jq);
#pragma unroll
        for (int pp = 0; pp < 4; pp++) { const float f = feat[(pg * 4 + pp) * 33 + k]; acc[pp][0] += f * w.x; acc[pp][1] += f * w.y; acc[pp][2] += f * w.z; acc[pp][3] += f * w.w; }
      }
      const float4 fr = *(const float4*)(p.hy_sin_freq + l * 64 + 4 * jq);
#pragma unroll
      for (int pp = 0; pp < 4; pp++)
        *(float4*)(h1 + (pg * 4 + pp) * 64 + 4 * jq) = make_float4(FSIN(fr.x * acc[pp][0]), FSIN(fr.y * acc[pp][1]), FSIN(fr.z * acc[pp][2]), FSIN(fr.w * acc[pp][3]));
    }
    __syncthreads();
    {
      const int jq = tid & 15, pg = tid >> 4;
      float acc[4][4];
      {
        const float4 b2 = *(const float4*)(p.hy_f_b2 + l * 64 + 4 * jq);
#pragma unroll
        for (int pp = 0; pp < 4; pp++) { acc[pp][0] = b2.x; acc[pp][1] = b2.y; acc[pp][2] = b2.z; acc[pp][3] = b2.w; }
      }
#pragma unroll 4
      for (int k = 0; k < 64; k++) {
        const float4 w = *(const float4*)(w2s + k * 64 + 4 * jq);
#pragma unroll
        for (int pp = 0; pp < 4; pp++) { const float f = h1[(pg * 4 + pp) * 64 + k]; acc[pp][0] += f * w.x; acc[pp][1] += f * w.y; acc[pp][2] += f * w.z; acc[pp][3] += f * w.w; }
      }
      const float4 fr = *(const float4*)(p.hy_sin_freq + l * 64 + 4 * jq);
#pragma unroll
      for (int pp = 0; pp < 4; pp++) {
        float* d = h2 + (pg * 4 + pp) * 65 + 4 * jq;
        d[0] = FSIN(fr.x * acc[pp][0]); d[1] = FSIN(fr.y * acc[pp][1]); d[2] = FSIN(fr.z * acc[pp][2]); d[3] = FSIN(fr.w * acc[pp][3]);
      }
    }
    __syncthreads();
    {
      const int pp = (wid & 1) * 64 + lane, ng = wid >> 1;
      float acc[32];
#pragma unroll
      for (int j = 0; j < 32; j++) acc[j] = 0.f;
#pragma unroll 2
      for (int k = 0; k < 64; k++) {
        const float hv = h2[pp * 65 + k];
        const float4* wr = (const float4*)(w3s + k * 128 + ng * 32);
#pragma unroll
        for (int j4 = 0; j4 < 8; j4++) { const float4 w = wr[j4]; acc[j4 * 4 + 0] += hv * w.x; acc[j4 * 4 + 1] += hv * w.y; acc[j4 * 4 + 2] += hv * w.z; acc[j4 * 4 + 3] += hv * w.w; }
      }
      const int pos = pos0 + pp;
      const float tn = (float)pos / (float)Lp;
      const float lo = logf(0.01f) / 1.5f, hi = logf(0.01f) / 0.3f;
      bf16_t* ftb = p.ft + (size_t)l * FT_L_ + (path ? FT_CTX_ : 0);
#pragma unroll
      for (int j = 0; j < 32; j++) {
        const int n = nblk * 128 + ng * 32 + j;
        const int ch = n & 255, fdir = n >> 9, ford = (n >> 8) & 1;
        const float delta = fabsf(lo + (hi - lo) * (float)ch / 255.f);
        const float v = (acc[j] + p.hy_f_b3[l * 1024 + n]) * (__expf(-tn * delta) + 0.05f);
        bf16_t* ftc = ftb + (size_t)((ford * 256 + ch) * 2) * 2 * Lp;
        if (fdir == 0 || pos > 0) {
          const int uu = fdir == 0 ? Lp - pos : Lp + pos;
          const bf16_t bv = f2bf(v);
          ftc[uu] = bv; ftc[2 * Lp + uu - 1] = bv;
        }
        if (fdir == 0 && pos == 0) { ftc[0] = 0; ftc[2 * Lp + 2 * Lp - 1] = 0; }
      }
    }
  }
}

__device__ __forceinline__ void phase_rowpass(PR p, int layer, int which, int bid, int nb) {
  const int lane = TIDX & 63, wid = TIDX >> 6;
  if (which == 0 && layer == 0 && nb * 8 * 3 == T) {
    f32x4 x[3][4];
#pragma unroll
    for (int k = 0; k < 3; k++) {
      const int row = bid * 8 + wid + k * nb * 8;
      const float* xs = row < TC ? p.x_prompt + (size_t)row * D : p.x_sample + (size_t)(row - TC) * D;
#pragma unroll
      for (int i = 0; i < 4; i++) x[k][i] = __builtin_nontemporal_load((const f32x4*)(xs + lane * 4 + 256 * i));
    }
    const float* gpre = p.norm_mix_pre;
#pragma unroll
    for (int k = 0; k < 3; k++) {
      const int row = bid * 8 + wid + k * nb * 8;
      const float* sh = p.mod + (size_t)row_mod(row) * 6144; const float* sc = sh + 1024;
      float ss = 0.f;
#pragma unroll
      for (int i = 0; i < 4; i++) { *(f32x4*)(p.xbuf + (size_t)row * D + lane * 4 + 256 * i) = x[k][i]; ss += x[k][i][0] * x[k][i][0] + x[k][i][1] * x[k][i][1] + x[k][i][2] * x[k][i][2] + x[k][i][3] * x[k][i][3]; }
      ss = wave_sum(ss);
      const float rs = rsqrtf(ss * (1.f / 1024.f) + EPS);
#pragma unroll
      for (int i = 0; i < 4; i++) {
        const int e = lane * 4 + 256 * i;
        const float4 g = *(const float4*)(gpre + e), s1 = *(const float4*)(sc + e), s0 = *(const float4*)(sh + e);
        uint2 o;
        o.x = pack2(x[k][i][0] * rs * g.x * (1.f + s1.x) + s0.x, x[k][i][1] * rs * g.y * (1.f + s1.y) + s0.y);
        o.y = pack2(x[k][i][2] * rs * g.z * (1.f + s1.z) + s0.z, x[k][i][3] * rs * g.w * (1.f + s1.w) + s0.w);
        *(uint2*)(p.hbuf + (size_t)row * D + e) = o;
      }
    }
    return;
  }
  for (int row = bid * 8 + wid; row < T; row += nb * 8) {
    const int mi = row_mod(row);
    const float* xs;
    const float* gate = nullptr; const float* gpost = nullptr;
    float* xd; bf16_t* hd = nullptr; const float *gpre = nullptr, *sc = nullptr, *sh = nullptr;
    bool has_raw;
    if (which == 0) {
      if (layer == 0) { xs = row < TC ? p.x_prompt + (size_t)row * D : p.x_sample + (size_t)(row - TC) * D; has_raw = false; }
      else { xs = p.x1buf + (size_t)row * D; has_raw = true; gate = p.mod + ((size_t)(layer - 1) * 3 + mi) * 6144 + 5 * 1024; gpost = p.norm_ffn_post + (layer - 1) * D; }
      if (layer < DEPTH) { xd = p.xbuf + (size_t)row * D; hd = p.hbuf + (size_t)row * D; gpre = p.norm_mix_pre + layer * D;
        sh = p.mod + ((size_t)layer * 3 + mi) * 6144; sc = sh + 1024; }
      else xd = p.out + (size_t)row * D;
    } else {
      xs = p.xbuf + (size_t)row * D; has_raw = true; gate = p.mod + ((size_t)layer * 3 + mi) * 6144 + 2 * 1024; gpost = p.norm_mix_post + layer * D;
      xd = p.x1buf + (size_t)row * D; hd = p.hbuf + (size_t)row * D; gpre = p.norm_ffn_pre + layer * D;
      sh = p.mod + ((size_t)layer * 3 + mi) * 6144 + 3 * 1024; sc = sh + 1024;
    }
    float4 x[4];
#pragma unroll
    for (int i = 0; i < 4; i++) x[i] = *(const float4*)(xs + lane * 4 + 256 * i);
    if (has_raw) {
      float4 r[4]; float ss = 0.f;
      const float* rp = p.raw + (size_t)row * D;
#pragma unroll
      for (int i = 0; i < 4; i++) { r[i] = *(const float4*)(rp + lane * 4 + 256 * i); ss += r[i].x * r[i].x + r[i].y * r[i].y + r[i].z * r[i].z + r[i].w * r[i].w; }
      ss = wave_sum(ss);
      float rs = rsqrtf(ss * (1.f / 1024.f) + EPS);
#pragma unroll
      for (int i = 0; i < 4; i++) {
        float4 g = *(const float4*)(gate + lane * 4 + 256 * i), gp = *(const float4*)(gpost + lane * 4 + 256 * i);
        x[i].x += g.x * gp.x * r[i].x * rs; x[i].y += g.y * gp.y * r[i].y * rs; x[i].z += g.z * gp.z * r[i].z * rs; x[i].w += g.w * gp.w * r[i].w * rs;
      }
    }
#pragma unroll
    for (int i = 0; i < 4; i++) *(float4*)(xd + lane * 4 + 256 * i) = x[i];
    if (hd) {
      float ss = 0.f;
#pragma unroll
      for (int i = 0; i < 4; i++) ss += x[i].x * x[i].x + x[i].y * x[i].y + x[i].z * x[i].z + x[i].w * x[i].w;
      ss = wave_sum(ss);
      float rs = rsqrtf(ss * (1.f / 1024.f) + EPS);
#pragma unroll
      for (int i = 0; i < 4; i++) {
        int e = lane * 4 + 256 * i;
        float4 g = *(const float4*)(gpre + e), s1 = *(const float4*)(sc + e), s0 = *(const float4*)(sh + e);
        float h0 = x[i].x * rs * g.x * (1.f + s1.x) + s0.x, h1 = x[i].y * rs * g.y * (1.f + s1.y) + s0.y;
        float h2 = x[i].z * rs * g.z * (1.f + s1.z) + s0.z, h3 = x[i].w * rs * g.w * (1.f + s1.w) + s0.w;
        uint2 o; o.x = pack2(h0, h1); o.y = pack2(h2, h3);
        *(uint2*)(hd + e) = o;
      }
    }
  }
}

struct EpiProj {
  bf16_t *proj, *ktr, *vtr, *ktm, *vtm, *hyt; float* gates;
  __device__ __forceinline__ void operator()(int row, int col, f32x4 v) const {
    if (col >= INW) return;
    uint2 o; o.x = pack2(v[0], v[1]); o.y = pack2(v[2], v[3]);
    *(uint2*)(proj + (size_t)row * INW + col) = o;
    bf16_t* tp = nullptr; int tc = 0;
    if (col >= 384 && col < 768) { tp = ktr; tc = col - 384; }
    else if (col >= 768 && col < 1152) { tp = vtr; tc = col - 768; }
    else if (col >= 1536 && col < 2304) { tp = hyt; tc = col - 1536; }
    else if (col >= 2688 && col < 3072) { tp = ktm; tc = col - 2688; }
    else if (col >= 3072 && col < 3456) { tp = vtm; tc = col - 3072; }
    if (tp) {
#pragma unroll
      for (int r = 0; r < 4; r++) tp[(size_t)(tc + r) * T + row] = f2bf(v[r]);
    }
    if (col >= 3840) *(float4*)(gates + (size_t)row * 16 + (col - 3840)) = make_float4(v[0], v[1], v[2], v[3]);
  }
};
struct EpiF32 {
  float* out; int ld;
  __device__ __forceinline__ void operator()(int row, int col, f32x4 v) const {
    *(float4*)(out + (size_t)row * ld + col) = make_float4(v[0], v[1], v[2], v[3]);
  }
};
struct EpiRow {
  const float* x; float* xo; bf16_t* ho;
  const float* modl; int goff; const float* gpost;
  const float* modn; int shoff; const float* gpre;
  unsigned long long* gran; unsigned epoch; unsigned* tmo;
  __device__ __forceinline__ void operator()(int, int, f32x4) const {}
};
template <class E> struct epi_proj { static constexpr bool value = false; };
template <> struct epi_proj<EpiProj> { static constexpr bool value = true; };
template <class E> struct epi_row { static constexpr bool value = false; };
template <> struct epi_row<EpiRow> { static constexpr bool value = true; };
struct EpiUp {
  static constexpr bool kFused = true;
  bf16_t* u; const bf16_t* h; const bf16_t* wt; const float* cw; const float* cb;
  __device__ __forceinline__ void operator()(int, int, f32x4) const {}
};
template <class E> struct epi_fused { static constexpr bool value = false; };
template <> struct epi_fused<EpiUp> { static constexpr bool value = true; };

typedef unsigned u32x2 __attribute__((ext_vector_type(2)));
typedef float f32x2 __attribute__((ext_vector_type(2)));
typedef __bf16 bf16x2_t __attribute__((ext_vector_type(2)));
#ifndef WT_AUX
#define WT_AUX 16
#endif
template <int BM, int BN, int GL, class Epi>
__device__ __forceinline__ void gemm_tiles(const bf16_t* __restrict__ A, const bf16_t* __restrict__ Bt, int M, int N, int K, int bid, int nb, char* smem, const Epi& epi) {
  constexpr int MT = BM / 64, NTW = BN / 32;
  constexpr int ACH = BM * 8 / NT, BCH = BN * 8 / NT;
  constexpr int ABYTES = BM * 128, BBYTES = BN * 128, STAGE = ABYTES + BBYTES;
  const int nm = M / BM, nn = N / BN;
  const int tid = TIDX, lane = tid & 63, wid = tid >> 6;
  const int wm = wid >> 1, wn = wid & 1;
  const int lr = lane & 15, lg = lane >> 4;
  u32x4 ra[ACH], rb[BCH];
  const unsigned voff = (unsigned)(((tid >> 3) * K + (tid & 7) * 8) * 2);
  const unsigned soff = (unsigned)((tid >> 3) * 128 + (((tid & 7) ^ ((tid >> 3) & 7)) << 4));
#define GLOAD(Ab, Bb) { \
    _Pragma("unroll") for (int i = 0; i < ACH; i++) ra[i] = *(const u32x4*)((const char*)((Ab) + (size_t)i * 64 * K) + voff); \
    _Pragma("unroll") for (int i = 0; i < BCH; i++) rb[i] = *(const u32x4*)((const char*)((Bb) + (size_t)i * 64 * K) + voff); }
#define SWRITE(buf) { char* sa_ = smem + (buf) * STAGE + soff; char* sb_ = sa_ + ABYTES; \
    _Pragma("unroll") for (int i = 0; i < ACH; i++) *(u32x4*)(sa_ + i * 8192) = ra[i]; \
    _Pragma("unroll") for (int i = 0; i < BCH; i++) *(u32x4*)(sb_ + i * 8192) = rb[i]; }
  const unsigned goff = (unsigned)(((tid >> 3) * K + (((tid & 7) ^ ((tid >> 3) & 7)) * 8)) * 2);
  const int wu = __builtin_amdgcn_readfirstlane(wid);
#define GLDS(buf, Ab, Bb) { \
    _Pragma("unroll") for (int i = 0; i < ACH; i++) __builtin_amdgcn_global_load_lds((const unsigned*)((const char*)((Ab) + (size_t)i * 64 * K) + goff), (LAS unsigned*)(smem + (buf) * STAGE + i * 8192 + wu * 1024), 16, 0, 0); \
    _Pragma("unroll") for (int i = 0; i < BCH; i++) __builtin_amdgcn_global_load_lds((const unsigned*)((const char*)((Bb) + (size_t)i * 64 * K) + goff), (LAS unsigned*)(smem + (buf) * STAGE + ABYTES + i * 8192 + wu * 1024), 16, 0, 0); }
#define GWAIT() { asm volatile("s_waitcnt vmcnt(0)" ::: "memory"); __syncthreads(); }
  const unsigned offA0 = (unsigned)((wm * (BM / 4) + lr) * 128 + ((lg ^ (lr & 7)) << 4));
  const unsigned offB0 = (unsigned)(ABYTES + (wn * (BN / 2) + lr) * 128 + ((lg ^ (lr & 7)) << 4));
  const int grp = bid & 7, jg = bid >> 3, ng = (nb + 7 - grp) >> 3;
  const int mpg = nm >> 3, tpg = mpg * nn;
  if (jg >= tpg) return;
#define TILE_M0(q) ((grp * mpg + (q) % mpg) * BM)
#define TILE_N0(q) (((q) / mpg) * BN)
  {
    const bf16_t* Ab = A + (size_t)TILE_M0(jg) * K; const bf16_t* Bb = Bt + (size_t)TILE_N0(jg) * K;
    if constexpr (GL == 2) {
    } else if constexpr (GL == 1) {
      __syncthreads();
      GLDS(0, Ab, Bb);
      GWAIT();
    } else {
      GLOAD(Ab, Bb);
      __syncthreads();
      SWRITE(0);
      GLOAD(Ab + 64, Bb + 64);
      __syncthreads();
    }
  }
  const int nk = K / 64;
  for (int q = jg; q < tpg; q += ng) {
    const int m0 = TILE_M0(q), n0 = TILE_N0(q);
    const int q2 = q + ng; const bool hn = q2 < tpg;
    const bf16_t* Ab = A + (size_t)m0 * K;
    const bf16_t* Bb = Bt + (size_t)n0 * K;
    const bf16_t* Abn = hn ? A + (size_t)TILE_M0(q2) * K : Ab;
    const bf16_t* Bbn = hn ? Bt + (size_t)TILE_N0(q2) * K : Bb;
    f32x4 acc[MT][NTW];
#pragma unroll
    for (int i = 0; i < MT; i++)
#pragma unroll
      for (int j = 0; j < NTW; j++) acc[i][j] = zero4();
    auto compute = [&](int buf) {
      const char* sa = smem + buf * STAGE;
#pragma unroll
      for (int ks = 0; ks < 2; ks++) {
        bf16x8 af[MT], bfr[NTW];
#pragma unroll
        for (int mi = 0; mi < MT; mi++) af[mi] = *(const bf16x8*)(sa + (offA0 ^ (ks << 6)) + mi * 2048);
#pragma unroll
        for (int ni = 0; ni < NTW; ni++) bfr[ni] = *(const bf16x8*)(sa + (offB0 ^ (ks << 6)) + ni * 2048);
        __builtin_amdgcn_sched_barrier(0);
#pragma unroll
        for (int ni = 0; ni < NTW; ni++)
#pragma unroll
          for (int mi = 0; mi < MT; mi++) acc[mi][ni] = __builtin_amdgcn_mfma_f32_16x16x32_bf16(bfr[ni], af[mi], acc[mi][ni], 0, 0, 0);
        __builtin_amdgcn_sched_barrier(0);
      }
    };
    f32x4 xv[epi_row<Epi>::value ? MT : 1][epi_row<Epi>::value ? NTW : 1];
    float* tabG = (float*)(smem + 3 * STAGE); float* tabP = tabG + 384; float* tabS = tabP + 384;
    if constexpr (epi_row<Epi>::value) {
      static_assert(3 * STAGE + 3 * 384 * 4 <= SMEM_BYTES - 64, "row tables");
      if (tid < 384) {
        const int v = tid >> 7, col = n0 + (tid & 127);
        tabG[tid] = epi.modl[v * 6144 + epi.goff + col] * epi.gpost[col];
        if (epi.ho) { tabP[tid] = epi.gpre[col] * (1.f + epi.modn[v * 6144 + epi.shoff + 1024 + col]); tabS[tid] = epi.modn[v * 6144 + epi.shoff + col]; }
      }
    }
    auto row_preload = [&]() {
      if constexpr (epi_row<Epi>::value) {
#pragma unroll
        for (int mi = 0; mi < MT; mi++) {
          const int row = m0 + wm * 48 + mi * 16 + lr;
#pragma unroll
          for (int ni = 0; ni < NTW; ni++) {
            const int col = n0 + wn * 64 + ni * 16 + lg * 4;
            xv[mi][ni] = __builtin_nontemporal_load((const f32x4*)(epi.x + (size_t)row * D + col));
          }
        }
      }
    };
    if constexpr (GL != 2) row_preload();
    if constexpr (GL == 2) {
      static_assert(3 * STAGE <= SMEM_BYTES - 64, "ring");
      constexpr int PL = ACH + BCH;
      __syncthreads();
      GLDS(0, Ab, Bb);
      GLDS(1, Ab + 64, Bb + 64);
      asm volatile("s_waitcnt vmcnt(%0)" :: "n"(PL) : "memory");
      __builtin_amdgcn_s_barrier();
      int cur = 0, nx2 = 2;
      const int ksplit = nk > 8 ? nk - 8 : 0;
#pragma unroll 1
      for (int kt = 0; kt < ksplit; kt++) {
        GLDS(nx2, Ab + (kt + 2) * 64, Bb + (kt + 2) * 64);
        __builtin_amdgcn_sched_barrier(0);
        compute(cur);
        __builtin_amdgcn_sched_barrier(0);
        asm volatile("s_waitcnt vmcnt(%0)" :: "n"(PL) : "memory");
        asm volatile("s_waitcnt lgkmcnt(0)" ::: "memory");
        __builtin_amdgcn_s_barrier();
        cur = cur == 2 ? 0 : cur + 1; nx2 = nx2 == 2 ? 0 : nx2 + 1;
      }
      row_preload();
#pragma unroll 1
      for (int kt = ksplit; kt < nk; kt++) {
        if (kt + 2 < nk) GLDS(nx2, Ab + (kt + 2) * 64, Bb + (kt + 2) * 64);
        __builtin_amdgcn_sched_barrier(0);
        compute(cur);
        __builtin_amdgcn_sched_barrier(0);
        if (kt + 2 < nk) asm volatile("s_waitcnt vmcnt(%0)" :: "n"(PL) : "memory");
        else asm volatile("s_waitcnt vmcnt(0)" ::: "memory");
        asm volatile("s_waitcnt lgkmcnt(0)" ::: "memory");
        __builtin_amdgcn_s_barrier();
        cur = cur == 2 ? 0 : cur + 1; nx2 = nx2 == 2 ? 0 : nx2 + 1;
      }
    } else if constexpr (GL == 1) {
      for (int kt = 0; kt < nk; kt += 2) {
        GLDS(1, Ab + (kt + 1) * 64, Bb + (kt + 1) * 64);
        __builtin_amdgcn_sched_barrier(0);
        compute(0);
        __builtin_amdgcn_sched_barrier(0);
        GWAIT();
        { const bool in = kt + 2 < nk; GLDS(0, in ? Ab + (kt + 2) * 64 : Abn, in ? Bb + (kt + 2) * 64 : Bbn); }
        __builtin_amdgcn_sched_barrier(0);
        compute(1);
        __builtin_amdgcn_sched_barrier(0);
        GWAIT();
      }
    } else
    for (int kt = 0; kt < nk; kt += 2) {
      SWRITE(1);
      { const bool in = kt + 2 < nk; GLOAD(in ? Ab + (kt + 2) * 64 : Abn, in ? Bb + (kt + 2) * 64 : Bbn); }
      __builtin_amdgcn_sched_barrier(0);
      compute(0);
      __builtin_amdgcn_sched_barrier(0);
      __syncthreads();
      SWRITE(0);
      { const bool in = kt + 3 < nk; GLOAD(in ? Ab + (kt + 3) * 64 : Abn + 64, in ? Bb + (kt + 3) * 64 : Bbn + 64); }
      __builtin_amdgcn_sched_barrier(0);
      compute(1);
      __builtin_amdgcn_sched_barrier(0);
      __syncthreads();
    }
    if constexpr (epi_row<Epi>::value) {
      static_assert(BM == 192 && BN == 128, "row-fused epilogue geometry");
      float* sst = (float*)(smem + STAGE);
      float* srr = sst + 2 * 192 * 4;
      const int mt = m0 / 192, ntile = n0 >> 7;
#pragma unroll
      for (int mi = 0; mi < MT; mi++) {
        const int mrow = row_mod(m0 + wm * 48 + mi * 16 + lr);
        float sA = 0.f, sB = 0.f, sC = 0.f, sD = 0.f;
#pragma unroll
        for (int ni = 0; ni < NTW; ni++) {
          const float4 g4 = *(const float4*)(tabG + mrow * 128 + wn * 64 + ni * 16 + lg * 4);
          const float gg[4] = {g4.x, g4.y, g4.z, g4.w};
#pragma unroll
          for (int r = 0; r < 4; r++) {
            const float raw = acc[mi][ni][r], gr = gg[r] * raw, xx = xv[mi][ni][r];
            sA += raw * raw; sB += xx * gr; sC += gr * gr; sD += xx * xx;
          }
        }
        sA += __shfl_xor(sA, 16); sA += __shfl_xor(sA, 32); sB += __shfl_xor(sB, 16); sB += __shfl_xor(sB, 32);
        sC += __shfl_xor(sC, 16); sC += __shfl_xor(sC, 32); sD += __shfl_xor(sD, 16); sD += __shfl_xor(sD, 32);
        if (lg == 0) *(float4*)(sst + (wn * 192 + wm * 48 + mi * 16 + lr) * 4) = make_float4(sA, sB, sC, sD);
      }
      __syncthreads();
      if (tid < 192) {
        unsigned long long* gbase = epi.gran + (size_t)mt * 8 * 4 * 192 + tid;
        const unsigned long long tag = (unsigned long long)epi.epoch << 32;
        {
          const float4 a = *(const float4*)(sst + tid * 4), b = *(const float4*)(sst + (192 + tid) * 4);
          unsigned long long* g = gbase + (size_t)ntile * 4 * 192;
          __hip_atomic_store(g + 0 * 192, tag | __float_as_uint(a.x + b.x), __ATOMIC_RELAXED, __HIP_MEMORY_SCOPE_AGENT);
          __hip_atomic_store(g + 1 * 192, tag | __float_as_uint(a.y + b.y), __ATOMIC_RELAXED, __HIP_MEMORY_SCOPE_AGENT);
          __hip_atomic_store(g + 2 * 192, tag | __float_as_uint(a.z + b.z), __ATOMIC_RELAXED, __HIP_MEMORY_SCOPE_AGENT);
          __hip_atomic_store(g + 3 * 192, tag | __float_as_uint(a.w + b.w), __ATOMIC_RELAXED, __HIP_MEMORY_SCOPE_AGENT);
        }
        float tA = 0.f, tB = 0.f, tC = 0.f, tD = 0.f;
        for (unsigned spins = 0;;) {
          bool ok = true; float q0 = 0.f, q1 = 0.f, q2 = 0.f, q3 = 0.f;
#pragma unroll 2
          for (int t = 0; t < 8; t++) {
            const unsigned long long w0 = __hip_atomic_load(gbase + (size_t)(t * 4 + 0) * 192, __ATOMIC_RELAXED, __HIP_MEMORY_SCOPE_AGENT);
            const unsigned long long w1 = __hip_atomic_load(gbase + (size_t)(t * 4 + 1) * 192, __ATOMIC_RELAXED, __HIP_MEMORY_SCOPE_AGENT);
            const unsigned long long w2 = __hip_atomic_load(gbase + (size_t)(t * 4 + 2) * 192, __ATOMIC_RELAXED, __HIP_MEMORY_SCOPE_AGENT);
            const unsigned long long w3 = __hip_atomic_load(gbase + (size_t)(t * 4 + 3) * 192, __ATOMIC_RELAXED, __HIP_MEMORY_SCOPE_AGENT);
            ok = ok && (unsigned)(w0 >> 32) == epi.epoch && (unsigned)(w1 >> 32) == epi.epoch && (unsigned)(w2 >> 32) == epi.epoch && (unsigned)(w3 >> 32) == epi.epoch;
            q0 += __uint_as_float((unsigned)w0); q1 += __uint_as_float((unsigned)w1); q2 += __uint_as_float((unsigned)w2); q3 += __uint_as_float((unsigned)w3);
          }
          if (ok) { tA = q0; tB = q1; tC = q2; tD = q3; break; }
          if (++spins > (1u << 18)) { __hip_atomic_store(epi.tmo, 1u, __ATOMIC_RELAXED, __HIP_MEMORY_SCOPE_AGENT); break; }
          __builtin_amdgcn_s_sleep(1);
        }
        const float r1 = rsqrtf(tA * (1.f / 1024.f) + EPS);
        const float ss = tD + 2.f * r1 * tB + r1 * r1 * tC;
        srr[tid * 2] = r1; srr[tid * 2 + 1] = rsqrtf(fmaxf(ss, 0.f) * (1.f / 1024.f) + EPS);
      }
      __syncthreads();
      const auto rsXo = __builtin_amdgcn_make_buffer_rsrc((void*)epi.xo, 0, 0x7fffffff, 0x00020000);
      const auto rsHo = __builtin_amdgcn_make_buffer_rsrc((void*)epi.ho, 0, 0x7fffffff, 0x00020000);
#pragma unroll
      for (int mi = 0; mi < MT; mi++) {
        const int rl = wm * 48 + mi * 16 + lr, row = m0 + rl;
        const int mrow = row_mod(row);
        const float r1 = srr[rl * 2], r2 = srr[rl * 2 + 1];
#pragma unroll
        for (int ni = 0; ni < NTW; ni++) {
          const int cl = wn * 64 + ni * 16 + lg * 4, col = n0 + cl;
          const float4 g4 = *(const float4*)(tabG + mrow * 128 + cl);
          const float gg[4] = {g4.x, g4.y, g4.z, g4.w};
          f32x4 xo;
#pragma unroll
          for (int r = 0; r < 4; r++) xo[r] = xv[mi][ni][r] + gg[r] * acc[mi][ni][r] * r1;
          __builtin_amdgcn_raw_buffer_store_b128((u32x4){__float_as_uint(xo[0]), __float_as_uint(xo[1]), __float_as_uint(xo[2]), __float_as_uint(xo[3])}, rsXo, (unsigned)((row * D + col) * 4), 0, WT_AUX);
          if (epi.ho) {
            const float4 pp = *(const float4*)(tabP + mrow * 128 + cl), s0 = *(const float4*)(tabS + mrow * 128 + cl);
            uint2 o;
            o.x = pack2(xo[0] * r2 * pp.x + s0.x, xo[1] * r2 * pp.y + s0.y);
            o.y = pack2(xo[2] * r2 * pp.z + s0.z, xo[3] * r2 * pp.w + s0.w);
            __builtin_amdgcn_raw_buffer_store_b64((u32x2){o.x, o.y}, rsHo, (unsigned)((row * D + col) * 2), 0, WT_AUX);
          }
        }
      }
    } else
    if constexpr (epi_fused<Epi>::value) {
     constexpr int UP_LA = STAGE, UP_LB = UP_LA + 258 * 144;
     static_assert(UP_LB + 256 * 144 <= SMEM_BYTES - 32, "fused epilogue images");
#pragma unroll
     for (int ph = 0; ph < NTW / 4; ph++) {
      {
        char* base = smem + (wn == 0 ? UP_LA + 144 : UP_LB);
#pragma unroll
        for (int mi = 0; mi < MT; mi++)
#pragma unroll
          for (int ni = 0; ni < 4; ni++) {
            const int r = wm * (BM / 4) + mi * 16 + lr, cidx = ni * 16 + lg * 4;
            uint2 o; o.x = pack2(acc[mi][ph * 4 + ni][0], acc[mi][ph * 4 + ni][1]); o.y = pack2(acc[mi][ph * 4 + ni][2], acc[mi][ph * 4 + ni][3]);
            *(uint2*)(base + r * 144 + cidx * 2) = o;
          }
      }
      {
        const int pos0 = m0 >= TC ? ((m0 - TC) & 1023) : 0;
        const bool top = m0 >= TC && pos0 != 0, bot = m0 >= TC && pos0 + BM != 1024;
        if (top || bot) {
          unsigned z0_ = 0u; asm volatile("" : "+v"(z0_)); uint4 ht0 = make_uint4(z0_, z0_, z0_, z0_), ht1 = ht0, hb0 = ht0, hb1 = ht0;
          if (top) { const bf16_t* hr = epi.h + (size_t)(m0 - 1) * K + lane * 8; ht0 = *(const uint4*)hr; ht1 = *(const uint4*)(hr + 512); }
          if (bot) { const bf16_t* hr = epi.h + (size_t)(m0 + BM) * K + lane * 8; hb0 = *(const uint4*)hr; hb1 = *(const uint4*)(hr + 512); }
#define DOT8(a, b) (bflo(a.x) * bflo(b.x) + bfhi(a.x) * bfhi(b.x) + bflo(a.y) * bflo(b.y) + bfhi(a.y) * bfhi(b.y) + bflo(a.z) * bflo(b.z) + bfhi(a.z) * bfhi(b.z) + bflo(a.w) * bflo(b.w) + bfhi(a.w) * bfhi(b.w))
#pragma unroll 1
          for (int fb = 0; fb < 2; fb++) {
            uint4 w0[4], w1[4];
#pragma unroll
            for (int fi = 0; fi < 4; fi++) { const bf16_t* wr = epi.wt + (size_t)(n0 + ph * 64 + wid * 8 + fb * 4 + fi) * K + lane * 8; w0[fi] = *(const uint4*)wr; w1[fi] = *(const uint4*)(wr + 512); }
#pragma unroll
            for (int fi = 0; fi < 4; fi++) {
              float st = DOT8(ht0, w0[fi]) + DOT8(ht1, w1[fi]), sb = DOT8(hb0, w0[fi]) + DOT8(hb1, w1[fi]);
              st = wave_sum(st); sb = wave_sum(sb);
              const int f = wid * 8 + fb * 4 + fi;
              if (lane == 0) { *(bf16_t*)(smem + UP_LA + f * 2) = f2bf(st); *(bf16_t*)(smem + UP_LA + 257 * 144 + f * 2) = f2bf(sb); }
            }
          }
#undef DOT8
        } else if (tid < 128) {
          *(bf16_t*)(smem + UP_LA + (tid >> 6) * 257 * 144 + (tid & 63) * 2) = 0;
        }
      }
      __syncthreads();
      {
        const int fc = tid & 7, f0 = (n0 >> 1) + ph * 64 + fc * 8;
        float w0[8], w1[8], w2[8], bb[8];
        {
          const float* cw = epi.cw + f0;
          const float4 a0 = *(const float4*)cw, a1 = *(const float4*)(cw + 4), b0 = *(const float4*)(cw + DFF), b1 = *(const float4*)(cw + DFF + 4);
          const float4 c0 = *(const float4*)(cw + 2 * DFF), c1 = *(const float4*)(cw + 2 * DFF + 4), d0 = *(const float4*)(epi.cb + f0), d1 = *(const float4*)(epi.cb + f0 + 4);
          w0[0] = a0.x; w0[1] = a0.y; w0[2] = a0.z; w0[3] = a0.w; w0[4] = a1.x; w0[5] = a1.y; w0[6] = a1.z; w0[7] = a1.w;
          w1[0] = b0.x; w1[1] = b0.y; w1[2] = b0.z; w1[3] = b0.w; w1[4] = b1.x; w1[5] = b1.y; w1[6] = b1.z; w1[7] = b1.w;
          w2[0] = c0.x; w2[1] = c0.y; w2[2] = c0.z; w2[3] = c0.w; w2[4] = c1.x; w2[5] = c1.y; w2[6] = c1.z; w2[7] = c1.w;
          bb[0] = d0.x; bb[1] = d0.y; bb[2] = d0.z; bb[3] = d0.w; bb[4] = d1.x; bb[5] = d1.y; bb[6] = d1.z; bb[7] = d1.w;
        }
#pragma unroll
        for (int j = 0; j < BM / 64; j++) {
          const int r = (tid >> 3) + 64 * j;
          const char* ap = smem + UP_LA + r * 144 + fc * 16;
          const uint4 x0 = *(const uint4*)ap, x1 = *(const uint4*)(ap + 144), x2 = *(const uint4*)(ap + 288);
          const uint4 bv = *(const uint4*)(smem + UP_LB + r * 144 + fc * 16);
          const unsigned xa[4] = {x0.x, x0.y, x0.z, x0.w}, xb[4] = {x1.x, x1.y, x1.z, x1.w}, xc[4] = {x2.x, x2.y, x2.z, x2.w}, bw[4] = {bv.x, bv.y, bv.z, bv.w};
          float o[8];
#pragma unroll
          for (int q = 0; q < 8; q++) {
            const float a0 = (q & 1) ? bfhi(xa[q >> 1]) : bflo(xa[q >> 1]), a1 = (q & 1) ? bfhi(xb[q >> 1]) : bflo(xb[q >> 1]), a2 = (q & 1) ? bfhi(xc[q >> 1]) : bflo(xc[q >> 1]);
            const float bq = (q & 1) ? bfhi(bw[q >> 1]) : bflo(bw[q >> 1]);
            const float a = a0 * w0[q] + a1 * w1[q] + a2 * w2[q] + bb[q];
            const float t2 = 1.5957691216057308f * (a + 0.044715f * a * a * a);
            o[q] = a * __builtin_amdgcn_rcpf(1.f + __expf(-t2)) * bq;
          }
          uint4 ov; ov.x = pack2(o[0], o[1]); ov.y = pack2(o[2], o[3]); ov.z = pack2(o[4], o[5]); ov.w = pack2(o[6], o[7]);
          *(uint4*)(epi.u + (size_t)(m0 + r) * DFF + f0) = ov;
        }
      }
      __syncthreads();
     }
    } else if constexpr (epi_proj<Epi>::value) {
      const auto rsP = __builtin_amdgcn_make_buffer_rsrc((void*)epi.proj, 0, 0x7fffffff, 0x00020000);
      const auto rsT = __builtin_amdgcn_make_buffer_rsrc((void*)epi.ktr, 0, 0x7fffffff, 0x00020000);
      const auto rsG = __builtin_amdgcn_make_buffer_rsrc((void*)epi.gates, 0, 0x7fffffff, 0x00020000);
      const int wns = wu & 1;
      const bool even = (lane & 1) == 0;
      unsigned voffP[MT], voffT[MT], voffG[MT];
#pragma unroll
      for (int mi = 0; mi < MT; mi++) {
        const int row = m0 + wm * (BM / 4) + mi * 16 + lr;
        voffP[mi] = (unsigned)((row * INW + lg * 4) * 2); voffT[mi] = (unsigned)(((lg * 4 + (lane & 1) * 2) * T + (row & ~1)) * 2); voffG[mi] = (unsigned)((row * 16 + lg * 4) * 4);
      }
#pragma unroll
      for (int ni = 0; ni < NTW; ni++) {
        const int col0 = n0 + wns * (BN / 2) + ni * 16;
        const bool tonly = (col0 >= 768 && col0 < 1152) || (col0 >= 1536 && col0 < 2304) || (col0 >= 3072 && col0 < 3456);
        long tel = -1;
        if (col0 >= 384 && col0 < 768) tel = (long)(col0 - 384) * T;
        else if (col0 >= 768 && col0 < 1152) tel = (epi.vtr - epi.ktr) + (long)(col0 - 768) * T;
        else if (col0 >= 1536 && col0 < 2304) tel = (epi.hyt - epi.ktr) + (long)(col0 - 1536) * T;
        else if (col0 >= 2688 && col0 < 3072) tel = (epi.ktm - epi.ktr) + (long)(col0 - 2688) * T;
        else if (col0 >= 3072 && col0 < 3456) tel = (epi.vtm - epi.ktr) + (long)(col0 - 3072) * T;
        const unsigned tso = (unsigned)(tel * 2);
#pragma unroll
        for (int mi = 0; mi < MT; mi++) {
          const f32x4 v = acc[mi][ni];
          const unsigned w01 = pack2(v[0], v[1]), w23 = pack2(v[2], v[3]);
          if (col0 < 3840 && !tonly) __builtin_amdgcn_raw_buffer_store_b64((u32x2){w01, w23}, rsP, voffP[mi], (unsigned)(col0 * 2), 0);
          if (col0 == 3840) __builtin_amdgcn_raw_buffer_store_b128((u32x4){__float_as_uint(v[0]), __float_as_uint(v[1]), __float_as_uint(v[2]), __float_as_uint(v[3])}, rsG, voffG[mi], 0, 0);
          if (tel >= 0) {
            float nb[4];
#pragma unroll
            for (int r = 0; r < 4; r++) nb[r] = __int_as_float(__builtin_amdgcn_update_dpp(0, __float_as_int(v[r]), 0xB1, 0xF, 0xF, false));
            const unsigned p0 = pack2(even ? v[0] : nb[2], even ? nb[0] : v[2]), p1 = pack2(even ? v[1] : nb[3], even ? nb[1] : v[3]);
            __builtin_amdgcn_raw_buffer_store_b32(p0, rsT, voffT[mi], tso, 0);
            __builtin_amdgcn_raw_buffer_store_b32(p1, rsT, voffT[mi], tso + (unsigned)(T * 2), 0);
          }
        }
      }
    } else {
#pragma unroll
      for (int mi = 0; mi < MT; mi++)
#pragma unroll
        for (int ni = 0; ni < NTW; ni++) epi(m0 + wm * (BM / 4) + mi * 16 + lr, n0 + wn * (BN / 2) + ni * 16 + lg * 4, acc[mi][ni]);
    }
  }
#undef GLOAD
#undef SWRITE
#undef GLDS
#undef GWAIT
#undef TILE_M0
#undef TILE_N0
}


namespace up8 {
constexpr int BM = 256, BK = 64, HALF = 128, HT = HALF * BK, SHM_B = 8 * HT * 2;
__device__ __forceinline__ int lds_byte(int r, int c) { int st = (r >> 4) * 2 + (c >> 5), rr = r & 15, cc = c & 31, ob = rr * 64 + cc * 2; return st * 1024 + (ob ^ (((ob >> 9) & 1) << 5)); }
__device__ __forceinline__ void stage_rc(int b, int& R, int& C) { int st = b / 1024, sb = b % 1024, swz = sb ^ (((sb >> 9) & 1) << 5); R = (st >> 1) * 16 + swz / 64; C = (st & 1) * 32 + (swz % 64) / 2; }
}
__device__ __forceinline__ void gemm_up8(const bf16_t* __restrict__ A, const bf16_t* __restrict__ Bt, int bid, int nb, char* smem, const EpiUp& epi) {
  using namespace up8;
  constexpr int K = D;
  static_assert(SHM_B <= SMEM_BYTES - 64, "LDS");
  const int tid = TIDX, wid = tid >> 6, lane = tid & 63, wr = wid >> 2, wc = wid & 3, fr = lane & 15, fq = lane >> 4;
  const int wu = __builtin_amdgcn_readfirstlane(wid);
  bf16_t* shm = (bf16_t*)smem;
#define SA(b, h) (shm + ((b) * 2 + (h)) * HT)
#define SB(b, h) (shm + (4 + (b) * 2 + (h)) * HT)
  int sR0, sC0, sR1, sC1; stage_rc(tid * 16, sR0, sC0); stage_rc(tid * 16 + 8192, sR1, sC1);
  const unsigned so0 = (unsigned)((sR0 * K + sC0) * 2), so1 = (unsigned)((sR1 * K + sC1) * 2);
  const auto rsA = __builtin_amdgcn_make_buffer_rsrc((void*)A, 0, 0x7fffffff, 0x00020000);
  const auto rsB = __builtin_amdgcn_make_buffer_rsrc((void*)Bt, 0, 0x7fffffff, 0x00020000);
  const auto rsU = __builtin_amdgcn_make_buffer_rsrc((void*)epi.u, 0, 0x7fffffff, 0x00020000);
#define rs_A rsA
#define rs_Bt rsB
#define STAGE(P, BASE, br, kt) do { const int so_ = ((br) * K + (kt) * BK) * 2; \
    __builtin_amdgcn_raw_ptr_buffer_load_lds(rs_##BASE, (LAS void*)((char*)(P) + wu * 1024), 16, so0, so_, 0, 0); \
    __builtin_amdgcn_raw_ptr_buffer_load_lds(rs_##BASE, (LAS void*)((char*)(P) + 8192 + wu * 1024), 16, so1, so_, 0, 0); } while (0)
#define LDA(dst, b, h) _Pragma("unroll") for (int m = 0; m < 4; ++m) _Pragma("unroll") for (int k = 0; k < 2; ++k) \
    dst[m][k] = *reinterpret_cast<const bf16x8*>((const char*)SA(b, h) + lds_byte(wr * 64 + m * 16 + fr, k * 32 + fq * 8))
#define LDB(dst, b, h) _Pragma("unroll") for (int n = 0; n < 2; ++n) _Pragma("unroll") for (int k = 0; k < 2; ++k) \
    dst[n][k] = *reinterpret_cast<const bf16x8*>((const char*)SB(b, h) + lds_byte(wc * 32 + n * 16 + fr, k * 32 + fq * 8))
#define MMA(ai, bj, At_, Bt_) do { __builtin_amdgcn_s_setprio(1); \
    _Pragma("unroll") for (int m = 0; m < 4; ++m) _Pragma("unroll") for (int n = 0; n < 2; ++n) _Pragma("unroll") for (int k = 0; k < 2; ++k) \
      acc[ai][bj][m][n] = __builtin_amdgcn_mfma_f32_16x16x32_bf16(Bt_[n][k], At_[m][k], acc[ai][bj][m][n], 0, 0, 0); \
    __builtin_amdgcn_s_setprio(0); } while (0)
#define WAIT_V(n) asm volatile("s_waitcnt vmcnt(" #n ")" ::: "memory")
#define WAIT_L(n) asm volatile("s_waitcnt lgkmcnt(" #n ")" ::: "memory")
#define BARX __builtin_amdgcn_s_barrier()
#define SCHED __builtin_amdgcn_sched_barrier(0)
  const int grp = bid & 7, jg = bid >> 3, ng = (nb + 7 - grp) >> 3;
  constexpr int mpg = 6, nn = 16, tpg = mpg * nn, nt = K / BK;
  for (int q = jg; q < tpg; q += ng) {
    const int mi_ = q % mpg, mt_ = mi_ < 4 ? (grp & 3) * 4 + mi_ : 16 + (grp & 3) * 2 + (mi_ - 4);
    const int m0 = mt_ * 256, n0 = ((grp >> 2) * nn + q / mpg) * 256;
    const int brow = m0, bcol = n0;
    f32x4 acc[2][2][4][2];
    { float zero_ = 0.f; asm volatile("" : "+v"(zero_));
#pragma unroll
      for (int a_ = 0; a_ < 2; a_++)
#pragma unroll
        for (int b_ = 0; b_ < 2; b_++)
#pragma unroll
          for (int m = 0; m < 4; m++)
#pragma unroll
            for (int n = 0; n < 2; n++) acc[a_][b_][m][n] = (f32x4){zero_, zero_, zero_, zero_}; }
    bf16x8 At[4][2], B0[2][2], B1[2][2];
    __syncthreads();
    STAGE(SB(0, 0), Bt, bcol, 0); STAGE(SA(0, 0), A, brow, 0);
    STAGE(SB(0, 1), Bt, bcol + HALF, 0); STAGE(SA(0, 1), A, brow + HALF, 0);
    if (wr == 1) BARX;
    WAIT_V(4); BARX;
    STAGE(SB(1, 0), Bt, bcol, 1); STAGE(SA(1, 0), A, brow, 1); STAGE(SB(1, 1), Bt, bcol + HALF, 1);
    WAIT_V(6); BARX;
#pragma unroll 1
    for (int t = 0; t < nt - 2; t += 2) {
      LDB(B0, 0, 0); SCHED; LDA(At, 0, 0); STAGE(SA(1, 1), A, brow + HALF, t + 1);
      WAIT_L(8); BARX; WAIT_L(0); MMA(0, 0, At, B0); BARX; SCHED;
      LDB(B1, 0, 1); STAGE(SB(0, 0), Bt, bcol, t + 2);
      BARX; WAIT_L(0); MMA(0, 1, At, B1); BARX;
      LDA(At, 0, 1); STAGE(SA(0, 0), A, brow, t + 2);
      BARX; WAIT_L(0); MMA(1, 0, At, B0); BARX; SCHED;
      STAGE(SB(0, 1), Bt, bcol + HALF, t + 2);
      WAIT_V(6); BARX; MMA(1, 1, At, B1); BARX;
      LDB(B0, 1, 0); SCHED; LDA(At, 1, 0); STAGE(SA(0, 1), A, brow + HALF, t + 2);
      WAIT_L(8); BARX; WAIT_L(0); MMA(0, 0, At, B0); BARX; SCHED;
      LDB(B1, 1, 1); STAGE(SB(1, 0), Bt, bcol, t + 3);
      BARX; WAIT_L(0); MMA(0, 1, At, B1); BARX;
      LDA(At, 1, 1); STAGE(SA(1, 0), A, brow, t + 3);
      BARX; WAIT_L(0); MMA(1, 0, At, B0); BARX; SCHED;
      STAGE(SB(1, 1), Bt, bcol + HALF, t + 3);
      WAIT_V(6); BARX; MMA(1, 1, At, B1); BARX;
    }
    { LDB(B0, 0, 0); LDA(At, 0, 0); STAGE(SA(1, 1), A, brow + HALF, nt - 1);
      BARX; WAIT_L(0); MMA(0, 0, At, B0); BARX;
      LDB(B1, 0, 1); BARX; WAIT_L(0); MMA(0, 1, At, B1); BARX;
      LDA(At, 0, 1); WAIT_V(4); BARX; WAIT_L(0); MMA(1, 0, At, B0); MMA(1, 1, At, B1); BARX; }
    { LDB(B0, 1, 0); LDA(At, 1, 0); WAIT_V(2); BARX; WAIT_L(0); MMA(0, 0, At, B0); BARX;
      LDB(B1, 1, 1); WAIT_V(0); BARX; WAIT_L(0); MMA(0, 1, At, B1); BARX;
      LDA(At, 1, 1); BARX; WAIT_L(0); MMA(1, 0, At, B0); MMA(1, 1, At, B1); BARX; }
    if (wr == 0) BARX;
    constexpr int RS = 272, UP_LA = 0, UP_LB = UP_LA + 258 * RS;
    static_assert(UP_LB + 256 * RS <= SMEM_BYTES - 64, "fused epilogue images");
    __syncthreads();
    int tid_e = tid; asm volatile("" : "+v"(tid_e));
    const int lane_e = tid_e & 63, wid_e = tid_e >> 6, wr_e = wid_e >> 2, wc_e = wid_e & 3, fr_e = lane_e & 15, fq_e = lane_e >> 4;
#pragma unroll
    for (int ai = 0; ai < 2; ai++)
#pragma unroll
      for (int m = 0; m < 4; m++)
#pragma unroll
        for (int n = 0; n < 2; n++) {
          const int r = ai * 128 + wr_e * 64 + m * 16 + fr_e, cidx = wc_e * 32 + n * 16 + fq_e * 4;
          uint2 oa, ob;
          oa.x = pack2(acc[ai][0][m][n][0], acc[ai][0][m][n][1]); oa.y = pack2(acc[ai][0][m][n][2], acc[ai][0][m][n][3]);
          ob.x = pack2(acc[ai][1][m][n][0], acc[ai][1][m][n][1]); ob.y = pack2(acc[ai][1][m][n][2], acc[ai][1][m][n][3]);
          *(uint2*)(smem + UP_LA + RS + r * RS + cidx * 2) = oa;
          *(uint2*)(smem + UP_LB + r * RS + cidx * 2) = ob;
        }
    {
      const int pos0 = m0 >= TC ? ((m0 - TC) & 1023) : 0;
      const bool top = m0 >= TC && pos0 != 0, bot = m0 >= TC && pos0 + 256 != 1024;
      if (top || bot) {
        unsigned z0_ = 0u; asm volatile("" : "+v"(z0_)); uint4 ht0 = make_uint4(z0_, z0_, z0_, z0_), ht1 = ht0, hb0 = ht0, hb1 = ht0;
        if (top) { const bf16_t* hr = epi.h + (size_t)(m0 - 1) * K + lane_e * 8; ht0 = *(const uint4*)hr; ht1 = *(const uint4*)(hr + 512); }
        if (bot) { const bf16_t* hr = epi.h + (size_t)(m0 + 256) * K + lane_e * 8; hb0 = *(const uint4*)hr; hb1 = *(const uint4*)(hr + 512); }
#define DOT2_(a, b, c) __builtin_amdgcn_fdot2_f32_bf16(__builtin_bit_cast(bf16x2_t, (a)), __builtin_bit_cast(bf16x2_t, (b)), (c), false)
#define DOT8A(acc, a, b) acc = DOT2_(a.x, b.x, DOT2_(a.y, b.y, DOT2_(a.z, b.z, DOT2_(a.w, b.w, acc))))
#define DOT8(a, b) (bflo(a.x) * bflo(b.x) + bfhi(a.x) * bfhi(b.x) + bflo(a.y) * bflo(b.y) + bfhi(a.y) * bfhi(b.y) + bflo(a.z) * bflo(b.z) + bfhi(a.z) * bfhi(b.z) + bflo(a.w) * bflo(b.w) + bfhi(a.w) * bfhi(b.w))
#pragma unroll 1
        for (int fb = 0; fb < 4; fb++) {
          uint4 w0[4], w1[4];
#pragma unroll
          for (int fi = 0; fi < 4; fi++) { const bf16_t* wrow = epi.wt + (size_t)(n0 + wid_e * 16 + fb * 4 + fi) * K + lane_e * 8; w0[fi] = *(const uint4*)wrow; w1[fi] = *(const uint4*)(wrow + 512); }
#pragma unroll
          for (int fi = 0; fi < 4; fi++) {
            float st = 0.f, sb = 0.f;
            DOT8A(st, ht0, w0[fi]); DOT8A(st, ht1, w1[fi]); DOT8A(sb, hb0, w0[fi]); DOT8A(sb, hb1, w1[fi]);
            st = wave_sum(st); sb = wave_sum(sb);
            const int f = wid_e * 16 + fb * 4 + fi;
            if (lane_e == 0) { *(bf16_t*)(smem + UP_LA + f * 2) = f2bf(st); *(bf16_t*)(smem + UP_LA + 257 * RS + f * 2) = f2bf(sb); }
          }
        }
#undef DOT8
#undef DOT8A
#undef DOT2_
      } else if (tid_e < 256) {
        *(bf16_t*)(smem + UP_LA + (tid_e >> 7) * 257 * RS + (tid_e & 127) * 2) = 0;
      }
    }
    __syncthreads();
    {
      const int fc = tid_e & 15, f0 = (n0 >> 1) + fc * 8;
      f32x2 w0[4], w1[4], w2[4], bb[4];
      {
        const float* cw = epi.cw + f0;
        const float4 a0 = *(const float4*)cw, a1 = *(const float4*)(cw + 4), b0 = *(const float4*)(cw + DFF), b1 = *(const float4*)(cw + DFF + 4);
        const float4 c0 = *(const float4*)(cw + 2 * DFF), c1 = *(const float4*)(cw + 2 * DFF + 4), d0 = *(const float4*)(epi.cb + f0), d1 = *(const float4*)(epi.cb + f0 + 4);
        w0[0] = (f32x2){a0.x, a0.y}; w0[1] = (f32x2){a0.z, a0.w}; w0[2] = (f32x2){a1.x, a1.y}; w0[3] = (f32x2){a1.z, a1.w};
        w1[0] = (f32x2){b0.x, b0.y}; w1[1] = (f32x2){b0.z, b0.w}; w1[2] = (f32x2){b1.x, b1.y}; w1[3] = (f32x2){b1.z, b1.w};
        w2[0] = (f32x2){c0.x, c0.y}; w2[1] = (f32x2){c0.z, c0.w}; w2[2] = (f32x2){c1.x, c1.y}; w2[3] = (f32x2){c1.z, c1.w};
        bb[0] = (f32x2){d0.x, d0.y}; bb[1] = (f32x2){d0.z, d0.w}; bb[2] = (f32x2){d1.x, d1.y}; bb[3] = (f32x2){d1.z, d1.w};
      }
      constexpr float GC0 = -1.5957691216057308f * 1.4426950408889634f, GC1 = GC0 * 0.044715f;
#pragma unroll 2
      for (int j = 0; j < 8; j++) {
        const int r = (tid_e >> 4) + 32 * j;
        const char* ap = smem + UP_LA + r * RS + fc * 16;
        const uint4 x0 = *(const uint4*)ap, x1 = *(const uint4*)(ap + RS), x2 = *(const uint4*)(ap + 2 * RS);
        const uint4 bv = *(const uint4*)(smem + UP_LB + r * RS + fc * 16);
        const unsigned xa[4] = {x0.x, x0.y, x0.z, x0.w}, xb[4] = {x1.x, x1.y, x1.z, x1.w}, xc[4] = {x2.x, x2.y, x2.z, x2.w}, bw[4] = {bv.x, bv.y, bv.z, bv.w};
        unsigned ow[4];
#pragma unroll
        for (int q = 0; q < 4; q++) {
          const f32x2 a0 = {bflo(xa[q]), bfhi(xa[q])}, a1 = {bflo(xb[q]), bfhi(xb[q])}, a2 = {bflo(xc[q]), bfhi(xc[q])}, bq = {bflo(bw[q]), bfhi(bw[q])};
          const f32x2 a = a0 * w0[q] + (a1 * w1[q] + (a2 * w2[q] + bb[q]));
          const f32x2 v = a * (a * a * GC1 + GC0);
          const f32x2 d = (f32x2){__builtin_amdgcn_exp2f(v[0]), __builtin_amdgcn_exp2f(v[1])} + 1.f;
          const f32x2 o = a * (f32x2){__builtin_amdgcn_rcpf(d[0]), __builtin_amdgcn_rcpf(d[1])} * bq;
          ow[q] = pack2(o[0], o[1]);
        }
        uint4 ov; ov.x = ow[0]; ov.y = ow[1]; ov.z = ow[2]; ov.w = ow[3];
        __builtin_amdgcn_raw_buffer_store_b128((u32x4){ov.x, ov.y, ov.z, ov.w}, rsU, (unsigned)(((m0 + r) * DFF + f0) * 2), 0, WT_AUX);
      }
    }
  }
#undef SA
#undef SB
#undef STAGE
#undef rs_A
#undef rs_Bt
#undef LDA
#undef LDB
#undef MMA
#undef WAIT_V
#undef WAIT_L
#undef BARX
#undef SCHED
}

template <int BM, int BN, int GL, class Epi>
__device__ __forceinline__ void phase_gemm(const bf16_t* A, const bf16_t* Bt, int M, int N, int K, int bid, int nb, char* smem, const Epi& epi) {
  gemm_tiles<BM, BN, GL, Epi>(A, Bt, M, N, K, bid, nb, smem, epi);
}

constexpr int LQ = 0, LK = 26624;
constexpr int LRED = 0;
constexpr int LKT = 36864;
constexpr int LVT = 61440;
constexpr int LST = 86016;
constexpr int LGT = 125952;
constexpr int MIX_LDS_END = LGT + (2048 + 256 + 256 + 16 + 192) * 4;
constexpr float KSCALE = 0.10206207261596577f;
constexpr float LOG2E = 1.4426950408889634f;


template <bool ML>
__device__ __forceinline__ void mix_unit(PR p, int layer, int s, int c, int h, char* smem) {
  const int tid = TIDX, lane = tid & 63, wid = tid >> 6, lr = lane & 15, lg = lane >> 4;
  const int L = seq_len(s), row0 = seq_row0(s), nc = L >> 7;
  const bool latent = s >= 16; const int lb = s - 16;
  const int P0 = c * 128;
  const int QOFF = ML ? 2304 : 0, KOFF = ML ? 2688 : 384, GOFF = ML ? 3456 : 1152, MOFF = ML ? 640 : 0;
  const bf16_t* ktg = (ML ? p.ktm : p.ktr) + (size_t)h * 96 * T + row0;
  const bf16_t* vtg = (ML ? p.vtm : p.vtr) + (size_t)h * 96 * T + row0;
  const bool rope = (!ML) && latent;
  float* red = (float*)(smem + LRED);
  float* Eg = (float*)(smem + LGT); float* Xo = Eg + 2048; float* Bo = Xo + 256; float* sc = Bo + 256; float* nin = sc + 16;
  float lgd0 = 0.f, lgd1 = 0.f;
  if (!ML) {
    lgd0 = log_sigmoidf_(p.ret_decay_logit[layer * 8 + h]) * LOG2E;
    lgd1 = log_sigmoidf_(p.ret_decay_logit[layer * 8 + 4 + h]) * LOG2E;
  }
  __syncthreads();
  if (ML) {
    for (int t = tid; t < L; t += NT) {
      const float4* g4 = (const float4*)(p.gates + (size_t)(row0 + t) * 16);
      const float4 gA = g4[0], gB = g4[1], gC = g4[2], gD = g4[3];
      const float ga[4] = {gA.x, gA.y, gA.z, gA.w}, gb[4] = {gB.x, gB.y, gB.z, gB.w}, gc[4] = {gC.x, gC.y, gC.z, gC.w}, gd[4] = {gD.x, gD.y, gD.z, gD.w};
      float gi0 = 0.f, gf0 = 0.f, gi1 = 0.f, gf1 = 0.f;
#pragma unroll
      for (int q = 0; q < 4; q++) if (q == h) { gi0 = ga[q]; gf0 = gb[q]; gi1 = gc[q]; gf1 = gd[q]; }
      const float* gbias = p.ml_gate_bias + layer * 16;
      Eg[t] = gi0 + gbias[h]; Eg[1024 + t] = gi1 + gbias[8 + h];
      red[t] = log_sigmoidf_(gf0 + gbias[4 + h]); red[1024 + t] = log_sigmoidf_(gf1 + gbias[12 + h]);
    }
    __syncthreads();
    if (wid < 2) {
      const int dir = wid; const int per = L >> 6;
      const float m0 = latent ? p.state_m[((lb * DEPTH + layer) * 2 + dir) * 4 + h] : 0.f;
      float ev[16], bv[16];
      float run = 0.f;
#pragma unroll
      for (int k = 0; k < 16; k++) {
        ev[k] = 0.f; bv[k] = 0.f;
        if (k < per) {
          int u = lane * per + k; int t = dir ? L - 1 - u : u;
          ev[k] = Eg[dir * 1024 + t];
          run += red[dir * 1024 + t];
          bv[k] = run;
        }
      }
      float incl = run;
#pragma unroll
      for (int o = 1; o < 64; o <<= 1) { float v = __shfl_up(incl, o); if (lane >= o) incl += v; }
      const float excl = incl - run;
      float xm = -3.0e38f;
#pragma unroll
      for (int k = 0; k < 16; k++) if (k < per) { bv[k] += excl; ev[k] -= bv[k]; xm = fmaxf(xm, ev[k]); }
      float inclm = xm;
#pragma unroll
      for (int o = 1; o < 64; o <<= 1) { float v = __shfl_up(inclm, o); if (lane >= o) inclm = fmaxf(inclm, v); }
      float xrun = __shfl_up(inclm, 1); if (lane == 0) xrun = -3.0e38f;
      xrun = fmaxf(xrun, m0);
      const int nprior = dir ? L - P0 - 128 : P0;
      if (lane == 0) { sc[6 + dir] = m0; if (nprior == 0) sc[0 + dir] = m0; }
#pragma unroll
      for (int k = 0; k < 16; k++) if (k < per) {
        int u = lane * per + k; int t = dir ? L - 1 - u : u;
        xrun = fmaxf(xrun, ev[k]);
        Eg[dir * 1024 + t] = ev[k];
        if (t >= P0 && t < P0 + 128) { Xo[dir * 128 + t - P0] = xrun; Bo[dir * 128 + t - P0] = bv[k]; }
        if (u == nprior - 1) sc[0 + dir] = xrun;
        if (u == L - 1) { sc[2 + dir] = xrun; sc[4 + dir] = bv[k]; }
      }
    }
    __syncthreads();
  }
  const int wq = wid & 3, kgrp = wid >> 2;
  const int dt0 = 3 * (wq >> 1), et0 = 3 * (wq & 1);
#pragma unroll 1
  for (int dirr = 0; dirr < 2 * REP_STATE; dirr++) {
    const int dir = dirr & 1;
    const int nprior_ch = dir ? nc - 1 - c : c;
    const bool need_final = (!latent) && (dir ? (c == 0) : (c == nc - 1));
    const float lgdir = dir ? lgd1 : lgd0;
    f32x4 acc[3][3];
    const float Xin = ML ? sc[0 + dir] : 0.f;
    {
      float f0 = 0.f;
      if (latent && kgrp == 0) f0 = ML ? __expf(sc[6 + dir] - Xin) : 1.f;
      const float* S0 = (ML ? p.state_c : p.state_ret) + ((size_t)((lb * DEPTH + layer) * 2 + dir) * 4 + h) * 9216;
#pragma unroll
      for (int a = 0; a < 3; a++)
#pragma unroll
        for (int b = 0; b < 3; b++)
#pragma unroll
          for (int r = 0; r < 4; r++) {
            float v = 0.f;
            if (latent && kgrp == 0) v = S0[((dt0 + a) * 16 + 4 * lg + r) * 96 + (et0 + b) * 16 + lr] * f0;
            acc[a][b][r] = v;
          }
    }
    float nacc[2][2] = {{0.f, 0.f}, {0.f, 0.f}};
    const int nsteps = nprior_ch + (need_final ? 1 : 0);
    float wret[2][8];
#pragma unroll
    for (int it = 0; it < 2; it++)
#pragma unroll
      for (int q = 0; q < 8; q++) { const int tl = ((tid + it * 512) & 15) * 8 + q; wret[it][q] = ML ? 0.f : __builtin_amdgcn_exp2f((float)(dir ? tl : 127 - tl) * lgdir) * KSCALE; }
    u32x4 pk1[2], pk2[2], pv[3];
#define MIX_PREFETCH(jj) { \
      _Pragma("unroll") for (int it = 0; it < 2; it++) { const int pi = tid + it * 512; if (pi < 768) { const int d = pi >> 4, cc = pi & 15; \
          pk1[it] = *(const u32x4*)(ktg + (size_t)d * T + (jj) * 128 + cc * 8); pk2[it] = *(const u32x4*)(ktg + (size_t)(d + 48) * T + (jj) * 128 + cc * 8); } } \
      _Pragma("unroll") for (int it = 0; it < 3; it++) { const int ci = tid + it * 512, e = ci >> 4, cc = ci & 15; pv[it] = *(const u32x4*)(vtg + (size_t)e * T + (jj) * 128 + cc * 8); } }
    if (nsteps > 0) { const int j0 = (0 == nprior_ch) ? c : (dir ? nc - 1 : 0); MIX_PREFETCH(j0); }
#pragma unroll 1
    for (int st = 0; st < nsteps; st++) {
      const bool fin = st == nprior_ch;
      const int j = fin ? c : (dir ? nc - 1 - st : st);
      const float Xref = ML ? (fin ? sc[2 + dir] : Xin) : 0.f;
      if (fin) {
        __syncthreads();
        if (kgrp == 1) {
#pragma unroll
          for (int a = 0; a < 3; a++)
#pragma unroll
            for (int b = 0; b < 3; b++)
#pragma unroll
              for (int r = 0; r < 4; r++) { red[(wq * 36 + (a * 3 + b) * 4 + r) * 64 + lane] = acc[a][b][r]; acc[a][b][r] = 0.f; }
        }
        __syncthreads();
        if (kgrp == 0) {
          const float resc = ML ? __expf(Xin - Xref) : 1.f;
#pragma unroll
          for (int a = 0; a < 3; a++)
#pragma unroll
            for (int b = 0; b < 3; b++) {
              f32x4 v = acc[a][b];
#pragma unroll
              for (int r = 0; r < 4; r++) v[r] += red[(wq * 36 + (a * 3 + b) * 4 + r) * 64 + lane];
              uint2 o; o.x = pack2(v[0], v[1]); o.y = pack2(v[2], v[3]);
              *(uint2*)(smem + LST + dir * 19968 + ((et0 + b) * 16 + lr) * 208 + ((dt0 + a) * 16 + 4 * lg) * 2) = o;
              acc[a][b] = v * resc;
            }
        }
        if (ML && (tid & 15) == 0) {
          const float resc = __expf(Xin - Xref);
#pragma unroll
          for (int it = 0; it < 2; it++) {
            int d = (tid >> 4) + 32 * it;
            if (d < 48) { nin[dir * 96 + d] = nacc[it][0]; nin[dir * 96 + d + 48] = nacc[it][1]; nacc[it][0] *= resc; nacc[it][1] *= resc; }
          }
        }
      }
      __syncthreads();
#pragma unroll
      for (int it = 0; it < 2; it++) {
        const int pi = tid + it * 512;
        if (pi < 768) {
          const int d = pi >> 4, cc = pi & 15;
          const int t0 = j * 128 + cc * 8;
          const u32x4 k1 = pk1[it], k2 = pk2[it];
          float w[8];
          if (ML) {
            const float4 e0 = *(const float4*)(Eg + dir * 1024 + t0), e1 = *(const float4*)(Eg + dir * 1024 + t0 + 4);
            w[0] = e0.x; w[1] = e0.y; w[2] = e0.z; w[3] = e0.w; w[4] = e1.x; w[5] = e1.y; w[6] = e1.z; w[7] = e1.w;
#pragma unroll
            for (int q = 0; q < 8; q++) w[q] = __expf(w[q] - Xref) * KSCALE;
          } else {
#pragma unroll
            for (int q = 0; q < 8; q++) w[q] = wret[it][q];
          }
          float x1[8], x2[8];
          x1[0] = bflo(k1.x); x1[1] = bfhi(k1.x); x1[2] = bflo(k1.y); x1[3] = bfhi(k1.y); x1[4] = bflo(k1.z); x1[5] = bfhi(k1.z); x1[6] = bflo(k1.w); x1[7] = bfhi(k1.w);
          x2[0] = bflo(k2.x); x2[1] = bfhi(k2.x); x2[2] = bflo(k2.y); x2[3] = bfhi(k2.y); x2[4] = bflo(k2.z); x2[5] = bfhi(k2.z); x2[6] = bflo(k2.w); x2[7] = bfhi(k2.w);
          if (rope) {
            const float* ct = p.rope_cosT + d * 1024 + t0; const float* sn = p.rope_sinT + d * 1024 + t0;
            const float4 c0 = *(const float4*)ct, c1 = *(const float4*)(ct + 4), s0 = *(const float4*)sn, s1 = *(const float4*)(sn + 4);
            const float cv[8] = {c0.x, c0.y, c0.z, c0.w, c1.x, c1.y, c1.z, c1.w}, sv[8] = {s0.x, s0.y, s0.z, s0.w, s1.x, s1.y, s1.z, s1.w};
#pragma unroll
            for (int q = 0; q < 8; q++) { float a1 = x1[q] * cv[q] - x2[q] * sv[q], a2 = x2[q] * cv[q] + x1[q] * sv[q]; x1[q] = a1; x2[q] = a2; }
          }
          float s1 = 0.f, s2 = 0.f;
#pragma unroll
          for (int q = 0; q < 8; q++) { x1[q] *= w[q]; x2[q] *= w[q]; s1 += x1[q]; s2 += x2[q]; }
          uint4 o1, o2;
          o1.x = pack2(x1[0], x1[1]); o1.y = pack2(x1[2], x1[3]); o1.z = pack2(x1[4], x1[5]); o1.w = pack2(x1[6], x1[7]);
          o2.x = pack2(x2[0], x2[1]); o2.y = pack2(x2[2], x2[3]); o2.z = pack2(x2[4], x2[5]); o2.w = pack2(x2[6], x2[7]);
          *(uint4*)(smem + LKT + d * 256 + ((cc ^ (d & 15)) << 4)) = o1;
          *(uint4*)(smem + LKT + (d + 48) * 256 + ((cc ^ ((d + 48) & 15)) << 4)) = o2;
          if (ML) {
            { s1 = row16_sum(s1); s2 = row16_sum(s2); }
            nacc[it][0] += s1; nacc[it][1] += s2;
          }
        }
      }
#pragma unroll
      for (int it = 0; it < 3; it++) {
        const int ci = tid + it * 512, e = ci >> 4, cc = ci & 15;
        *(u32x4*)(smem + LVT + e * 256 + ((cc ^ (e & 15)) << 4)) = pv[it];
      }
      __syncthreads();
      if (st + 1 < nsteps) { const int jn = (st + 1 == nprior_ch) ? c : (dir ? nc - 2 - st : st + 1); MIX_PREFETCH(jn); }
      if (!ML) {
        const float g128 = __builtin_amdgcn_exp2f(128.f * lgdir);
#pragma unroll
        for (int a = 0; a < 3; a++)
#pragma unroll
          for (int b = 0; b < 3; b++) acc[a][b] = acc[a][b] * g128;
      }
#pragma unroll
      for (int kk = 0; kk < 2; kk++) {
        const int ch = (kgrp * 2 + kk) * 4 + lg;
        bf16x8 af[3], bfr[3];
#pragma unroll
        for (int a = 0; a < 3; a++) { int row = (dt0 + a) * 16 + lr; af[a] = *(const bf16x8*)(smem + LKT + row * 256 + ((ch ^ (row & 15)) << 4)); }
#pragma unroll
        for (int b = 0; b < 3; b++) { int row = (et0 + b) * 16 + lr; bfr[b] = *(const bf16x8*)(smem + LVT + row * 256 + ((ch ^ (row & 15)) << 4)); }
#pragma unroll
        for (int a = 0; a < 3; a++)
#pragma unroll
          for (int b = 0; b < 3; b++) acc[a][b] = __builtin_amdgcn_mfma_f32_16x16x32_bf16(af[a], bfr[b], acc[a][b], 0, 0, 0);
      }
    }
#undef MIX_PREFETCH
    __syncthreads();
    if (kgrp == 1) {
#pragma unroll
      for (int a = 0; a < 3; a++)
#pragma unroll
        for (int b = 0; b < 3; b++)
#pragma unroll
          for (int r = 0; r < 4; r++) red[(wq * 36 + (a * 3 + b) * 4 + r) * 64 + lane] = acc[a][b][r];
    }
    __syncthreads();
    if (kgrp == 0) {
      const size_t sidx = ((size_t)(s * DEPTH + layer) * 2 + dir) * 4 + h;
#pragma unroll
      for (int a = 0; a < 3; a++)
#pragma unroll
        for (int b = 0; b < 3; b++) {
          f32x4 v = acc[a][b];
#pragma unroll
          for (int r = 0; r < 4; r++) v[r] += red[(wq * 36 + (a * 3 + b) * 4 + r) * 64 + lane];
          if (need_final) {
            float* dst = p.out + (ML ? O_MC : O_SR) + sidx * 9216;
#pragma unroll
            for (int r = 0; r < 4; r++) dst[((dt0 + a) * 16 + 4 * lg + r) * 96 + (et0 + b) * 16 + lr] = v[r];
          } else {
            uint2 o; o.x = pack2(v[0], v[1]); o.y = pack2(v[2], v[3]);
            *(uint2*)(smem + LST + dir * 19968 + ((et0 + b) * 16 + lr) * 208 + ((dt0 + a) * 16 + 4 * lg) * 2) = o;
          }
        }
    }
    if (ML && (tid & 15) == 0) {
      const size_t sidx = ((size_t)(s * DEPTH + layer) * 2 + dir) * 4 + h;
      float f0 = 0.f; const float* n0 = p.state_n;
      if (latent) { f0 = __expf(sc[6 + dir] - Xin); n0 = p.state_n + ((size_t)((lb * DEPTH + layer) * 2 + dir) * 4 + h) * 96; }
#pragma unroll
      for (int it = 0; it < 2; it++) {
        int d = (tid >> 4) + 32 * it;
        if (d < 48) {
          if (need_final) { p.out[O_MN + sidx * 96 + d] = nacc[it][0]; p.out[O_MN + sidx * 96 + d + 48] = nacc[it][1]; }
          else {
            float a0 = nacc[it][0], a1 = nacc[it][1];
            if (latent) { a0 += f0 * n0[d]; a1 += f0 * n0[d + 48]; }
            nin[dir * 96 + d] = a0; nin[dir * 96 + d + 48] = a1;
          }
        }
      }
      if (need_final && tid == 0) p.out[O_MM + sidx] = sc[4 + dir] + sc[2 + dir];
    }
  }
#pragma unroll 1
  for (int orep = 0; orep < REP_OUT; orep++) {
  __syncthreads();
#pragma unroll
  for (int it = 0; it < 2; it++) {
    const int pi = tid + it * 512;
    if (pi < 768) {
      const int r = pi / 6, cc = pi % 6;
      const int pos = P0 + r;
      const bf16_t* pr = p.proj + (size_t)(row0 + pos) * INW + h * 96 + cc * 8;
      uint4 q1 = *(const uint4*)(pr + QOFF), q2 = *(const uint4*)(pr + QOFF + 48);
      uint4 k1 = *(const uint4*)(pr + KOFF), k2 = *(const uint4*)(pr + KOFF + 48);
      float a1[8], a2[8], b1[8], b2[8];
      a1[0] = bflo(q1.x); a1[1] = bfhi(q1.x); a1[2] = bflo(q1.y); a1[3] = bfhi(q1.y); a1[4] = bflo(q1.z); a1[5] = bfhi(q1.z); a1[6] = bflo(q1.w); a1[7] = bfhi(q1.w);
      a2[0] = bflo(q2.x); a2[1] = bfhi(q2.x); a2[2] = bflo(q2.y); a2[3] = bfhi(q2.y); a2[4] = bflo(q2.z); a2[5] = bfhi(q2.z); a2[6] = bflo(q2.w); a2[7] = bfhi(q2.w);
      b1[0] = bflo(k1.x); b1[1] = bfhi(k1.x); b1[2] = bflo(k1.y); b1[3] = bfhi(k1.y); b1[4] = bflo(k1.z); b1[5] = bfhi(k1.z); b1[6] = bflo(k1.w); b1[7] = bfhi(k1.w);
      b2[0] = bflo(k2.x); b2[1] = bfhi(k2.x); b2[2] = bflo(k2.y); b2[3] = bfhi(k2.y); b2[4] = bflo(k2.z); b2[5] = bfhi(k2.z); b2[6] = bflo(k2.w); b2[7] = bfhi(k2.w);
      if (rope) {
        const float* ct = p.rope_cos + pos * 48 + cc * 8; const float* sn = p.rope_sin + pos * 48 + cc * 8;
        const float4 c0 = *(const float4*)ct, c1 = *(const float4*)(ct + 4), s0 = *(const float4*)sn, s1 = *(const float4*)(sn + 4);
        const float cv[8] = {c0.x, c0.y, c0.z, c0.w, c1.x, c1.y, c1.z, c1.w}, sv[8] = {s0.x, s0.y, s0.z, s0.w, s1.x, s1.y, s1.z, s1.w};
#pragma unroll
        for (int q = 0; q < 8; q++) {
          float t1 = a1[q] * cv[q] - a2[q] * sv[q], t2 = a2[q] * cv[q] + a1[q] * sv[q]; a1[q] = t1; a2[q] = t2;
          float u1 = b1[q] * cv[q] - b2[q] * sv[q], u2 = b2[q] * cv[q] + b1[q] * sv[q]; b1[q] = u1; b2[q] = u2;
        }
      }
      uint4 o;
      o.x = pack2(a1[0], a1[1]); o.y = pack2(a1[2], a1[3]); o.z = pack2(a1[4], a1[5]); o.w = pack2(a1[6], a1[7]);
      *(uint4*)(smem + LQ + r * 208 + cc * 16) = o;
      o.x = pack2(a2[0], a2[1]); o.y = pack2(a2[2], a2[3]); o.z = pack2(a2[4], a2[5]); o.w = pack2(a2[6], a2[7]);
      *(uint4*)(smem + LQ + r * 208 + (cc + 6) * 16) = o;
      o.x = pack2(b1[0] * KSCALE, b1[1] * KSCALE); o.y = pack2(b1[2] * KSCALE, b1[3] * KSCALE); o.z = pack2(b1[4] * KSCALE, b1[5] * KSCALE); o.w = pack2(b1[6] * KSCALE, b1[7] * KSCALE);
      *(uint4*)(smem + LK + r * 208 + cc * 16) = o;
      o.x = pack2(b2[0] * KSCALE, b2[1] * KSCALE); o.y = pack2(b2[2] * KSCALE, b2[3] * KSCALE); o.z = pack2(b2[4] * KSCALE, b2[5] * KSCALE); o.w = pack2(b2[6] * KSCALE, b2[7] * KSCALE);
      *(uint4*)(smem + LK + r * 208 + (cc + 6) * 16) = o;
    }
  }
#pragma unroll
  for (int it = 0; it < 3; it++) {
    const int ci = tid + it * 512, e = ci >> 4, cc = ci & 15;
    uint4 v = *(const uint4*)(vtg + (size_t)e * T + P0 + cc * 8);
    *(uint4*)(smem + LVT + e * 256 + ((cc ^ (e & 15)) << 4)) = v;
  }
  __syncthreads();
  {
    const int i0 = wid * 16, il = i0 + lr;
    bf16x8 qf[3];
#pragma unroll
    for (int ks = 0; ks < 3; ks++) qf[ks] = *(const bf16x8*)(smem + LQ + il * 208 + (ks * 4 + lg) * 16);
    f32x4 pt[8];
#pragma unroll
    for (int jt = 0; jt < 8; jt++) {
      f32x4 a4 = zero4();
#pragma unroll
      for (int ks = 0; ks < 3; ks++) {
        bf16x8 kf = *(const bf16x8*)(smem + LK + (jt * 16 + lr) * 208 + (ks * 4 + lg) * 16);
        a4 = __builtin_amdgcn_mfma_f32_16x16x32_bf16(kf, qf[ks], a4, 0, 0, 0);
      }
      pt[jt] = a4;
      __builtin_amdgcn_sched_barrier(0);
    }
    constexpr int ND = ML ? 2 : 1;
    f32x4 o[ND][6];
    float den[2] = {0.f, 0.f};
    float xo[2] = {0.f, 0.f};
    if (ML) { xo[0] = Xo[il]; xo[1] = Xo[128 + il]; }
#pragma unroll
    for (int dd = 0; dd < ND; dd++) {
      bf16x8 pop[4];
#pragma unroll
      for (int jt2 = 0; jt2 < 4; jt2++) {
        float v[8];
#pragma unroll
        for (int q = 0; q < 8; q++) {
          const int jt = jt2 * 2 + (q >> 2), r = q & 3;
          const int jl = jt * 16 + 4 * lg + r;
          float w;
          if (!ML) {
            const int df = il - jl;
            w = df > 0 ? __builtin_amdgcn_exp2f((float)df * lgd0) : (df < 0 ? __builtin_amdgcn_exp2f((float)(-df) * lgd1) : 2.f);
          } else {
            const float e = Eg[dd * 1024 + P0 + jl];
            const bool ok = dd == 0 ? (jl <= il) : (jl >= il);
            w = ok ? __expf(e - xo[dd]) : 0.f;
          }
          v[q] = pt[jt][r] * w;
          den[dd] += v[q];
        }
        union { bf16x8 v8; uint4 u; } cv;
        cv.u.x = pack2(v[0], v[1]); cv.u.y = pack2(v[2], v[3]); cv.u.z = pack2(v[4], v[5]); cv.u.w = pack2(v[6], v[7]);
        pop[jt2] = cv.v8;
        __builtin_amdgcn_sched_barrier(0);
      }
#pragma unroll
      for (int et = 0; et < 6; et++) {
        f32x4 a4 = zero4();
        const int row = et * 16 + lr;
#pragma unroll
        for (int jt2 = 0; jt2 < 4; jt2++) {
          const int ch0 = jt2 * 4 + (lg >> 1), ch1 = ch0 + 2;
          union { bf16x8 v8; uint2 h2[2]; } vf;
          vf.h2[0] = *(const uint2*)(smem + LVT + row * 256 + ((ch0 ^ (row & 15)) << 4) + (lg & 1) * 8);
          vf.h2[1] = *(const uint2*)(smem + LVT + row * 256 + ((ch1 ^ (row & 15)) << 4) + (lg & 1) * 8);
          a4 = __builtin_amdgcn_mfma_f32_16x16x32_bf16(vf.v8, pop[jt2], a4, 0, 0, 0);
        }
        o[dd][et] = a4;
        __builtin_amdgcn_sched_barrier(0);
      }
    }
#pragma unroll
    for (int dir = 0; dir < 2; dir++) {
      float scale;
      if (!ML) scale = dir == 0 ? __builtin_amdgcn_exp2f((float)(il + 1) * lgd0) : __builtin_amdgcn_exp2f((float)(128 - il) * lgd1);
      else scale = __expf(sc[0 + dir] - xo[dir]);
#pragma unroll
      for (int et = 0; et < 6; et++) {
        f32x4 a4 = zero4();
#pragma unroll
        for (int ks = 0; ks < 3; ks++) {
          bf16x8 sf = *(const bf16x8*)(smem + LST + dir * 19968 + (et * 16 + lr) * 208 + (ks * 4 + lg) * 16);
          a4 = __builtin_amdgcn_mfma_f32_16x16x32_bf16(sf, qf[ks], a4, 0, 0, 0);
        }
        o[ML ? dir : 0][et] = o[ML ? dir : 0][et] + a4 * scale;
        __builtin_amdgcn_sched_barrier(0);
      }
      if (ML) {
        float dq = 0.f;
#pragma unroll
        for (int ks = 0; ks < 3; ks++) {
          union { bf16x8 v8; uint4 u; } cv; cv.v8 = qf[ks];
          const float* nn = nin + dir * 96 + ks * 32 + lg * 8;
          dq += bflo(cv.u.x) * nn[0] + bfhi(cv.u.x) * nn[1] + bflo(cv.u.y) * nn[2] + bfhi(cv.u.y) * nn[3] + bflo(cv.u.z) * nn[4] + bfhi(cv.u.z) * nn[5] + bflo(cv.u.w) * nn[6] + bfhi(cv.u.w) * nn[7];
        }
        den[dir] += scale * dq;
      }
    }
    f32x4 of[6];
    if (ML) {
      float nrm[2];
#pragma unroll
      for (int dir = 0; dir < 2; dir++) {
        float dsum = den[dir];
        dsum += __shfl_xor(dsum, 16); dsum += __shfl_xor(dsum, 32);
        const float M = Bo[dir * 128 + il] + xo[dir];
        nrm[dir] = __builtin_amdgcn_rcpf(fmaxf(fabsf(dsum), __expf(-M)));
      }
#pragma unroll
      for (int et = 0; et < 6; et++) of[et] = o[0][et] * nrm[0] + o[ND - 1][et] * nrm[1];
    } else {
#pragma unroll
      for (int et = 0; et < 6; et++) of[et] = o[0][et];
    }
    float ss = 0.f;
#pragma unroll
    for (int et = 0; et < 6; et++) ss += of[et][0] * of[et][0] + of[et][1] * of[et][1] + of[et][2] * of[et][2] + of[et][3] * of[et][3];
    ss += __shfl_xor(ss, 16); ss += __shfl_xor(ss, 32);
    const float rs = rsqrtf(ss * (1.f / 96.f) + EPS);
    const int row = row0 + P0 + il;
    const float* ng = (ML ? p.ml_norm_g : p.ret_norm_g) + layer * 384 + h * 96;
#pragma unroll
    for (int et = 0; et < 6; et++) {
      const int e0 = et * 16 + 4 * lg;
      const uint2 gg = *(const uint2*)(p.proj + (size_t)row * INW + GOFF + h * 96 + e0);
      const float4 n4 = *(const float4*)(ng + e0);
      float g[4] = {bflo(gg.x), bfhi(gg.x), bflo(gg.y), bfhi(gg.y)};
      float r4[4];
      const float nv[4] = {n4.x, n4.y, n4.z, n4.w};
#pragma unroll
      for (int r = 0; r < 4; r++) {
        const float gv = ML ? sigmoidf_(g[r]) : g[r] * sigmoidf_(g[r]);
        r4[r] = of[et][r] * rs * nv[r] * gv;
      }
      uint2 ov; ov.x = pack2(r4[0], r4[1]); ov.y = pack2(r4[2], r4[3]);
      *(uint2*)(p.mixed + (size_t)row * D + MOFF + h * 96 + e0) = ov;
    }
  }
  }
}

constexpr int HZ = 0, HX = 61440, HF = 94208, HO = 127488;
constexpr int FT_CTX = 2 * 256 * 2 * 512, FT_L = FT_CTX + 2 * 256 * 2 * 2048;
typedef float f32x16 __attribute__((ext_vector_type(16)));

__device__ __forceinline__ void hyena_unit(PR p, int layer, int path, int cg, char* smem) {
  const int tid = TIDX, lane = tid & 63, wid = tid >> 6;
  const int L = path ? 1024 : 256, lgL = path ? 10 : 8, NB = path ? 2 : 16, CH = path ? 4 : 2;
  const int c0 = cg * CH, ntok = NB * L, lgnt8 = path ? 8 : 9, tok0 = path ? TC : 0;
  const int ZL = 3 * L + ((3 * L) >> 2), ZO = L - 32;
  __syncthreads();
  u32x4 cvv[6]; unsigned hl[6], hr[6]; float cw0[6], cw1[6], cw2[6], cbb[6];
#pragma unroll
  for (int it = 0; it < 6; it++) {
    const int ci = tid + it * NT;
    const int t8 = ci & ((ntok >> 3) - 1), rest = ci >> lgnt8, arr = rest % 3, ch = rest / 3;
    const int tk = t8 * 8, tl = tk & (L - 1);
    const int col = arr * 256 + c0 + ch;
    const bf16_t* src = p.hyt + (size_t)col * T + tok0 + tk;
    cvv[it] = __builtin_nontemporal_load((const u32x4*)src);
    hl[it] = *(const unsigned short*)(src + (tl > 0 ? -1 : 0)); hr[it] = *(const unsigned short*)(src + (tl + 8 < L ? 8 : 7));
    cw0[it] = p.hy_conv_w[(layer * 3 + 0) * 768 + col]; cw1[it] = p.hy_conv_w[(layer * 3 + 1) * 768 + col]; cw2[it] = p.hy_conv_w[(layer * 3 + 2) * 768 + col]; cbb[it] = p.hy_conv_b[layer * 768 + col];
  }
  u32x4 fv[4];
#define HY_FLOAD(order_) { const int nch_ = CH * 2 * (L >> 2); \
    _Pragma("unroll") for (int j = 0; j < 4; j++) { const int ci = tid + j * NT; fv[j] = (u32x4){0u, 0u, 0u, 0u}; \
      if (ci < nch_) { const int u8 = ci & ((L >> 2) - 1), rest = ci >> (lgL - 2), cp = rest & 1, fc = rest >> 1; \
        fv[j] = __builtin_nontemporal_load((const u32x4*)(p.ft + (size_t)layer * FT_L + (path ? FT_CTX : 0) + ((size_t)(((order_) * 256 + c0 + fc) * 2 + cp) * 2 * L) + u8 * 8)); } } }
  HY_FLOAD(0);
  { unsigned zz_ = 0u; asm volatile("" : "+v"(zz_)); const uint4 z4_ = make_uint4(zz_, zz_, zz_, zz_);
    for (int i = tid; i < 61440 / 16; i += NT) ((uint4*)(smem + HZ))[i] = z4_; }
  __syncthreads();
#pragma unroll
  for (int it = 0; it < 6; it++) {
    const int ci = tid + it * NT;
    const int t8 = ci & ((ntok >> 3) - 1), rest = ci >> lgnt8, arr = rest % 3, ch = rest / 3;
    const int tk = t8 * 8, tl = tk & (L - 1), b = tk >> lgL;
    const u32x4 v = cvv[it];
    float x[10];
    x[0] = tl > 0 ? __uint_as_float(hl[it] << 16) : 0.f; x[9] = tl + 8 < L ? __uint_as_float(hr[it] << 16) : 0.f;
    x[1] = bflo(v.x); x[2] = bfhi(v.x); x[3] = bflo(v.y); x[4] = bfhi(v.y); x[5] = bflo(v.z); x[6] = bfhi(v.z); x[7] = bflo(v.w); x[8] = bfhi(v.w);
    float y[8];
#pragma unroll
    for (int q = 0; q < 8; q++) y[q] = cw0[it] * x[q] + cw1[it] * x[q + 1] + cw2[it] * x[q + 2] + cbb[it];
    uint4 o; o.x = pack2(y[0], y[1]); o.y = pack2(y[2], y[3]); o.z = pack2(y[4], y[5]); o.w = pack2(y[6], y[7]);
    if (arr == 0) { const int idx = ZO + tl, phys = idx + 8 * (idx >> 5); *(uint4*)(smem + HZ + ((ch * NB + b) * ZL + phys) * 2) = o; }
    else *(uint4*)(smem + HX + ((ch * 2 + arr - 1) * ntok + tk) * 2) = o;
  }
  const int cl = lane & 31, hh = lane >> 5;
  int ch, b, I;
  if (path) { ch = wid >> 1; b = wid & 1; I = cl; } else { ch = wid >> 2; b = (wid & 3) * 4 + (cl >> 3); I = cl & 7; }
  char* zb = smem + HZ + ((ch * NB + b) * ZL) * 2;
  const char* fbase = smem + HF + ((ch * 2 + (cl & 1)) * (2 * L + 32)) * 2;
#pragma unroll 1
  for (int order = 0; order < 2; order++) {
    {
      const int nch = CH * 2 * (L >> 2);
#pragma unroll
      for (int j = 0; j < 4; j++) {
        const int ci = tid + j * NT;
        if (ci < nch) {
          const int u8 = ci & ((L >> 2) - 1), rest = ci >> (lgL - 2), cp = rest & 1, fc = rest >> 1;
          *(u32x4*)(smem + HF + ((fc * 2 + cp) * (2 * L + 32) + u8 * 8) * 2) = fv[j];
        }
      }
    }
    __syncthreads();
    if (order == 0) HY_FLOAD(1);
    f32x16 acc;
#pragma unroll
    for (int r = 0; r < 16; r++) acc[r] = 0.f;
#pragma unroll 2
    for (int dl = -L + 16; dl <= L - 32; dl += 16) {
      const int u0 = L - dl - cl + 8 * hh - (cl & 1);
      const unsigned* fp = (const unsigned*)(fbase + u0 * 2);
      union { bf16x8 v8; unsigned u[4]; } af;
      af.u[0] = fp[0]; af.u[1] = fp[1]; af.u[2] = fp[2]; af.u[3] = fp[3];
      const int idx = ZO + 32 * I - dl + 8 * hh, phys = idx + 8 * (idx >> 5);
      const bf16x8 bfr = *(const bf16x8*)(zb + phys * 2);
      acc = __builtin_amdgcn_mfma_f32_32x32x16_bf16(af.v8, bfr, acc, 0, 0, 0);
    }
    __syncthreads();
    const float bias = p.hy_bias[(layer * 2 + order) * 256 + c0 + ch];
#pragma unroll
    for (int g = 0; g < 4; g++) {
      const int t = 32 * I + 8 * g + 4 * hh;
      const int idx = ZO + t, phys = idx + 8 * (idx >> 5);
      const uint2 z4 = *(const uint2*)(zb + phys * 2);
      const uint2 h4 = *(const uint2*)(smem + HX + ((ch * 2 + order) * ntok + b * L + t) * 2);
      const float zz[4] = {bflo(z4.x), bfhi(z4.x), bflo(z4.y), bfhi(z4.y)};
      const float hx[4] = {bflo(h4.x), bfhi(h4.x), bflo(h4.y), bfhi(h4.y)};
      float r4[4];
#pragma unroll
      for (int r = 0; r < 4; r++) r4[r] = hx[r] * (acc[4 * g + r] + bias * zz[r]);
      if (order == 0) { uint2 o; o.x = pack2(r4[0], r4[1]); o.y = pack2(r4[2], r4[3]); *(uint2*)(zb + phys * 2) = o; }
      else {
#pragma unroll
        for (int r = 0; r < 4; r++) *(bf16_t*)(smem + HO + ((b * L + t + r) * CH + ch) * 2) = f2bf(r4[r]);
      }
    }
    __syncthreads();
  }
#undef HY_FLOAD
  for (int tk = tid; tk < ntok; tk += NT) {
    bf16_t* dst = p.mixed + (size_t)(tok0 + tk) * D + 384 + c0;
    if (path) *(uint2*)dst = *(const uint2*)(smem + HO + tk * 8);
    else *(unsigned*)dst = *(const unsigned*)(smem + HO + tk * 4);
  }
}

#define XB_TMO      128
#define XB_XCNT(j)  (256  + 64 * (j))
#define XB_XSUB(j)  (1280 + 64 * (j))
#define XB_XGEN(j)  (2304 + 64 * (j))
#define XB_TOP      3328
#define XB_TOPGEN   3392
#define XCD_BAR_WORDS 3456
#define XB_SPIN_CAP (1u << 22)
__device__ __forceinline__ unsigned xb_ld(unsigned* p)              { return __hip_atomic_load(p, __ATOMIC_RELAXED, __HIP_MEMORY_SCOPE_AGENT); }
__device__ __forceinline__ unsigned xb_add(unsigned* p, unsigned v) { return __hip_atomic_fetch_add(p, v, __ATOMIC_RELAXED, __HIP_MEMORY_SCOPE_AGENT); }
__device__ __forceinline__ unsigned xb_xcc_id() { return (unsigned)__builtin_amdgcn_s_getreg((3 << 11) | 20) & 0xFu; }
#define XB_SPIN(cond, bar) do { unsigned _sp = 0; while (cond) { __builtin_amdgcn_s_sleep(1); \
    if ((++_sp & 255u) == 0u) { if (xb_ld(&(bar)[XB_TMO])) break; if (_sp > XB_SPIN_CAP) { atomicAdd(&(bar)[XB_TMO], 1u); break; } } } } while (0)
struct XcdBarrier { unsigned* bar; unsigned x; volatile LAS unsigned* st; };
__device__ __forceinline__ XcdBarrier xcd_barrier_post(unsigned* bar, volatile LAS unsigned* st) {
    XcdBarrier b; b.bar = bar; b.x = xb_xcc_id(); b.st = st;
    if (threadIdx.x == 0) (void)xb_add(&bar[XB_XCNT(b.x)], 1u);
    return b;
}
__device__ __forceinline__ void xcd_barrier_complete(unsigned* bar, unsigned x, unsigned& nloc, unsigned& nx) {
    const unsigned G = gridDim.x * gridDim.y * gridDim.z;
    unsigned sum, cnt, mine, sp = 0u;
    for (;;) {
        sum = 0u; cnt = 0u; mine = 0u;
#pragma unroll
        for (unsigned j = 0; j < 16; ++j) { const unsigned c = xb_ld(&bar[XB_XCNT(j)]); sum += c; cnt += (c > 0u) ? 1u : 0u; mine = (j == x) ? c : mine; }
        if (sum == G) break;
        __builtin_amdgcn_s_sleep(1);
        if ((++sp & 255u) == 0u) { if (xb_ld(&bar[XB_TMO])) break; if (sp > XB_SPIN_CAP) { atomicAdd(&bar[XB_TMO], 1u); break; } }
    }
    nloc = mine > 0u ? mine : 1u; nx = cnt > 0u ? cnt : 1u;
}
__device__ __forceinline__ void xcd_barrier(const XcdBarrier& b) {
    asm volatile("s_waitcnt vmcnt(0)" ::: "memory");
    __syncthreads();
    if (TIDX == 0) {
        unsigned* bar = b.bar;
        __builtin_amdgcn_s_waitcnt(0);
        unsigned nloc = b.st[0], nx = b.st[1];
        if (nloc == 0u) { xcd_barrier_complete(bar, b.x, nloc, nx); b.st[0] = nloc; b.st[1] = nx; }
        const unsigned old = xb_add(&bar[XB_XSUB(b.x)], 1u);
        const unsigned gen = old / nloc;
        if (old + 1u == (gen + 1u) * nloc) {
            __builtin_amdgcn_fence(__ATOMIC_RELEASE, "agent");
            asm volatile("s_waitcnt vmcnt(0)" ::: "memory");
            const unsigned og = xb_add(&bar[XB_TOP], 1u);
            const unsigned tg = og / nx;
            if (og + 1u == (tg + 1u) * nx) xb_add(&bar[XB_TOPGEN], 1u);
            else XB_SPIN(xb_ld(&bar[XB_TOPGEN]) == tg, bar);
            __builtin_amdgcn_fence(__ATOMIC_ACQUIRE, "agent");
            xb_add(&bar[XB_XGEN(b.x)], 1u);
            asm volatile("s_waitcnt vmcnt(0)" ::: "memory");
        } else {
            XB_SPIN(xb_ld(&bar[XB_XGEN(b.x)]) == gen, bar);
            __builtin_amdgcn_fence(__ATOMIC_ACQUIRE, "agent");
            asm volatile("s_waitcnt vmcnt(0)" ::: "memory");
        }
    }
    __syncthreads();
}


constexpr int MIXALL_UNITS = 576;
__device__ __forceinline__ void phase_mix_all(PR p, int layer, int rep, int bid, int nb, char* smem) {
  volatile LAS unsigned* bc = (volatile LAS unsigned*)(smem + SMEM_BYTES - 32);
  unsigned* ctr = p.bar + XCD_BAR_WORDS + layer + 8 * rep;
  for (int first = 1;; first = 0) {
    int u = bid;
    if (!first) {
      __syncthreads();
      if (TIDX == 0) *bc = atomicAdd(ctr, 1u) + (unsigned)nb;
      __syncthreads();
      u = (int)*bc;
    }
    if (u >= MIXALL_UNITS) break;
    int kind, a0 = 0, a1 = 0, a2 = 0;
    if (u < 128) { int v = u & 63; a0 = 16 + (v >> 5); a1 = (v >> 2) & 7; a2 = v & 3; kind = u < 64 ? 0 : 1; }
    else if (u < 192) { kind = 2; a0 = 1; a1 = u - 128; }
    else if (u < 448) { int v = (u - 192) & 127; a0 = v >> 3; a1 = (v >> 2) & 1; a2 = v & 3; kind = u < 320 ? 0 : 1; }
    else { kind = 2; a0 = 0; a1 = u - 448; }
    for (int rr = 0; rr < ((kind == PROBE_KIND) ? 2 : 1); rr++) {
    if (kind == 0) mix_unit<true>(p, layer, a0, a1, a2, smem);
    else if (kind == 1) mix_unit<false>(p, layer, a0, a1, a2, smem);
    else hyena_unit(p, layer, a0, a1, smem);
    }
  }
}


__device__ __forceinline__ void phase_prologue(PR p, char* smem) {
  volatile LAS unsigned* bc = (volatile LAS unsigned*)(smem + SMEM_BYTES - 32);
  unsigned* ctr = p.bar + XCD_BAR_WORDS + 40;
  constexpr int NF = DEPTH * 80, NM = DEPTH * 48, NR = 8, NTR = DEPTH * TR_L, NU = NF + NM + NR + NTR, FSTEP = 10;
  static_assert((NF - 1) * FSTEP < NU, "filter slots");
  for (int first = 1;; first = 0) {
    int u = (int)blockIdx.x;
    if (!first) {
      __syncthreads();
      if (TIDX == 0) *bc = atomicAdd(ctr, 1u) + gridDim.x;
      __syncthreads();
      u = (int)*bc;
    }
    if (u >= NU) break;
    const int fs = u / FSTEP;
    if (u - fs * FSTEP == 0 && fs < NF) { phase_filt(p, fs, 1 << 30, smem); continue; }
    const int v = u - (fs + 1 < NF ? fs + 1 : NF);
    if (v < NM) phase_mod(p, v, 1 << 30, smem);
    else if (v < NM + NR) phase_rope(p, v - NM, NR);
    else phase_transpose(p, v - NM - NR, 1 << 30, smem);
  }
}

enum { PH_TRANSPOSE = 0, PH_MOD, PH_ROPE, PH_FILT, PH_S0, PH_INPROJ, PH_RET, PH_ML, PH_RETST, PH_MLST, PH_HY1, PH_HY2A, PH_HY2B, PH_OUTPROJ, PH_S1, PH_UP, PH_ACT, PH_DOWN, PH_MIXF, PH_MIXALL, PH_OUTPROJ_F, PH_DOWN_F };

template <int ph>
__device__ __forceinline__ void run_phase(PR p, int layer, int bid, int nb, char* smem) {
  switch (ph) {
    case PH_TRANSPOSE: phase_transpose(p, bid, nb, smem); break;
    case PH_MOD: phase_mod(p, bid, nb, smem); break;
    case PH_ROPE: phase_rope(p, bid, nb); break;
    case PH_FILT: phase_filt(p, bid, nb, smem); break;
    case PH_S0: phase_rowpass(p, layer, 0, bid, nb); break;
    case PH_S1: phase_rowpass(p, layer, 1, bid, nb); break;
    case PH_INPROJ: {
      EpiProj e{p.proj, p.ktr, p.vtr, p.ktm, p.vtm, p.hyt, p.gates};
      phase_gemm<192, 256, USE_GLDS, EpiProj>(p.hbuf, p.wt_in + (size_t)layer * INWP * D, T, INWP, D, bid, nb, smem, e);
    } break;
    case PH_MIXALL: phase_mix_all(p, layer & 7, layer >> 3, bid, nb, smem); break;
    case PH_OUTPROJ: {
      EpiF32 e{p.raw, D};
      phase_gemm<192, 128, USE_GLDS, EpiF32>(p.mixed, p.wt_out + (size_t)layer * D * D, T, D, D, bid, nb, smem, e);
    } break;
    case PH_OUTPROJ_F: {
      const int slotid = layer * 2;
      EpiRow e{p.xbuf, p.x1buf, p.hbuf, p.mod + (size_t)layer * 3 * 6144, 2 * 1024, p.norm_mix_post + layer * D,
               p.mod + (size_t)layer * 3 * 6144, 3 * 1024, p.norm_ffn_pre + layer * D,
               p.rstats, (unsigned)(slotid + 1), p.bar + XCD_BAR_WORDS + 64 + 8 * 32 * 16};
      phase_gemm<192, 128, 2, EpiRow>(p.mixed, p.wt_out + (size_t)layer * D * D, T, D, D, bid, nb, smem, e);
    } break;
    case PH_DOWN_F: {
      const int slotid = layer * 2 + 1;
      const bool last = layer + 1 >= DEPTH;
      const int ln = last ? layer : layer + 1;
      EpiRow e{p.x1buf, last ? p.out : p.xbuf, last ? (bf16_t*)nullptr : p.hbuf, p.mod + (size_t)layer * 3 * 6144, 5 * 1024, p.norm_ffn_post + layer * D,
               p.mod + (size_t)ln * 3 * 6144, 0, p.norm_mix_pre + ln * D,
               p.rstats, (unsigned)(slotid + 1), p.bar + XCD_BAR_WORDS + 64 + 8 * 32 * 16};
      phase_gemm<192, 128, 2, EpiRow>(p.ubuf, p.wt_down + (size_t)layer * D * DFF, T, D, DFF, bid, nb, smem, e);
    } break;
    case PH_UP: {
      EpiUp e{p.ubuf, p.hbuf, p.wt_up + (size_t)layer * 2 * DFF * D, p.ffn_conv_w + (size_t)layer * 3 * DFF, p.ffn_conv_b + (size_t)layer * DFF};
#if UP8
      gemm_up8(p.hbuf, p.wt_up + (size_t)layer * 2 * DFF * D, bid, nb, smem, e);
#else
      phase_gemm<256, 256, USE_GLDS, EpiUp>(p.hbuf, p.wt_up + (size_t)layer * 2 * DFF * D, T, 2 * DFF, D, bid, nb, smem, e);
#endif
    } break;
    case PH_DOWN: {
      EpiF32 e{p.raw, D};
      phase_gemm<192, 128, USE_GLDS, EpiF32>(p.ubuf, p.wt_down + (size_t)layer * D * DFF, T, D, DFF, bid, nb, smem, e);
    } break;
  }
}

#ifndef MULTI_LAUNCH
#define MULTI_LAUNCH 0
#endif
__global__ void __launch_bounds__(NT) k_mega(Params p_) {
  extern __shared__ __attribute__((aligned(16))) char smem[];
  const int bid = blockIdx.x, nb = gridDim.x;
  volatile LAS unsigned* st = (volatile LAS unsigned*)(smem + SMEM_BYTES - 16);
  if (TIDX == 0) { st[0] = 0u; st[1] = 0u; st[2] = 0u; st[3] = 0u; }
  __syncthreads();
  (void)xcd_barrier_post(get_params()->bar, st);
#define BAR() { XcdBarrier xb_; xb_.bar = get_params()->bar; xb_.x = xb_xcc_id(); xb_.st = st; xcd_barrier(xb_); }
  phase_prologue(*get_params(), smem);
  BAR();
  run_phase<PH_S0>(*get_params(), 0, bid, nb, smem);
  BAR();
  for (int l = 0; l < DEPTH; l++) {
    for (int rep = 0; rep < REP_G1; rep++) { run_phase<PH_INPROJ>(*get_params(), l, bid, nb, smem); BAR(); }
    for (int rep = 0; rep < REP_MIX; rep++) { run_phase<PH_MIXALL>(*get_params(), l + 8 * rep, bid, nb, smem); BAR(); }
    for (int rep = 0; rep < REP_BAR; rep++) BAR();
    for (int rep = 0; rep < REP_G2; rep++) { run_phase<PH_OUTPROJ_F>(*get_params(), l, bid, nb, smem); BAR(); }
    for (int rep = 0; rep < REP_G3; rep++) { run_phase<PH_UP>(*get_params(), l, bid, nb, smem); BAR(); }
    for (int rep = 0; rep < REP_G4; rep++) { run_phase<PH_DOWN_F>(*get_params(), l, bid, nb, smem); if (rep + 1 < REP_G4) BAR(); }
    if (l + 1 < DEPTH) BAR();
  }
}

static inline size_t align_up(size_t x) { return (x + 255) & ~(size_t)255; }

extern "C" void kernel_launch(void* const* d_in, const int* in_sizes, int n_in, void* d_out, int out_size, void* d_ws, size_t ws_size, hipStream_t stream) {
  Params p{};
  const float* const* in = (const float* const*)d_in;
  p.x_prompt = in[0]; p.x_sample = in[1]; p.c = in[2]; p.state_ret = in[3]; p.state_c = in[4]; p.state_n = in[5]; p.state_m = in[6]; p.c_ctx = in[7];
  p.norm_mix_pre = in[8]; p.norm_mix_post = in[9]; p.norm_ffn_pre = in[10]; p.norm_ffn_post = in[11]; p.w_mod = in[12]; p.b_mod = in[13]; p.w_in = in[14]; p.w_out = in[15];
  p.ret_decay_logit = in[16]; p.ret_norm_g = in[17]; p.hy_conv_w = in[18]; p.hy_conv_b = in[19]; p.hy_f_w1 = in[20]; p.hy_f_b1 = in[21]; p.hy_f_w2 = in[22]; p.hy_f_b2 = in[23];
  p.hy_f_w3 = in[24]; p.hy_f_b3 = in[25]; p.hy_sin_freq = in[26]; p.hy_bias = in[27]; p.ml_gate_bias = in[28]; p.ml_norm_g = in[29];
  p.w_up = in[30]; p.ffn_conv_w = in[31]; p.ffn_conv_b = in[32]; p.w_down = in[33];
  p.out = (float*)d_out;
  char* w = (char*)d_ws; size_t off = 0;
  auto take = [&](size_t bytes) { char* r = w + off; off = align_up(off + bytes); return r; };
  p.wt_in = (bf16_t*)take((size_t)DEPTH * INWP * D * 2);
  p.wt_out = (bf16_t*)take((size_t)DEPTH * D * D * 2);
  p.wt_up = (bf16_t*)take((size_t)DEPTH * 2 * DFF * D * 2);
  p.wt_down = (bf16_t*)take((size_t)DEPTH * D * DFF * 2);
  p.mod = (float*)take((size_t)DEPTH * 3 * 6144 * 4);
  p.rope_cos = (float*)take(1024 * 48 * 4); p.rope_sin = (float*)take(1024 * 48 * 4);
  p.rope_cosT = (float*)take(1024 * 48 * 4); p.rope_sinT = (float*)take(1024 * 48 * 4);
  p.xbuf = (float*)take((size_t)T * D * 4); p.x1buf = (float*)take((size_t)T * D * 4); p.raw = (float*)take((size_t)T * D * 4);
  p.hbuf = (bf16_t*)take((size_t)T * D * 2);
  p.ubuf = (bf16_t*)take((size_t)T * DFF * 2);
  p.proj = (bf16_t*)take((size_t)T * INW * 2);
  p.ktr = (bf16_t*)take((size_t)384 * T * 2); p.vtr = (bf16_t*)take((size_t)384 * T * 2);
  p.ktm = (bf16_t*)take((size_t)384 * T * 2); p.vtm = (bf16_t*)take((size_t)384 * T * 2);
  p.hyt = (bf16_t*)take((size_t)768 * T * 2);
  p.mixed = (bf16_t*)take((size_t)T * D * 2);
  p.gates = (float*)take((size_t)T * 16 * 4);
  p.ft = (bf16_t*)take((size_t)DEPTH * (2 * 256 * 2 * 512 + 2 * 256 * 2 * 2048) * 2);
  p.bar = (unsigned*)take((XCD_BAR_WORDS + 64 + 8 * 32 * 16 + 16) * 4);
  p.rstats = (unsigned long long*)take((size_t)8 * 32 * 192 * 8 * 2 * 8);
  if (off > ws_size) { fprintf(stderr, "workspace too small: need %zu have %zu\n", off, ws_size); return; }

  {
    static int grid = 0;
    if (grid == 0) {
      int dev = 0, cus = 0;
      if (hipGetDevice(&dev) != hipSuccess || hipDeviceGetAttribute(&cus, hipDeviceAttributeMultiprocessorCount, dev) != hipSuccess || cus <= 0) { fprintf(stderr, "device query failed\n"); grid = -1; return; }
      if (hipFuncSetAttribute((const void*)k_mega, hipFuncAttributeMaxDynamicSharedMemorySize, SMEM_BYTES) != hipSuccess) { fprintf(stderr, "hipFuncSetAttribute failed\n"); grid = -1; return; }
      grid = cus;
    }
    if (grid < 0) return;
    if (hipMemsetAsync(p.bar, 0, (XCD_BAR_WORDS + 64 + 8 * 32 * 16 + 16) * 4, stream) != hipSuccess) { fprintf(stderr, "memset failed\n"); return; }
    p.fuse_rows = 1; p.pad_ = 0;
    if (grid < 256) { fprintf(stderr, "this kernel needs >= 256 CUs (one resident workgroup per column tile of the fused residual epilogues)\n"); return; }
    hipLaunchKernelGGL(k_mega, dim3(grid), dim3(NT), SMEM_BYTES, stream, p);
  }
}
```

```cpp
#include <hip/hip_runtime.h>
#include <stdint.h>
#include <stdio.h>

#define NT 512
#define LAS __attribute__((address_space(3)))
constexpr int SMEM_BYTES = 147456;
typedef unsigned short bf16_t;
typedef short bf16x8 __attribute__((ext_vector_type(8)));
typedef float f32x4 __attribute__((ext_vector_type(4)));
typedef unsigned u32x4 __attribute__((ext_vector_type(4)));

constexpr int D = 1024, T = 6144, TC = 4096, DEPTH = 4;
constexpr int INW = 3856, INWP = 4096, DFF = 4096;
constexpr float EPS = 1e-6f;
constexpr size_t O_YP = 0, O_YS = 4194304, O_SR = 6291456, O_MC = 11010048, O_MN = 15728640, O_MM = 15777792;

#ifndef REP_MIX
#define REP_MIX 1
#endif
#ifndef REP_ELT
#define REP_ELT 1
#endif
#ifndef REP_BAR
#define REP_BAR 0
#endif
#ifndef REP_TR
#define REP_TR 1
#endif
#ifndef REP_MOD
#define REP_MOD 1
#endif
#ifndef REP_FILT
#define REP_FILT 1
#endif
#ifndef REP_STATE
#define REP_STATE 1
#endif
#ifndef REP_OUT
#define REP_OUT 1
#endif
#ifndef UP8
#define UP8 1
#endif
#ifndef USE_GLDS
#define USE_GLDS 1
#endif
#ifndef PROBE_KIND
#define PROBE_KIND 9
#endif
#ifndef REP_EPI
#define REP_EPI 1
#endif
#ifndef REP_G1
#define REP_G1 1
#endif
#ifndef REP_G2
#define REP_G2 1
#endif
#ifndef REP_G3
#define REP_G3 1
#endif
#ifndef REP_G4
#define REP_G4 1
#endif
#ifndef NAIVE_MIX
#define NAIVE_MIX 0
#endif
#ifndef NAIVE_GEMM
#define NAIVE_GEMM 0
#endif

struct Params {
  const float *x_prompt, *x_sample, *c, *state_ret, *state_c, *state_n, *state_m, *c_ctx;
  const float *norm_mix_pre, *norm_mix_post, *norm_ffn_pre, *norm_ffn_post, *w_mod, *b_mod, *w_in, *w_out;
  const float *ret_decay_logit, *ret_norm_g, *hy_conv_w, *hy_conv_b, *hy_f_w1, *hy_f_b1, *hy_f_w2, *hy_f_b2, *hy_f_w3, *hy_f_b3, *hy_sin_freq, *hy_bias, *ml_gate_bias, *ml_norm_g;
  const float *w_up, *ffn_conv_w, *ffn_conv_b, *w_down;
  float* out;
  bf16_t *wt_in, *wt_out, *wt_up, *wt_down;
  float *mod, *rope_cos, *rope_sin, *rope_cosT, *rope_sinT;
  float *xbuf, *x1buf, *raw;
  bf16_t *hbuf, *proj, *ktr, *vtr, *ktm, *vtm, *hyt, *mixed, *ubuf;
  float *gates;
  bf16_t* ft;
  unsigned* bar;
  unsigned long long* rstats;
  int fuse_rows; int pad_;
};

#define CONSTAS __attribute__((address_space(4)))
typedef const CONSTAS Params& PR;
__device__ __forceinline__ const CONSTAS Params* get_params() {
  const CONSTAS Params* pp = (const CONSTAS Params*)__builtin_amdgcn_kernarg_segment_ptr();
  asm volatile("" : "+s"(pp));
  return pp;
}
__device__ __forceinline__ int opaque_tid() { int t = threadIdx.x; asm volatile("" : "+v"(t)); return t; }
#define TIDX opaque_tid()

__device__ __forceinline__ unsigned cvt_pk_bf16(float lo, float hi) { unsigned r; asm("v_cvt_pk_bf16_f32 %0, %1, %2" : "=v"(r) : "v"(lo), "v"(hi)); return r; }
__device__ __forceinline__ bf16_t f2bf(float f) { return (bf16_t)(cvt_pk_bf16(f, 0.f) & 0xffffu); }
__device__ __forceinline__ float bf2f(bf16_t h) { return __uint_as_float(((unsigned)h) << 16); }
__device__ __forceinline__ float bflo(unsigned u) { return __uint_as_float(u << 16); }
__device__ __forceinline__ float bfhi(unsigned u) { return __uint_as_float(u & 0xffff0000u); }
__device__ __forceinline__ unsigned pack2(float a, float b) { return cvt_pk_bf16(a, b); }
__device__ __forceinline__ f32x4 zero4() { float z = 0.f; asm volatile("" : "+v"(z)); return (f32x4){z, z, z, z}; }
__device__ __forceinline__ float row16_sum(float v) {
  v += __int_as_float(__builtin_amdgcn_update_dpp(0, __float_as_int(v), 0xB1, 0xF, 0xF, false));
  v += __int_as_float(__builtin_amdgcn_update_dpp(0, __float_as_int(v), 0x4E, 0xF, 0xF, false));
  v += __int_as_float(__builtin_amdgcn_update_dpp(0, __float_as_int(v), 0x141, 0xF, 0xF, false));
  v += __int_as_float(__builtin_amdgcn_update_dpp(0, __float_as_int(v), 0x140, 0xF, 0xF, false));
  return v;
}
__device__ __forceinline__ float wave_sum(float v) {
  v = row16_sum(v);
  v += __shfl_xor(v, 16); v += __shfl_xor(v, 32);
  return v;
}
__device__ __forceinline__ float sigmoidf_(float x) { return __builtin_amdgcn_rcpf(1.f + __expf(-x)); }
__device__ __forceinline__ float log_sigmoidf_(float x) { return fminf(x, 0.f) - log1pf(__expf(-fabsf(x))); }
__device__ __forceinline__ float gelu_tanh(float x) {
  const float k = 0.7978845608028654f;
  float u = k * (x + 0.044715f * x * x * x);
  return 0.5f * x * (1.f + tanhf(u));
}
__device__ __forceinline__ int seq_len(int s) { return s < 16 ? 256 : 1024; }
__device__ __forceinline__ int seq_row0(int s) { return s < 16 ? s * 256 : TC + (s - 16) * 1024; }
__device__ __forceinline__ int row_mod(int row) { return row < TC ? 0 : 1 + ((row - TC) >> 10); }

template <class RowFn>
__device__ __forceinline__ void tr_batch(const float* __restrict__ src, int K, int N, int k0, int nt0, int cnt, bf16_t* __restrict__ dst, RowFn drow, float* lds) {
  const int tid = TIDX;
  float4 v[4][2];
#pragma unroll
  for (int b = 0; b < 4; b++)
#pragma unroll
    for (int i = 0; i < 2; i++) {
      const int k = (tid >> 4) + 32 * i, n = (nt0 + b) * 64 + (tid & 15) * 4;
      v[b][i] = make_float4(0.f, 0.f, 0.f, 0.f);
      if (b < cnt && n < N) { const f32x4 t_ = __builtin_nontemporal_load((const f32x4*)(src + (size_t)(k0 + k) * N + n)); v[b][i] = make_float4(t_[0], t_[1], t_[2], t_[3]); }
    }
  __syncthreads();
#pragma unroll
  for (int b = 0; b < 4; b++)
#pragma unroll
    for (int i = 0; i < 2; i++) {
      const int k = (tid >> 4) + 32 * i, n4 = (tid & 15) * 4;
      float* l = lds + b * 64 * 65;
      l[(n4 + 0) * 65 + k] = v[b][i].x; l[(n4 + 1) * 65 + k] = v[b][i].y; l[(n4 + 2) * 65 + k] = v[b][i].z; l[(n4 + 3) * 65 + k] = v[b][i].w;
    }
  __syncthreads();
#pragma unroll
  for (int b = 0; b < 4; b++) if (b < cnt) {
    const int n = tid >> 3, kc = (tid & 7) * 8;
    const float* r = lds + b * 64 * 65 + n * 65 + kc;
    uint4 o;
    o.x = pack2(r[0], r[1]); o.y = pack2(r[2], r[3]); o.z = pack2(r[4], r[5]); o.w = pack2(r[6], r[7]);
    __builtin_nontemporal_store((u32x4){o.x, o.y, o.z, o.w}, (u32x4*)(dst + (size_t)(drow(nt0 + b) + n) * K + k0 + kc));
  }
}

constexpr int TR_IN = 16 * 16, TR_OUT = 16 * 4, TR_UP = 16 * 32, TR_DN = 64 * 4, TR_L = TR_IN + TR_OUT + TR_UP + TR_DN;
__device__ __forceinline__ void phase_transpose(PR p, int bid, int nb, char* smem) {
  float* lds = (float*)smem;
  {
    const int u = bid;
    int l = u / TR_L, r = u % TR_L;
    if (r < TR_IN) {
      int kt = r >> 4, nb4 = r & 15;
      tr_batch(p.w_in + (size_t)l * D * INW, D, INW, kt * 64, nb4 * 4, 4, p.wt_in + (size_t)l * INWP * D, [](int nt) { return nt * 64; }, lds);
    } else if ((r -= TR_IN) < TR_OUT) {
      int kt = r >> 2, nb4 = r & 3;
      tr_batch(p.w_out + (size_t)l * D * D, D, D, kt * 64, nb4 * 4, 4, p.wt_out + (size_t)l * D * D, [](int nt) { return nt * 64; }, lds);
    } else if ((r -= TR_OUT) < TR_UP) {
      int kt = r >> 5, nb4 = r & 31;
      tr_batch(p.w_up + (size_t)l * D * 2 * DFF, D, 2 * DFF, kt * 64, nb4 * 4, 4, p.wt_up + (size_t)l * 2 * DFF * D, [](int nt) { return nt < 64 ? (nt >> 1) * 256 + (nt & 1) * 64 : ((nt - 64) >> 1) * 256 + 128 + (nt & 1) * 64; }, lds);
    } else {
      r -= TR_UP;
      int kt = r >> 2, nb4 = r & 3;
      tr_batch(p.w_down + (size_t)l * DFF * D, DFF, D, kt * 64, nb4 * 4, 4, p.wt_down + (size_t)l * D * DFF, [](int nt) { return nt * 64; }, lds);
    }
  }
}

__device__ __forceinline__ void phase_mod(PR p, int bid, int nb, char* smem) {
  float* sv = (float*)smem;
  float* red = sv + 3 * 1024;
  const int tid = TIDX, lane = tid & 63, wid = tid >> 6;
  for (int i = tid; i < 3 * 1024; i += NT) {
    int v = i >> 10, k = i & 1023;
    float x = v == 0 ? p.c_ctx[k] : p.c[(v - 1) * 1024 + k];
    sv[i] = x * sigmoidf_(x);
  }
  __syncthreads();
  {
    const int u = bid;
    int l = u / 48, cb = u % 48;
    int kg = wid * 2 + (lane >> 5), cl = lane & 31;
    const float* w = p.w_mod + (size_t)l * D * 6144 + cb * 128 + cl * 4;
    float acc[3][4] = {};
#pragma unroll 16
    for (int k = kg * 64; k < kg * 64 + 64; k++) {
      const f32x4 wv_ = __builtin_nontemporal_load((const f32x4*)(w + (size_t)k * 6144)); const float4 wv = make_float4(wv_[0], wv_[1], wv_[2], wv_[3]);
#pragma unroll
      for (int v = 0; v < 3; v++) {
        float s = sv[v * 1024 + k];
        acc[v][0] += s * wv.x; acc[v][1] += s * wv.y; acc[v][2] += s * wv.z; acc[v][3] += s * wv.w;
      }
    }
#pragma unroll
    for (int v = 0; v < 3; v++)
#pragma unroll
      for (int j = 0; j < 4; j++) red[(kg * 3 + v) * 128 + cl * 4 + j] = acc[v][j];
    __syncthreads();
    if (tid < 384) {
      int v = tid >> 7, cidx = tid & 127;
      float s = 0.f;
      for (int g = 0; g < 16; g++) s += red[(g * 3 + v) * 128 + cidx];
      int col = cb * 128 + cidx;
      p.mod[((size_t)l * 3 + v) * 6144 + col] = s + p.b_mod[(size_t)l * 6144 + col];
    }
    __syncthreads();
  }
}

__device__ __forceinline__ void phase_rope(PR p, int bid, int nb) {
  for (int i = bid * NT + TIDX; i < 1024 * 48; i += nb * NT) {
    int pos = i / 48, j = i % 48;
    int f = j < 24 ? j : j - 24;
    float base = j < 24 ? (float)(pos >> 6) : (float)(pos & 63);
    float freq = __builtin_amdgcn_exp2f(-(float)f * (13.287712379549449f / 24.f));
    float a = base * freq;
    float cv = cosf(a), sv = sinf(a);
    p.rope_cos[i] = cv; p.rope_sin[i] = sv; p.rope_cosT[j * 1024 + pos] = cv; p.rope_sinT[j * 1024 + pos] = sv;
  }
}

constexpr int FT_CTX_ = 2 * 256 * 2 * 512, FT_L_ = FT_CTX_ + 2 * 256 * 2 * 2048;
#define FSIN(x) __builtin_amdgcn_sinf((x) * 0.15915494309189535f)
__device__ __forceinline__ void phase_filt(PR p, int bid, int nb, char* smem) {
  float* feat = (float*)smem;
  float* h1 = feat + 128 * 33;
  float* h2 = h1 + 128 * 64;
  float* w3s = h2 + 128 * 65;
  float* w1s = w3s + 64 * 128;
  float* w2s = w1s + 33 * 64;
  const int tid = TIDX, lane = tid & 63, wid = tid >> 6;
  {
    const int u = bid;
    const int l = u / 80, r = u % 80;
    const int path = r < 16 ? 0 : 1;
    const int Lp = path ? 1024 : 256;
    const int pb = path ? (r - 16) >> 3 : r >> 3, nblk = r & 7;
    const int pos0 = pb * 128;
    __syncthreads();
    for (int i = tid; i < 128 * 33; i += NT) {
      int pp = i / 33, j = i % 33;
      float tn = (float)(pos0 + pp) / (float)Lp;
      float v;
      if (j == 0) v = tn;
      else {
        int bi = (j - 1) & 15;
        float band = 1e-4f + (float)bi * ((15.f - 1e-4f) / 15.f);
        const float rev = tn * band;
        v = j <= 16 ? __builtin_amdgcn_cosf(rev) : __builtin_amdgcn_sinf(rev);
      }
      feat[i] = v;
    }
    {
      float4 t3[4], t1[2], t2[2];
#pragma unroll
      for (int j = 0; j < 4; j++) { const int i4 = tid + j * NT, k = i4 >> 5, n4 = i4 & 31; t3[j] = *(const float4*)(p.hy_f_w3 + ((size_t)l * 64 + k) * 1024 + nblk * 128 + n4 * 4); }
#pragma unroll
      for (int j = 0; j < 2; j++) { const int i4 = tid + j * NT; t1[j] = i4 < 528 ? *(const float4*)(p.hy_f_w1 + (size_t)l * 33 * 64 + i4 * 4) : make_float4(0.f, 0.f, 0.f, 0.f); t2[j] = *(const float4*)(p.hy_f_w2 + (size_t)l * 64 * 64 + i4 * 4); }
#pragma unroll
      for (int j = 0; j < 4; j++) *(float4*)(w3s + (tid + j * NT) * 4) = t3[j];
#pragma unroll
      for (int j = 0; j < 2; j++) { const int i4 = tid + j * NT; if (i4 < 528) *(float4*)(w1s + i4 * 4) = t1[j]; *(float4*)(w2s + i4 * 4) = t2[j]; }
    }
    __syncthreads();
    {
      const int jq = tid & 15, pg = tid >> 4;
      float acc[4][4];
      {
        const float4 b1 = *(const float4*)(p.hy_f_b1 + l * 64 + 4 * jq);
#pragma unroll
        for (int pp = 0; pp < 4; pp++) { acc[pp][0] = b1.x; acc[pp][1] = b1.y; acc[pp][2] = b1.z; acc[pp][3] = b1.w; }
      }
#pragma unroll 3
      for (int k = 0; k < 33; k++) {
        const float4 w = *(const float4*)(w1s + k * 64 + 4 * jq);
#pragma unroll
        for (int pp = 0; pp < 4; pp++) { const float f = feat[(pg * 4 + pp) * 33 + k]; acc[pp][0] += f * w.x; acc[pp][1] += f * w.y; acc[pp][2] += f * w.z; acc[pp][3] += f * w.w; }
      }
      const float4 fr = *(const float4*)(p.hy_sin_freq + l * 64 + 4 * jq);
#pragma unroll
      for (int pp = 0; pp < 4; pp++)
        *(float4*)(h1 + (pg * 4 + pp) * 64 + 4 * jq) = make_float4(FSIN(fr.x * acc[pp][0]), FSIN(fr.y * acc[pp][1]), FSIN(fr.z * acc[pp][2]), FSIN(fr.w * acc[pp][3]));
    }
    __syncthreads();
    {
      const int jq = tid & 15, pg = tid >> 4;
      float acc[4][4];
      {
        const float4 b2 = *(const float4*)(p.hy_f_b2 + l * 64 + 4 * jq);
#pragma unroll
        for (int pp = 0; pp < 4; pp++) { acc[pp][0] = b2.x; acc[pp][1] = b2.y; acc[pp][2] = b2.z; acc[pp][3] = b2.w; }
      }
#pragma unroll 4
      for (int k = 0; k < 64; k++) {
        const float4 w = *(const float4*)(w2s + k * 64 + 4 * jq);
#pragma unroll
        for (int pp = 0; pp < 4; pp++) { const float f = h1[(pg * 4 + pp) * 64 + k]; acc[pp][0] += f * w.x; acc[pp][1] += f * w.y; acc[pp][2] += f * w.z; acc[pp][3] += f * w.w; }
      }
      const float4 fr = *(const float4*)(p.hy_sin_freq + l * 64 + 4 * jq);
#pragma unroll
      for (int pp = 0; pp < 4; pp++) {
        float* d = h2 + (pg * 4 + pp) * 65 + 4 * jq;
        d[0] = FSIN(fr.x * acc[pp][0]); d[1] = FSIN(fr.y * acc[pp][1]); d[2] = FSIN(fr.z * acc[pp][2]); d[3] = FSIN(fr.w * acc[pp][3]);
      }
    }
    __syncthreads();
    {
      const int pp = (wid & 1) * 64 + lane, ng = wid >> 1;
      float acc[32];
#pragma unroll
      for (int j = 0; j < 32; j++) acc[j] = 0.f;
#pragma unroll 2
      for (int k = 0; k < 64; k++) {
        const float hv = h2[pp * 65 + k];
        const float4* wr = (const float4*)(w3s + k * 128 + ng * 32);
#pragma unroll
        for (int j4 = 0; j4 < 8; j4++) { const float4 w = wr[j4]; acc[j4 * 4 + 0] += hv * w.x; acc[j4 * 4 + 1] += hv * w.y; acc[j4 * 4 + 2] += hv * w.z; acc[j4 * 4 + 3] += hv * w.w; }
      }
      const int pos = pos0 + pp;
      const float tn = (float)pos / (float)Lp;
      const float lo = logf(0.01f) / 1.5f, hi = logf(0.01f) / 0.3f;
      bf16_t* ftb = p.ft + (size_t)l * FT_L_ + (path ? FT_CTX_ : 0);
#pragma unroll
      for (int j = 0; j < 32; j++) {
        const int n = nblk * 128 + ng * 32 + j;
        const int ch = n & 255, fdir = n >> 9, ford = (n >> 8) & 1;
        const float delta = fabsf(lo + (hi - lo) * (float)ch / 255.f);
        const float v = (acc[j] + p.hy_f_b3[l * 1024 + n]) * (__expf(-tn * delta) + 0.05f);
        bf16_t* ftc = ftb + (size_t)((ford * 256 + ch) * 2) * 2 * Lp;
        if (fdir == 0 || pos > 0) {
          const int uu = fdir == 0 ? Lp - pos : Lp + pos;
          const bf16_t bv = f2bf(v);
          ftc[uu] = bv; ftc[2 * Lp + uu - 1] = bv;
        }
        if (fdir == 0 && pos == 0) { ftc[0] = 0; ftc[2 * Lp + 2 * Lp - 1] = 0; }
      }
    }
  }
}

__device__ __forceinline__ void phase_rowpass(PR p, int layer, int which, int bid, int nb) {
  const int lane = TIDX & 63, wid = TIDX >> 6;
  if (which == 0 && layer == 0 && nb * 8 * 3 == T) {
    f32x4 x[3][4];
#pragma unroll
    for (int k = 0; k < 3; k++) {
      const int row = bid * 8 + wid + k * nb * 8;
      const float* xs = row < TC ? p.x_prompt + (size_t)row * D : p.x_sample + (size_t)(row - TC) * D;
#pragma unroll
      for (int i = 0; i < 4; i++) x[k][i] = __builtin_nontemporal_load((const f32x4*)(xs + lane * 4 + 256 * i));
    }
    const float* gpre = p.norm_mix_pre;
#pragma unroll
    for (int k = 0; k < 3; k++) {
      const int row = bid * 8 + wid + k * nb * 8;
      const float* sh = p.mod + (size_t)row_mod(row) * 6144; const float* sc = sh + 1024;
      float ss = 0.f;
#pragma unroll
      for (int i = 0; i < 4; i++) { *(f32x4*)(p.xbuf + (size_t)row * D + lane * 4 + 256 * i) = x[k][i]; ss += x[k][i][0] * x[k][i][0] + x[k][i][1] * x[k][i][1] + x[k][i][2] * x[k][i][2] + x[k][i][3] * x[k][i][3]; }
      ss = wave_sum(ss);
      const float rs = rsqrtf(ss * (1.f / 1024.f) + EPS);
#pragma unroll
      for (int i = 0; i < 4; i++) {
        const int e = lane * 4 + 256 * i;
        const float4 g = *(const float4*)(gpre + e), s1 = *(const float4*)(sc + e), s0 = *(const float4*)(sh + e);
        uint2 o;
        o.x = pack2(x[k][i][0] * rs * g.x * (1.f + s1.x) + s0.x, x[k][i][1] * rs * g.y * (1.f + s1.y) + s0.y);
        o.y = pack2(x[k][i][2] * rs * g.z * (1.f + s1.z) + s0.z, x[k][i][3] * rs * g.w * (1.f + s1.w) + s0.w);
        *(uint2*)(p.hbuf + (size_t)row * D + e) = o;
      }
    }
    return;
  }
  for (int row = bid * 8 + wid; row < T; row += nb * 8) {
    const int mi = row_mod(row);
    const float* xs;
    const float* gate = nullptr; const float* gpost = nullptr;
    float* xd; bf16_t* hd = nullptr; const float *gpre = nullptr, *sc = nullptr, *sh = nullptr;
    bool has_raw;
    if (which == 0) {
      if (layer == 0) { xs = row < TC ? p.x_prompt + (size_t)row * D : p.x_sample + (size_t)(row - TC) * D; has_raw = false; }
      else { xs = p.x1buf + (size_t)row * D; has_raw = true; gate = p.mod + ((size_t)(layer - 1) * 3 + mi) * 6144 + 5 * 1024; gpost = p.norm_ffn_post + (layer - 1) * D; }
      if (layer < DEPTH) { xd = p.xbuf + (size_t)row * D; hd = p.hbuf + (size_t)row * D; gpre = p.norm_mix_pre + layer * D;
        sh = p.mod + ((size_t)layer * 3 + mi) * 6144; sc = sh + 1024; }
      else xd = p.out + (size_t)row * D;
    } else {
      xs = p.xbuf + (size_t)row * D; has_raw = true; gate = p.mod + ((size_t)layer * 3 + mi) * 6144 + 2 * 1024; gpost = p.norm_mix_post + layer * D;
      xd = p.x1buf + (size_t)row * D; hd = p.hbuf + (size_t)row * D; gpre = p.norm_ffn_pre + layer * D;
      sh = p.mod + ((size_t)layer * 3 + mi) * 6144 + 3 * 1024; sc = sh + 1024;
    }
    float4 x[4];
#pragma unroll
    for (int i = 0; i < 4; i++) x[i] = *(const float4*)(xs + lane * 4 + 256 * i);
    if (has_raw) {
      float4 r[4]; float ss = 0.f;
      const float* rp = p.raw + (size_t)row * D;
#pragma unroll
      for (int i = 0; i < 4; i++) { r[i] = *(const float4*)(rp + lane * 4 + 256 * i); ss += r[i].x * r[i].x + r[i].y * r[i].y + r[i].z * r[i].z + r[i].w * r[i].w; }
      ss = wave_sum(ss);
      float rs = rsqrtf(ss * (1.f / 1024.f) + EPS);
#pragma unroll
      for (int i = 0; i < 4; i++) {
        float4 g = *(const float4*)(gate + lane * 4 + 256 * i), gp = *(const float4*)(gpost + lane * 4 + 256 * i);
        x[i].x += g.x * gp.x * r[i].x * rs; x[i].y += g.y * gp.y * r[i].y * rs; x[i].z += g.z * gp.z * r[i].z * rs; x[i].w += g.w * gp.w * r[i].w * rs;
      }
    }
#pragma unroll
    for (int i = 0; i < 4; i++) *(float4*)(xd + lane * 4 + 256 * i) = x[i];
    if (hd) {
      float ss = 0.f;
#pragma unroll
      for (int i = 0; i < 4; i++) ss += x[i].x * x[i].x + x[i].y * x[i].y + x[i].z * x[i].z + x[i].w * x[i].w;
      ss = wave_sum(ss);
      float rs = rsqrtf(ss * (1.f / 1024.f) + EPS);
#pragma unroll
      for (int i = 0; i < 4; i++) {
        int e = lane * 4 + 256 * i;
        float4 g = *(const float4*)(gpre + e), s1 = *(const float4*)(sc + e), s0 = *(const float4*)(sh + e);
        float h0 = x[i].x * rs * g.x * (1.f + s1.x) + s0.x, h1 = x[i].y * rs * g.y * (1.f + s1.y) + s0.y;
        float h2 = x[i].z * rs * g.z * (1.f + s1.z) + s0.z, h3 = x[i].w * rs * g.w * (1.f + s1.w) + s0.w;
        uint2 o; o.x = pack2(h0, h1); o.y = pack2(h2, h3);
        *(uint2*)(hd + e) = o;
      }
    }
  }
}

struct EpiProj {
  bf16_t *proj, *ktr, *vtr, *ktm, *vtm, *hyt; float* gates;
  __device__ __forceinline__ void operator()(int row, int col, f32x4 v) const {
    if (col >= INW) return;
    uint2 o; o.x = pack2(v[0], v[1]); o.y = pack2(v[2], v[3]);
    *(uint2*)(proj + (size_t)row * INW + col) = o;
    bf16_t* tp = nullptr; int tc = 0;
    if (col >= 384 && col < 768) { tp = ktr; tc = col - 384; }
    else if (col >= 768 && col < 1152) { tp = vtr; tc = col - 768; }
    else if (col >= 1536 && col < 2304) { tp = hyt; tc = col - 1536; }
    else if (col >= 2688 && col < 3072) { tp = ktm; tc = col - 2688; }
    else if (col >= 3072 && col < 3456) { tp = vtm; tc = col - 3072; }
    if (tp) {
#pragma unroll
      for (int r = 0; r < 4; r++) tp[(size_t)(tc + r) * T + row] = f2bf(v[r]);
    }
    if (col >= 3840) *(float4*)(gates + (size_t)row * 16 + (col - 3840)) = make_float4(v[0], v[1], v[2], v[3]);
  }
};
struct EpiF32 {
  float* out; int ld;
  __device__ __forceinline__ void operator()(int row, int col, f32x4 v) const {
    *(float4*)(out + (size_t)row * ld + col) = make_float4(v[0], v[1], v[2], v[3]);
  }
};
struct EpiRow {
  const float* x; float* xo; bf16_t* ho;
  const float* modl; int goff; const float* gpost;
  const float* modn; int shoff; const float* gpre;
  unsigned long long* gran; unsigned epoch; unsigned* tmo;
  __device__ __forceinline__ void operator()(int, int, f32x4) const {}
};
template <class E> struct epi_proj { static constexpr bool value = false; };
template <> struct epi_proj<EpiProj> { static constexpr bool value = true; };
template <class E> struct epi_row { static constexpr bool value = false; };
template <> struct epi_row<EpiRow> { static constexpr bool value = true; };
struct EpiUp {
  static constexpr bool kFused = true;
  bf16_t* u; const bf16_t* h; const bf16_t* wt; const float* cw; const float* cb;
  __device__ __forceinline__ void operator()(int, int, f32x4) const {}
};
template <class E> struct epi_fused { static constexpr bool value = false; };
template <> struct epi_fused<EpiUp> { static constexpr bool value = true; };

typedef unsigned u32x2 __attribute__((ext_vector_type(2)));
typedef float f32x2 __attribute__((ext_vector_type(2)));
typedef __bf16 bf16x2_t __attribute__((ext_vector_type(2)));
#ifndef WT_AUX
#define WT_AUX 16
#endif
template <int BM, int BN, int GL, class Epi>
__device__ __forceinline__ void gemm_tiles(const bf16_t* __restrict__ A, const bf16_t* __restrict__ Bt, int M, int N, int K, int bid, int nb, char* smem, const Epi& epi) {
  constexpr int MT = BM / 64, NTW = BN / 32;
  constexpr int ACH = BM * 8 / NT, BCH = BN * 8 / NT;
  constexpr int ABYTES = BM * 128, BBYTES = BN * 128, STAGE = ABYTES + BBYTES;
  const int nm = M / BM, nn = N / BN;
  const int tid = TIDX, lane = tid & 63, wid = tid >> 6;
  const int wm = wid >> 1, wn = wid & 1;
  const int lr = lane & 15, lg = lane >> 4;
  u32x4 ra[ACH], rb[BCH];
  const unsigned voff = (unsigned)(((tid >> 3) * K + (tid & 7) * 8) * 2);
  const unsigned soff = (unsigned)((tid >> 3) * 128 + (((tid & 7) ^ ((tid >> 3) & 7)) << 4));
#define GLOAD(Ab, Bb) { \
    _Pragma("unroll") for (int i = 0; i < ACH; i++) ra[i] = *(const u32x4*)((const char*)((Ab) + (size_t)i * 64 * K) + voff); \
    _Pragma("unroll") for (int i = 0; i < BCH; i++) rb[i] = *(const u32x4*)((const char*)((Bb) + (size_t)i * 64 * K) + voff); }
#define SWRITE(buf) { char* sa_ = smem + (buf) * STAGE + soff; char* sb_ = sa_ + ABYTES; \
    _Pragma("unroll") for (int i = 0; i < ACH; i++) *(u32x4*)(sa_ + i * 8192) = ra[i]; \
    _Pragma("unroll") for (int i = 0; i < BCH; i++) *(u32x4*)(sb_ + i * 8192) = rb[i]; }
  const unsigned goff = (unsigned)(((tid >> 3) * K + (((tid & 7) ^ ((tid >> 3) & 7)) * 8)) * 2);
  const int wu = __builtin_amdgcn_readfirstlane(wid);
#define GLDS(buf, Ab, Bb) { \
    _Pragma("unroll") for (int i = 0; i < ACH; i++) __builtin_amdgcn_global_load_lds((const unsigned*)((const char*)((Ab) + (size_t)i * 64 * K) + goff), (LAS unsigned*)(smem + (buf) * STAGE + i * 8192 + wu * 1024), 16, 0, 0); \
    _Pragma("unroll") for (int i = 0; i < BCH; i++) __builtin_amdgcn_global_load_lds((const unsigned*)((const char*)((Bb) + (size_t)i * 64 * K) + goff), (LAS unsigned*)(smem + (buf) * STAGE + ABYTES + i * 8192 + wu * 1024), 16, 0, 0); }
#define GWAIT() { asm volatile("s_waitcnt vmcnt(0)" ::: "memory"); __syncthreads(); }
  const unsigned offA0 = (unsigned)((wm * (BM / 4) + lr) * 128 + ((lg ^ (lr & 7)) << 4));
  const unsigned offB0 = (unsigned)(ABYTES + (wn * (BN / 2) + lr) * 128 + ((lg ^ (lr & 7)) << 4));
  const int grp = bid & 7, jg = bid >> 3, ng = (nb + 7 - grp) >> 3;
  const int mpg = nm >> 3, tpg = mpg * nn;
  if (jg >= tpg) return;
#define TILE_M0(q) ((grp * mpg + (q) % mpg) * BM)
#define TILE_N0(q) (((q) / mpg) * BN)
  {
    const bf16_t* Ab = A + (size_t)TILE_M0(jg) * K; const bf16_t* Bb = Bt + (size_t)TILE_N0(jg) * K;
    if constexpr (GL == 2) {
    } else if constexpr (GL == 1) {
      __syncthreads();
      GLDS(0, Ab, Bb);
      GWAIT();
    } else {
      GLOAD(Ab, Bb);
      __syncthreads();
      SWRITE(0);
      GLOAD(Ab + 64, Bb + 64);
      __syncthreads();
    }
  }
  const int nk = K / 64;
  for (int q = jg; q < tpg; q += ng) {
    const int m0 = TILE_M0(q), n0 = TILE_N0(q);
    const int q2 = q + ng; const bool hn = q2 < tpg;
    const bf16_t* Ab = A + (size_t)m0 * K;
    const bf16_t* Bb = Bt + (size_t)n0 * K;
    const bf16_t* Abn = hn ? A + (size_t)TILE_M0(q2) * K : Ab;
    const bf16_t* Bbn = hn ? Bt + (size_t)TILE_N0(q2) * K : Bb;
    f32x4 acc[MT][NTW];
#pragma unroll
    for (int i = 0; i < MT; i++)
#pragma unroll
      for (int j = 0; j < NTW; j++) acc[i][j] = zero4();
    auto compute = [&](int buf) {
      const char* sa = smem + buf * STAGE;
#pragma unroll
      for (int ks = 0; ks < 2; ks++) {
        bf16x8 af[MT], bfr[NTW];
#pragma unroll
        for (int mi = 0; mi < MT; mi++) af[mi] = *(const bf16x8*)(sa + (offA0 ^ (ks << 6)) + mi * 2048);
#pragma unroll
        for (int ni = 0; ni < NTW; ni++) bfr[ni] = *(const bf16x8*)(sa + (offB0 ^ (ks << 6)) + ni * 2048);
        __builtin_amdgcn_sched_barrier(0);
#pragma unroll
        for (int ni = 0; ni < NTW; ni++)
#pragma unroll
          for (int mi = 0; mi < MT; mi++) acc[mi][ni] = __builtin_amdgcn_mfma_f32_16x16x32_bf16(bfr[ni], af[mi], acc[mi][ni], 0, 0, 0);
        __builtin_amdgcn_sched_barrier(0);
      }
    };
    f32x4 xv[epi_row<Epi>::value ? MT : 1][epi_row<Epi>::value ? NTW : 1];
    float* tabG = (float*)(smem + 3 * STAGE); float* tabP = tabG + 384; float* tabS = tabP + 384;
    if constexpr (epi_row<Epi>::value) {
      static_assert(3 * STAGE + 3 * 384 * 4 <= SMEM_BYTES - 64, "row tables");
      if (tid < 384) {
        const int v = tid >> 7, col = n0 + (tid & 127);
        tabG[tid] = epi.modl[v * 6144 + epi.goff + col] * epi.gpost[col];
        if (epi.ho) { tabP[tid] = epi.gpre[col] * (1.f + epi.modn[v * 6144 + epi.shoff + 1024 + col]); tabS[tid] = epi.modn[v * 6144 + epi.shoff + col]; }
      }
    }
    auto row_preload = [&]() {
      if constexpr (epi_row<Epi>::value) {
#pragma unroll
        for (int mi = 0; mi < MT; mi++) {
          const int row = m0 + wm * 48 + mi * 16 + lr;
#pragma unroll
          for (int ni = 0; ni < NTW; ni++) {
            const int col = n0 + wn * 64 + ni * 16 + lg * 4;
            xv[mi][ni] = __builtin_nontemporal_load((const f32x4*)(epi.x + (size_t)row * D + col));
          }
        }
      }
    };
    if constexpr (GL != 2) row_preload();
    if constexpr (GL == 2) {
      static_assert(3 * STAGE <= SMEM_BYTES - 64, "ring");
      constexpr int PL = ACH + BCH;
      __syncthreads();
      GLDS(0, Ab, Bb);
      GLDS(1, Ab + 64, Bb + 64);
      asm volatile("s_waitcnt vmcnt(%0)" :: "n"(PL) : "memory");
      __builtin_amdgcn_s_barrier();
      int cur = 0, nx2 = 2;
      const int ksplit = nk > 8 ? nk - 8 : 0;
#pragma unroll 1
      for (int kt = 0; kt < ksplit; kt++) {
        GLDS(nx2, Ab + (kt + 2) * 64, Bb + (kt + 2) * 64);
        __builtin_amdgcn_sched_barrier(0);
        compute(cur);
        __builtin_amdgcn_sched_barrier(0);
        asm volatile("s_waitcnt vmcnt(%0)" :: "n"(PL) : "memory");
        asm volatile("s_waitcnt lgkmcnt(0)" ::: "memory");
        __builtin_amdgcn_s_barrier();
        cur = cur == 2 ? 0 : cur + 1; nx2 = nx2 == 2 ? 0 : nx2 + 1;
      }
      row_preload();
#pragma unroll 1
      for (int kt = ksplit; kt < nk; kt++) {
        if (kt + 2 < nk) GLDS(nx2, Ab + (kt + 2) * 64, Bb + (kt + 2) * 64);
        __builtin_amdgcn_sched_barrier(0);
        compute(cur);
        __builtin_amdgcn_sched_barrier(0);
        if (kt + 2 < nk) asm volatile("s_waitcnt vmcnt(%0)" :: "n"(PL) : "memory");
        else asm volatile("s_waitcnt vmcnt(0)" ::: "memory");
        asm volatile("s_waitcnt lgkmcnt(0)" ::: "memory");
        __builtin_amdgcn_s_barrier();
        cur = cur == 2 ? 0 : cur + 1; nx2 = nx2 == 2 ? 0 : nx2 + 1;
      }
    } else if constexpr (GL == 1) {
      for (int kt = 0; kt < nk; kt += 2) {
        GLDS(1, Ab + (kt + 1) * 64, Bb + (kt + 1) * 64);
        __builtin_amdgcn_sched_barrier(0);
        compute(0);
        __builtin_amdgcn_sched_barrier(0);
        GWAIT();
        { const bool in = kt + 2 < nk; GLDS(0, in ? Ab + (kt + 2) * 64 : Abn, in ? Bb + (kt + 2) * 64 : Bbn); }
        __builtin_amdgcn_sched_barrier(0);
        compute(1);
        __builtin_amdgcn_sched_barrier(0);
        GWAIT();
      }
    } else
    for (int kt = 0; kt < nk; kt += 2) {
      SWRITE(1);
      { const bool in = kt + 2 < nk; GLOAD(in ? Ab + (kt + 2) * 64 : Abn, in ? Bb + (kt + 2) * 64 : Bbn); }
      __builtin_amdgcn_sched_barrier(0);
      compute(0);
      __builtin_amdgcn_sched_barrier(0);
      __syncthreads();
      SWRITE(0);
      { const bool in = kt + 3 < nk; GLOAD(in ? Ab + (kt + 3) * 64 : Abn + 64, in ? Bb + (kt + 3) * 64 : Bbn + 64); }
      __builtin_amdgcn_sched_barrier(0);
      compute(1);
      __builtin_amdgcn_sched_barrier(0);
      __syncthreads();
    }
    if constexpr (epi_row<Epi>::value) {
      static_assert(BM == 192 && BN == 128, "row-fused epilogue geometry");
      float* sst = (float*)(smem + STAGE);
      float* srr = sst + 2 * 192 * 4;
      const int mt = m0 / 192, ntile = n0 >> 7;
#pragma unroll
      for (int mi = 0; mi < MT; mi++) {
        const int mrow = row_mod(m0 + wm * 48 + mi * 16 + lr);
        float sA = 0.f, sB = 0.f, sC = 0.f, sD = 0.f;
#pragma unroll
        for (int ni = 0; ni < NTW; ni++) {
          const float4 g4 = *(const float4*)(tabG + mrow * 128 + wn * 64 + ni * 16 + lg * 4);
          const float gg[4] = {g4.x, g4.y, g4.z, g4.w};
#pragma unroll
          for (int r = 0; r < 4; r++) {
            const float raw = acc[mi][ni][r], gr = gg[r] * raw, xx = xv[mi][ni][r];
            sA += raw * raw; sB += xx * gr; sC += gr * gr; sD += xx * xx;
          }
        }
        sA += __shfl_xor(sA, 16); sA += __shfl_xor(sA, 32); sB += __shfl_xor(sB, 16); sB += __shfl_xor(sB, 32);
        sC += __shfl_xor(sC, 16); sC += __shfl_xor(sC, 32); sD += __shfl_xor(sD, 16); sD += __shfl_xor(sD, 32);
        if (lg == 0) *(float4*)(sst + (wn * 192 + wm * 48 + mi * 16 + lr) * 4) = make_float4(sA, sB, sC, sD);
      }
      __syncthreads();
      if (tid < 192) {
        unsigned long long* gbase = epi.gran + (size_t)mt * 8 * 4 * 192 + tid;
        const unsigned long long tag = (unsigned long long)epi.epoch << 32;
        {
          const float4 a = *(const float4*)(sst + tid * 4), b = *(const float4*)(sst + (192 + tid) * 4);
          unsigned long long* g = gbase + (size_t)ntile * 4 * 192;
          __hip_atomic_store(g + 0 * 192, tag | __float_as_uint(a.x + b.x), __ATOMIC_RELAXED, __HIP_MEMORY_SCOPE_AGENT);
          __hip_atomic_store(g + 1 * 192, tag | __float_as_uint(a.y + b.y), __ATOMIC_RELAXED, __HIP_MEMORY_SCOPE_AGENT);
          __hip_atomic_store(g + 2 * 192, tag | __float_as_uint(a.z + b.z), __ATOMIC_RELAXED, __HIP_MEMORY_SCOPE_AGENT);
          __hip_atomic_store(g + 3 * 192, tag | __float_as_uint(a.w + b.w), __ATOMIC_RELAXED, __HIP_MEMORY_SCOPE_AGENT);
        }
        float tA = 0.f, tB = 0.f, tC = 0.f, tD = 0.f;
        for (unsigned spins = 0;;) {
          bool ok = true; float q0 = 0.f, q1 = 0.f, q2 = 0.f, q3 = 0.f;
#pragma unroll 2
          for (int t = 0; t < 8; t++) {
            const unsigned long long w0 = __hip_atomic_load(gbase + (size_t)(t * 4 + 0) * 192, __ATOMIC_RELAXED, __HIP_MEMORY_SCOPE_AGENT);
            const unsigned long long w1 = __hip_atomic_load(gbase + (size_t)(t * 4 + 1) * 192, __ATOMIC_RELAXED, __HIP_MEMORY_SCOPE_AGENT);
            const unsigned long long w2 = __hip_atomic_load(gbase + (size_t)(t * 4 + 2) * 192, __ATOMIC_RELAXED, __HIP_MEMORY_SCOPE_AGENT);
            const unsigned long long w3 = __hip_atomic_load(gbase + (size_t)(t * 4 + 3) * 192, __ATOMIC_RELAXED, __HIP_MEMORY_SCOPE_AGENT);
            ok = ok && (unsigned)(w0 >> 32) == epi.epoch && (unsigned)(w1 >> 32) == epi.epoch && (unsigned)(w2 >> 32) == epi.epoch && (unsigned)(w3 >> 32) == epi.epoch;
            q0 += __uint_as_float((unsigned)w0); q1 += __uint_as_float((unsigned)w1); q2 += __uint_as_float((unsigned)w2); q3 += __uint_as_float((unsigned)w3);
          }
          if (ok) { tA = q0; tB = q1; tC = q2; tD = q3; break; }
          if (++spins > (1u << 18)) { __hip_atomic_store(epi.tmo, 1u, __ATOMIC_RELAXED, __HIP_MEMORY_SCOPE_AGENT); break; }
          __builtin_amdgcn_s_sleep(1);
        }
        const float r1 = rsqrtf(tA * (1.f / 1024.f) + EPS);
        const float ss = tD + 2.f * r1 * tB + r1 * r1 * tC;
        srr[tid * 2] = r1; srr[tid * 2 + 1] = rsqrtf(fmaxf(ss, 0.f) * (1.f / 1024.f) + EPS);
      }
      __syncthreads();
      const auto rsXo = __builtin_amdgcn_make_buffer_rsrc((void*)epi.xo, 0, 0x7fffffff, 0x00020000);
      const auto rsHo = __builtin_amdgcn_make_buffer_rsrc((void*)epi.ho, 0, 0x7fffffff, 0x00020000);
#pragma unroll
      for (int mi = 0; mi < MT; mi++) {
        const int rl = wm * 48 + mi * 16 + lr, row = m0 + rl;
        const int mrow = row_mod(row);
        const float r1 = srr[rl * 2], r2 = srr[rl * 2 + 1];
#pragma unroll
        for (int ni = 0; ni < NTW; ni++) {
          const int cl = wn * 64 + ni * 16 + lg * 4, col = n0 + cl;
          const float4 g4 = *(const float4*)(tabG + mrow * 128 + cl);
          const float gg[4] = {g4.x, g4.y, g4.z, g4.w};
          f32x4 xo;
#pragma unroll
          for (int r = 0; r < 4; r++) xo[r] = xv[mi][ni][r] + gg[r] * acc[mi][ni][r] * r1;
          __builtin_amdgcn_raw_buffer_store_b128((u32x4){__float_as_uint(xo[0]), __float_as_uint(xo[1]), __float_as_uint(xo[2]), __float_as_uint(xo[3])}, rsXo, (unsigned)((row * D + col) * 4), 0, WT_AUX);
          if (epi.ho) {
            const float4 pp = *(const float4*)(tabP + mrow * 128 + cl), s0 = *(const float4*)(tabS + mrow * 128 + cl);
            uint2 o;
            o.x = pack2(xo[0] * r2 * pp.x + s0.x, xo[1] * r2 * pp.y + s0.y);
            o.y = pack2(xo[2] * r2 * pp.z + s0.z, xo[3] * r2 * pp.w + s0.w);
            __builtin_amdgcn_raw_buffer_store_b64((u32x2){o.x, o.y}, rsHo, (unsigned)((row * D + col) * 2), 0, WT_AUX);
          }
        }
      }
    } else
    if constexpr (epi_fused<Epi>::value) {
     constexpr int UP_LA = STAGE, UP_LB = UP_LA + 258 * 144;
     static_assert(UP_LB + 256 * 144 <= SMEM_BYTES - 32, "fused epilogue images");
#pragma unroll
     for (int ph = 0; ph < NTW / 4; ph++) {
      {
        char* base = smem + (wn == 0 ? UP_LA + 144 : UP_LB);
#pragma unroll
        for (int mi = 0; mi < MT; mi++)
#pragma unroll
          for (int ni = 0; ni < 4; ni++) {
            const int r = wm * (BM / 4) + mi * 16 + lr, cidx = ni * 16 + lg * 4;
            uint2 o; o.x = pack2(acc[mi][ph * 4 + ni][0], acc[mi][ph * 4 + ni][1]); o.y = pack2(acc[mi][ph * 4 + ni][2], acc[mi][ph * 4 + ni][3]);
            *(uint2*)(base + r * 144 + cidx * 2) = o;
          }
      }
      {
        const int pos0 = m0 >= TC ? ((m0 - TC) & 1023) : 0;
        const bool top = m0 >= TC && pos0 != 0, bot = m0 >= TC && pos0 + BM != 1024;
        if (top || bot) {
          unsigned z0_ = 0u; asm volatile("" : "+v"(z0_)); uint4 ht0 = make_uint4(z0_, z0_, z0_, z0_), ht1 = ht0, hb0 = ht0, hb1 = ht0;
          if (top) { const bf16_t* hr = epi.h + (size_t)(m0 - 1) * K + lane * 8; ht0 = *(const uint4*)hr; ht1 = *(const uint4*)(hr + 512); }
          if (bot) { const bf16_t* hr = epi.h + (size_t)(m0 + BM) * K + lane * 8; hb0 = *(const uint4*)hr; hb1 = *(const uint4*)(hr + 512); }
#define DOT8(a, b) (bflo(a.x) * bflo(b.x) + bfhi(a.x) * bfhi(b.x) + bflo(a.y) * bflo(b.y) + bfhi(a.y) * bfhi(b.y) + bflo(a.z) * bflo(b.z) + bfhi(a.z) * bfhi(b.z) + bflo(a.w) * bflo(b.w) + bfhi(a.w) * bfhi(b.w))
#pragma unroll 1
          for (int fb = 0; fb < 2; fb++) {
            uint4 w0[4], w1[4];
#pragma unroll
            for (int fi = 0; fi < 4; fi++) { const bf16_t* wr = epi.wt + (size_t)(n0 + ph * 64 + wid * 8 + fb * 4 + fi) * K + lane * 8; w0[fi] = *(const uint4*)wr; w1[fi] = *(const uint4*)(wr + 512); }
#pragma unroll
            for (int fi = 0; fi < 4; fi++) {
              float st = DOT8(ht0, w0[fi]) + DOT8(ht1, w1[fi]), sb = DOT8(hb0, w0[fi]) + DOT8(hb1, w1[fi]);
              st = wave_sum(st); sb = wave_sum(sb);
              const int f = wid * 8 + fb * 4 + fi;
              if (lane == 0) { *(bf16_t*)(smem + UP_LA + f * 2) = f2bf(st); *(bf16_t*)(smem + UP_LA + 257 * 144 + f * 2) = f2bf(sb); }
            }
          }
#undef DOT8
        } else if (tid < 128) {
          *(bf16_t*)(smem + UP_LA + (tid >> 6) * 257 * 144 + (tid & 63) * 2) = 0;
        }
      }
      __syncthreads();
      {
        const int fc = tid & 7, f0 = (n0 >> 1) + ph * 64 + fc * 8;
        float w0[8], w1[8], w2[8], bb[8];
        {
          const float* cw = epi.cw + f0;
          const float4 a0 = *(const float4*)cw, a1 = *(const float4*)(cw + 4), b0 = *(const float4*)(cw + DFF), b1 = *(const float4*)(cw + DFF + 4);
          const float4 c0 = *(const float4*)(cw + 2 * DFF), c1 = *(const float4*)(cw + 2 * DFF + 4), d0 = *(const float4*)(epi.cb + f0), d1 = *(const float4*)(epi.cb + f0 + 4);
          w0[0] = a0.x; w0[1] = a0.y; w0[2] = a0.z; w0[3] = a0.w; w0[4] = a1.x; w0[5] = a1.y; w0[6] = a1.z; w0[7] = a1.w;
          w1[0] = b0.x; w1[1] = b0.y; w1[2] = b0.z; w1[3] = b0.w; w1[4] = b1.x; w1[5] = b1.y; w1[6] = b1.z; w1[7] = b1.w;
          w2[0] = c0.x; w2[1] = c0.y; w2[2] = c0.z; w2[3] = c0.w; w2[4] = c1.x; w2[5] = c1.y; w2[6] = c1.z; w2[7] = c1.w;
          bb[0] = d0.x; bb[1] = d0.y; bb[2] = d0.z; bb[3] = d0.w; bb[4] = d1.x; bb[5] = d1.y; bb[6] = d1.z; bb[7] = d1.w;
        }
#pragma unroll
        for (int j = 0; j < BM / 64; j++) {
          const int r = (tid >> 3) + 64 * j;
          const char* ap = smem + UP_LA + r * 144 + fc * 16;
          const uint4 x0 = *(const uint4*)ap, x1 = *(const uint4*)(ap + 144), x2 = *(const uint4*)(ap + 288);
          const uint4 bv = *(const uint4*)(smem + UP_LB + r * 144 + fc * 16);
          const unsigned xa[4] = {x0.x, x0.y, x0.z, x0.w}, xb[4] = {x1.x, x1.y, x1.z, x1.w}, xc[4] = {x2.x, x2.y, x2.z, x2.w}, bw[4] = {bv.x, bv.y, bv.z, bv.w};
          float o[8];
#pragma unroll
          for (int q = 0; q < 8; q++) {
            const float a0 = (q & 1) ? bfhi(xa[q >> 1]) : bflo(xa[q >> 1]), a1 = (q & 1) ? bfhi(xb[q >> 1]) : bflo(xb[q >> 1]), a2 = (q & 1) ? bfhi(xc[q >> 1]) : bflo(xc[q >> 1]);
            const float bq = (q & 1) ? bfhi(bw[q >> 1]) : bflo(bw[q >> 1]);
            const float a = a0 * w0[q] + a1 * w1[q] + a2 * w2[q] + bb[q];
            const float t2 = 1.5957691216057308f * (a + 0.044715f * a * a * a);
            o[q] = a * __builtin_amdgcn_rcpf(1.f + __expf(-t2)) * bq;
          }
          uint4 ov; ov.x = pack2(o[0], o[1]); ov.y = pack2(o[2], o[3]); ov.z = pack2(o[4], o[5]); ov.w = pack2(o[6], o[7]);
          *(uint4*)(epi.u + (size_t)(m0 + r) * DFF + f0) = ov;
        }
      }
      __syncthreads();
     }
    } else if constexpr (epi_proj<Epi>::value) {
      const auto rsP = __builtin_amdgcn_make_buffer_rsrc((void*)epi.proj, 0, 0x7fffffff, 0x00020000);
      const auto rsT = __builtin_amdgcn_make_buffer_rsrc((void*)epi.ktr, 0, 0x7fffffff, 0x00020000);
      const auto rsG = __builtin_amdgcn_make_buffer_rsrc((void*)epi.gates, 0, 0x7fffffff, 0x00020000);
      const int wns = wu & 1;
      const bool even = (lane & 1) == 0;
      unsigned voffP[MT], voffT[MT], voffG[MT];
#pragma unroll
      for (int mi = 0; mi < MT; mi++) {
        const int row = m0 + wm * (BM / 4) + mi * 16 + lr;
        voffP[mi] = (unsigned)((row * INW + lg * 4) * 2); voffT[mi] = (unsigned)(((lg * 4 + (lane & 1) * 2) * T + (row & ~1)) * 2); voffG[mi] = (unsigned)((row * 16 + lg * 4) * 4);
      }
#pragma unroll
      for (int ni = 0; ni < NTW; ni++) {
        const int col0 = n0 + wns * (BN / 2) + ni * 16;
        const bool tonly = (col0 >= 768 && col0 < 1152) || (col0 >= 1536 && col0 < 2304) || (col0 >= 3072 && col0 < 3456);
        long tel = -1;
        if (col0 >= 384 && col0 < 768) tel = (long)(col0 - 384) * T;
        else if (col0 >= 768 && col0 < 1152) tel = (epi.vtr - epi.ktr) + (long)(col0 - 768) * T;
        else if (col0 >= 1536 && col0 < 2304) tel = (epi.hyt - epi.ktr) + (long)(col0 - 1536) * T;
        else if (col0 >= 2688 && col0 < 3072) tel = (epi.ktm - epi.ktr) + (long)(col0 - 2688) * T;
        else if (col0 >= 3072 && col0 < 3456) tel = (epi.vtm - epi.ktr) + (long)(col0 - 3072) * T;
        const unsigned tso = (unsigned)(tel * 2);
#pragma unroll
        for (int mi = 0; mi < MT; mi++) {
          const f32x4 v = acc[mi][ni];
          const unsigned w01 = pack2(v[0], v[1]), w23 = pack2(v[2], v[3]);
          if (col0 < 3840 && !tonly) __builtin_amdgcn_raw_buffer_store_b64((u32x2){w01, w23}, rsP, voffP[mi], (unsigned)(col0 * 2), 0);
          if (col0 == 3840) __builtin_amdgcn_raw_buffer_store_b128((u32x4){__float_as_uint(v[0]), __float_as_uint(v[1]), __float_as_uint(v[2]), __float_as_uint(v[3])}, rsG, voffG[mi], 0, 0);
          if (tel >= 0) {
            float nb[4];
#pragma unroll
            for (int r = 0; r < 4; r++) nb[r] = __int_as_float(__builtin_amdgcn_update_dpp(0, __float_as_int(v[r]), 0xB1, 0xF, 0xF, false));
            const unsigned p0 = pack2(even ? v[0] : nb[2], even ? nb[0] : v[2]), p1 = pack2(even ? v[1] : nb[3], even ? nb[1] : v[3]);
            __builtin_amdgcn_raw_buffer_store_b32(p0, rsT, voffT[mi], tso, 0);
            __builtin_amdgcn_raw_buffer_store_b32(p1, rsT, voffT[mi], tso + (unsigned)(T * 2), 0);
          }
        }
      }
    } else {
#pragma unroll
      for (int mi = 0; mi < MT; mi++)
#pragma unroll
        for (int ni = 0; ni < NTW; ni++) epi(m0 + wm * (BM / 4) + mi * 16 + lr, n0 + wn * (BN / 2) + ni * 16 + lg * 4, acc[mi][ni]);
    }
  }
#undef GLOAD
#undef SWRITE
#undef GLDS
#undef GWAIT
#undef TILE_M0
#undef TILE_N0
}


namespace up8 {
constexpr int BM = 256, BK = 64, HALF = 128, HT = HALF * BK, SHM_B = 8 * HT * 2;
__device__ __forceinline__ int lds_byte(int r, int c) { int st = (r >> 4) * 2 + (c >> 5), rr = r & 15, cc = c & 31, ob = rr * 64 + cc * 2; return st * 1024 + (ob ^ (((ob >> 9) & 1) << 5)); }
__device__ __forceinline__ void stage_rc(int b, int& R, int& C) { int st = b / 1024, sb = b % 1024, swz = sb ^ (((sb >> 9) & 1) << 5); R = (st >> 1) * 16 + swz / 64; C = (st & 1) * 32 + (swz % 64) / 2; }
}
__device__ __forceinline__ void gemm_up8(const bf16_t* __restrict__ A, const bf16_t* __restrict__ Bt, int bid, int nb, char* smem, const EpiUp& epi) {
  using namespace up8;
  constexpr int K = D;
  static_assert(SHM_B <= SMEM_BYTES - 64, "LDS");
  const int tid = TIDX, wid = tid >> 6, lane = tid & 63, wr = wid >> 2, wc = wid & 3, fr = lane & 15, fq = lane >> 4;
  const int wu = __builtin_amdgcn_readfirstlane(wid);
  bf16_t* shm = (bf16_t*)smem;
#define SA(b, h) (shm + ((b) * 2 + (h)) * HT)
#define SB(b, h) (shm + (4 + (b) * 2 + (h)) * HT)
  int sR0, sC0, sR1, sC1; stage_rc(tid * 16, sR0, sC0); stage_rc(tid * 16 + 8192, sR1, sC1);
  const unsigned so0 = (unsigned)((sR0 * K + sC0) * 2), so1 = (unsigned)((sR1 * K + sC1) * 2);
  const auto rsA = __builtin_amdgcn_make_buffer_rsrc((void*)A, 0, 0x7fffffff, 0x00020000);
  const auto rsB = __builtin_amdgcn_make_buffer_rsrc((void*)Bt, 0, 0x7fffffff, 0x00020000);
  const auto rsU = __builtin_amdgcn_make_buffer_rsrc((void*)epi.u, 0, 0x7fffffff, 0x00020000);
#define rs_A rsA
#define rs_Bt rsB
#define STAGE(P, BASE, br, kt) do { const int so_ = ((br) * K + (kt) * BK) * 2; \
    __builtin_amdgcn_raw_ptr_buffer_load_lds(rs_##BASE, (LAS void*)((char*)(P) + wu * 1024), 16, so0, so_, 0, 0); \
    __builtin_amdgcn_raw_ptr_buffer_load_lds(rs_##BASE, (LAS void*)((char*)(P) + 8192 + wu * 1024), 16, so1, so_, 0, 0); } while (0)
#define LDA(dst, b, h) _Pragma("unroll") for (int m = 0; m < 4; ++m) _Pragma("unroll") for (int k = 0; k < 2; ++k) \
    dst[m][k] = *reinterpret_cast<const bf16x8*>((const char*)SA(b, h) + lds_byte(wr * 64 + m * 16 + fr, k * 32 + fq * 8))
#define LDB(dst, b, h) _Pragma("unroll") for (int n = 0; n < 2; ++n) _Pragma("unroll") for (int k = 0; k < 2; ++k) \
    dst[n][k] = *reinterpret_cast<const bf16x8*>((const char*)SB(b, h) + lds_byte(wc * 32 + n * 16 + fr, k * 32 + fq * 8))
#define MMA(ai, bj, At_, Bt_) do { __builtin_amdgcn_s_setprio(1); \
    _Pragma("unroll") for (int m = 0; m < 4; ++m) _Pragma("unroll") for (int n = 0; n < 2; ++n) _Pragma("unroll") for (int k = 0; k < 2; ++k) \
      acc[ai][bj][m][n] = __builtin_amdgcn_mfma_f32_16x16x32_bf16(Bt_[n][k], At_[m][k], acc[ai][bj][m][n], 0, 0, 0); \
    __builtin_amdgcn_s_setprio(0); } while (0)
#define WAIT_V(n) asm volatile("s_waitcnt vmcnt(" #n ")" ::: "memory")
#define WAIT_L(n) asm volatile("s_waitcnt lgkmcnt(" #n ")" ::: "memory")
#define BARX __builtin_amdgcn_s_barrier()
#define SCHED __builtin_amdgcn_sched_barrier(0)
  const int grp = bid & 7, jg = bid >> 3, ng = (nb + 7 - grp) >> 3;
  constexpr int mpg = 6, nn = 16, tpg = mpg * nn, nt = K / BK;
  for (int q = jg; q < tpg; q += ng) {
    const int mi_ = q % mpg, mt_ = mi_ < 4 ? (grp & 3) * 4 + mi_ : 16 + (grp & 3) * 2 + (mi_ - 4);
    const int m0 = mt_ * 256, n0 = ((grp >> 2) * nn + q / mpg) * 256;
    const int brow = m0, bcol = n0;
    f32x4 acc[2][2][4][2];
    { float zero_ = 0.f; asm volatile("" : "+v"(zero_));
#pragma unroll
      for (int a_ = 0; a_ < 2; a_++)
#pragma unroll
        for (int b_ = 0; b_ < 2; b_++)
#pragma unroll
          for (int m = 0; m < 4; m++)
#pragma unroll
            for (int n = 0; n < 2; n++) acc[a_][b_][m][n] = (f32x4){zero_, zero_, zero_, zero_}; }
    bf16x8 At[4][2], B0[2][2], B1[2][2];
    __syncthreads();
    STAGE(SB(0, 0), Bt, bcol, 0); STAGE(SA(0, 0), A, brow, 0);
    STAGE(SB(0, 1), Bt, bcol + HALF, 0); STAGE(SA(0, 1), A, brow + HALF, 0);
    if (wr == 1) BARX;
    WAIT_V(4); BARX;
    STAGE(SB(1, 0), Bt, bcol, 1); STAGE(SA(1, 0), A, brow, 1); STAGE(SB(1, 1), Bt, bcol + HALF, 1);
    WAIT_V(6); BARX;
#pragma unroll 1
    for (int t = 0; t < nt - 2; t += 2) {
      LDB(B0, 0, 0); SCHED; LDA(At, 0, 0); STAGE(SA(1, 1), A, brow + HALF, t + 1);
      WAIT_L(8); BARX; WAIT_L(0); MMA(0, 0, At, B0); BARX; SCHED;
      LDB(B1, 0, 1); STAGE(SB(0, 0), Bt, bcol, t + 2);
      BARX; WAIT_L(0); MMA(0, 1, At, B1); BARX;
      LDA(At, 0, 1); STAGE(SA(0, 0), A, brow, t + 2);
      BARX; WAIT_L(0); MMA(1, 0, At, B0); BARX; SCHED;
      STAGE(SB(0, 1), Bt, bcol + HALF, t + 2);
      WAIT_V(6); BARX; MMA(1, 1, At, B1); BARX;
      LDB(B0, 1, 0); SCHED; LDA(At, 1, 0); STAGE(SA(0, 1), A, brow + HALF, t + 2);
      WAIT_L(8); BARX; WAIT_L(0); MMA(0, 0, At, B0); BARX; SCHED;
      LDB(B1, 1, 1); STAGE(SB(1, 0), Bt, bcol, t + 3);
      BARX; WAIT_L(0); MMA(0, 1, At, B1); BARX;
      LDA(At, 1, 1); STAGE(SA(1, 0), A, brow, t + 3);
      BARX; WAIT_L(0); MMA(1, 0, At, B0); BARX; SCHED;
      STAGE(SB(1, 1), Bt, bcol + HALF, t + 3);
      WAIT_V(6); BARX; MMA(1, 1, At, B1); BARX;
    }
    { LDB(B0, 0, 0); LDA(At, 0, 0); STAGE(SA(1, 1), A, brow + HALF, nt - 1);
      BARX; WAIT_L(0); MMA(0, 0, At, B0); BARX;
      LDB(B1, 0, 1); BARX; WAIT_L(0); MMA(0, 1, At, B1); BARX;
      LDA(At, 0, 1); WAIT_V(4); BARX; WAIT_L(0); MMA(1, 0, At, B0); MMA(1, 1, At, B1); BARX; }
    { LDB(B0, 1, 0); LDA(At, 1, 0); WAIT_V(2); BARX; WAIT_L(0); MMA(0, 0, At, B0); BARX;
      LDB(B1, 1, 1); WAIT_V(0); BARX; WAIT_L(0); MMA(0, 1, At, B1); BARX;
      LDA(At, 1, 1); BARX; WAIT_L(0); MMA(1, 0, At, B0); MMA(1, 1, At, B1); BARX; }
    if (wr == 0) BARX;
    constexpr int RS = 272, UP_LA = 0, UP_LB = UP_LA + 258 * RS;
    static_assert(UP_LB + 256 * RS <= SMEM_BYTES - 64, "fused epilogue images");
    __syncthreads();
    int tid_e = tid; asm volatile("" : "+v"(tid_e));
    const int lane_e = tid_e & 63, wid_e = tid_e >> 6, wr_e = wid_e >> 2, wc_e = wid_e & 3, fr_e = lane_e & 15, fq_e = lane_e >> 4;
#pragma unroll
    for (int ai = 0; ai < 2; ai++)
#pragma unroll
      for (int m = 0; m < 4; m++)
#pragma unroll
        for (int n = 0; n < 2; n++) {
          const int r = ai * 128 + wr_e * 64 + m * 16 + fr_e, cidx = wc_e * 32 + n * 16 + fq_e * 4;
          uint2 oa, ob;
          oa.x = pack2(acc[ai][0][m][n][0], acc[ai][0][m][n][1]); oa.y = pack2(acc[ai][0][m][n][2], acc[ai][0][m][n][3]);
          ob.x = pack2(acc[ai][1][m][n][0], acc[ai][1][m][n][1]); ob.y = pack2(acc[ai][1][m][n][2], acc[ai][1][m][n][3]);
          *(uint2*)(smem + UP_LA + RS + r * RS + cidx * 2) = oa;
          *(uint2*)(smem + UP_LB + r * RS + cidx * 2) = ob;
        }
    {
      const int pos0 = m0 >= TC ? ((m0 - TC) & 1023) : 0;
      const bool top = m0 >= TC && pos0 != 0, bot = m0 >= TC && pos0 + 256 != 1024;
      if (top || bot) {
        unsigned z0_ = 0u; asm volatile("" : "+v"(z0_)); uint4 ht0 = make_uint4(z0_, z0_, z0_, z0_), ht1 = ht0, hb0 = ht0, hb1 = ht0;
        if (top) { const bf16_t* hr = epi.h + (size_t)(m0 - 1) * K + lane_e * 8; ht0 = *(const uint4*)hr; ht1 = *(const uint4*)(hr + 512); }
        if (bot) { const bf16_t* hr = epi.h + (size_t)(m0 + 256) * K + lane_e * 8; hb0 = *(const uint4*)hr; hb1 = *(const uint4*)(hr + 512); }
#define DOT2_(a, b, c) __builtin_amdgcn_fdot2_f32_bf16(__builtin_bit_cast(bf16x2_t, (a)), __builtin_bit_cast(bf16x2_t, (b)), (c), false)
#define DOT8A(acc, a, b) acc = DOT2_(a.x, b.x, DOT2_(a.y, b.y, DOT2_(a.z, b.z, DOT2_(a.w, b.w, acc))))
#define DOT8(a, b) (bflo(a.x) * bflo(b.x) + bfhi(a.x) * bfhi(b.x) + bflo(a.y) * bflo(b.y) + bfhi(a.y) * bfhi(b.y) + bflo(a.z) * bflo(b.z) + bfhi(a.z) * bfhi(b.z) + bflo(a.w) * bflo(b.w) + bfhi(a.w) * bfhi(b.w))
#pragma unroll 1
        for (int fb = 0; fb < 4; fb++) {
          uint4 w0[4], w1[4];
#pragma unroll
          for (int fi = 0; fi < 4; fi++) { const bf16_t* wrow = epi.wt + (size_t)(n0 + wid_e * 16 + fb * 4 + fi) * K + lane_e * 8; w0[fi] = *(const uint4*)wrow; w1[fi] = *(const uint4*)(wrow + 512); }
#pragma unroll
          for (int fi = 0; fi < 4; fi++) {
            float st = 0.f, sb = 0.f;
            DOT8A(st, ht0, w0[fi]); DOT8A(st, ht1, w1[fi]); DOT8A(sb, hb0, w0[fi]); DOT8A(sb, hb1, w1[fi]);
            st = wave_sum(st); sb = wave_sum(sb);
            const int f = wid_e * 16 + fb * 4 + fi;
            if (lane_e == 0) { *(bf16_t*)(smem + UP_LA + f * 2) = f2bf(st); *(bf16_t*)(smem + UP_LA + 257 * RS + f * 2) = f2bf(sb); }
          }
        }
#undef DOT8
#undef DOT8A
#undef DOT2_
      } else if (tid_e < 256) {
        *(bf16_t*)(smem + UP_LA + (tid_e >> 7) * 257 * RS + (tid_e & 127) * 2) = 0;
      }
    }
    __syncthreads();
    {
      const int fc = tid_e & 15, f0 = (n0 >> 1) + fc * 8;
      f32x2 w0[4], w1[4], w2[4], bb[4];
      {
        const float* cw = epi.cw + f0;
        const float4 a0 = *(const float4*)cw, a1 = *(const float4*)(cw + 4), b0 = *(const float4*)(cw + DFF), b1 = *(const float4*)(cw + DFF + 4);
        const float4 c0 = *(const float4*)(cw + 2 * DFF), c1 = *(const float4*)(cw + 2 * DFF + 4), d0 = *(const float4*)(epi.cb + f0), d1 = *(const float4*)(epi.cb + f0 + 4);
        w0[0] = (f32x2){a0.x, a0.y}; w0[1] = (f32x2){a0.z, a0.w}; w0[2] = (f32x2){a1.x, a1.y}; w0[3] = (f32x2){a1.z, a1.w};
        w1[0] = (f32x2){b0.x, b0.y}; w1[1] = (f32x2){b0.z, b0.w}; w1[2] = (f32x2){b1.x, b1.y}; w1[3] = (f32x2){b1.z, b1.w};
        w2[0] = (f32x2){c0.x, c0.y}; w2[1] = (f32x2){c0.z, c0.w}; w2[2] = (f32x2){c1.x, c1.y}; w2[3] = (f32x2){c1.z, c1.w};
        bb[0] = (f32x2){d0.x, d0.y}; bb[1] = (f32x2){d0.z, d0.w}; bb[2] = (f32x2){d1.x, d1.y}; bb[3] = (f32x2){d1.z, d1.w};
      }
      constexpr float GC0 = -1.5957691216057308f * 1.4426950408889634f, GC1 = GC0 * 0.044715f;
#pragma unroll 2
      for (int j = 0; j < 8; j++) {
        const int r = (tid_e >> 4) + 32 * j;
        const char* ap = smem + UP_LA + r * RS + fc * 16;
        const uint4 x0 = *(const uint4*)ap, x1 = *(const uint4*)(ap + RS), x2 = *(const uint4*)(ap + 2 * RS);
        const uint4 bv = *(const uint4*)(smem + UP_LB + r * RS + fc * 16);
        const unsigned xa[4] = {x0.x, x0.y, x0.z, x0.w}, xb[4] = {x1.x, x1.y, x1.z, x1.w}, xc[4] = {x2.x, x2.y, x2.z, x2.w}, bw[4] = {bv.x, bv.y, bv.z, bv.w};
        unsigned ow[4];
#pragma unroll
        for (int q = 0; q < 4; q++) {
          const f32x2 a0 = {bflo(xa[q]), bfhi(xa[q])}, a1 = {bflo(xb[q]), bfhi(xb[q])}, a2 = {bflo(xc[q]), bfhi(xc[q])}, bq = {bflo(bw[q]), bfhi(bw[q])};
          const f32x2 a = a0 * w0[q] + (a1 * w1[q] + (a2 * w2[q] + bb[q]));
          const f32x2 v = a * (a * a * GC1 + GC0);
          const f32x2 d = (f32x2){__builtin_amdgcn_exp2f(v[0]), __builtin_amdgcn_exp2f(v[1])} + 1.f;
          const f32x2 o = a * (f32x2){__builtin_amdgcn_rcpf(d[0]), __builtin_amdgcn_rcpf(d[1])} * bq;
          ow[q] = pack2(o[0], o[1]);
        }
        uint4 ov; ov.x = ow[0]; ov.y = ow[1]; ov.z = ow[2]; ov.w = ow[3];
        __builtin_amdgcn_raw_buffer_store_b128((u32x4){ov.x, ov.y, ov.z, ov.w}, rsU, (unsigned)(((m0 + r) * DFF + f0) * 2), 0, WT_AUX);
      }
    }
  }
#undef SA
#undef SB
#undef STAGE
#undef rs_A
#undef rs_Bt
#undef LDA
#undef LDB
#undef MMA
#undef WAIT_V
#undef WAIT_L
#undef BARX
#undef SCHED
}

template <int BM, int BN, int GL, class Epi>
__device__ __forceinline__ void phase_gemm(const bf16_t* A, const bf16_t* Bt, int M, int N, int K, int bid, int nb, char* smem, const Epi& epi) {
  gemm_tiles<BM, BN, GL, Epi>(A, Bt, M, N, K, bid, nb, smem, epi);
}

constexpr int LQ = 0, LK = 26624;
constexpr int LRED = 0;
constexpr int LKT = 36864;
constexpr int LVT = 61440;
constexpr int LST = 86016;
constexpr int LGT = 125952;
constexpr int MIX_LDS_END = LGT + (2048 + 256 + 256 + 16 + 192) * 4;
constexpr float KSCALE = 0.10206207261596577f;
constexpr float LOG2E = 1.4426950408889634f;


template <bool ML>
__device__ __forceinline__ void mix_unit(PR p, int layer, int s, int c, int h, char* smem) {
  const int tid = TIDX, lane = tid & 63, wid = tid >> 6, lr = lane & 15, lg = lane >> 4;
  const int L = seq_len(s), row0 = seq_row0(s), nc = L >> 7;
  const bool latent = s >= 16; const int lb = s - 16;
  const int P0 = c * 128;
  const int QOFF = ML ? 2304 : 0, KOFF = ML ? 2688 : 384, GOFF = ML ? 3456 : 1152, MOFF = ML ? 640 : 0;
  const bf16_t* ktg = (ML ? p.ktm : p.ktr) + (size_t)h * 96 * T + row0;
  const bf16_t* vtg = (ML ? p.vtm : p.vtr) + (size_t)h * 96 * T + row0;
  const bool rope = (!ML) && latent;
  float* red = (float*)(smem + LRED);
  float* Eg = (float*)(smem + LGT); float* Xo = Eg + 2048; float* Bo = Xo + 256; float* sc = Bo + 256; float* nin = sc + 16;
  float lgd0 = 0.f, lgd1 = 0.f;
  if (!ML) {
    lgd0 = log_sigmoidf_(p.ret_decay_logit[layer * 8 + h]) * LOG2E;
    lgd1 = log_sigmoidf_(p.ret_decay_logit[layer * 8 + 4 + h]) * LOG2E;
  }
  __syncthreads();
  if (ML) {
    for (int t = tid; t < L; t += NT) {
      const float4* g4 = (const float4*)(p.gates + (size_t)(row0 + t) * 16);
      const float4 gA = g4[0], gB = g4[1], gC = g4[2], gD = g4[3];
      const float ga[4] = {gA.x, gA.y, gA.z, gA.w}, gb[4] = {gB.x, gB.y, gB.z, gB.w}, gc[4] = {gC.x, gC.y, gC.z, gC.w}, gd[4] = {gD.x, gD.y, gD.z, gD.w};
      float gi0 = 0.f, gf0 = 0.f, gi1 = 0.f, gf1 = 0.f;
#pragma unroll
      for (int q = 0; q < 4; q++) if (q == h) { gi0 = ga[q]; gf0 = gb[q]; gi1 = gc[q]; gf1 = gd[q]; }
      const float* gbias = p.ml_gate_bias + layer * 16;
      Eg[t] = gi0 + gbias[h]; Eg[1024 + t] = gi1 + gbias[8 + h];
      red[t] = log_sigmoidf_(gf0 + gbias[4 + h]); red[1024 + t] = log_sigmoidf_(gf1 + gbias[12 + h]);
    }
    __syncthreads();
    if (wid < 2) {
      const int dir = wid; const int per = L >> 6;
      const float m0 = latent ? p.state_m[((lb * DEPTH + layer) * 2 + dir) * 4 + h] : 0.f;
      float ev[16], bv[16];
      float run = 0.f;
#pragma unroll
      for (int k = 0; k < 16; k++) {
        ev[k] = 0.f; bv[k] = 0.f;
        if (k < per) {
          int u = lane * per + k; int t = dir ? L - 1 - u : u;
          ev[k] = Eg[dir * 1024 + t];
          run += red[dir * 1024 + t];
          bv[k] = run;
        }
      }
      float incl = run;
#pragma unroll
      for (int o = 1; o < 64; o <<= 1) { float v = __shfl_up(incl, o); if (lane >= o) incl += v; }
      const float excl = incl - run;
      float xm = -3.0e38f;
#pragma unroll
      for (int k = 0; k < 16; k++) if (k < per) { bv[k] += excl; ev[k] -= bv[k]; xm = fmaxf(xm, ev[k]); }
      float inclm = xm;
#pragma unroll
      for (int o = 1; o < 64; o <<= 1) { float v = __shfl_up(inclm, o); if (lane >= o) inclm = fmaxf(inclm, v); }
      float xrun = __shfl_up(inclm, 1); if (lane == 0) xrun = -3.0e38f;
      xrun = fmaxf(xrun, m0);
      const int nprior = dir ? L - P0 - 128 : P0;
      if (lane == 0) { sc[6 + dir] = m0; if (nprior == 0) sc[0 + dir] = m0; }
#pragma unroll
      for (int k = 0; k < 16; k++) if (k < per) {
        int u = lane * per + k; int t = dir ? L - 1 - u : u;
        xrun = fmaxf(xrun, ev[k]);
        Eg[dir * 1024 + t] = ev[k];
        if (t >= P0 && t < P0 + 128) { Xo[dir * 128 + t - P0] = xrun; Bo[dir * 128 + t - P0] = bv[k]; }
        if (u == nprior - 1) sc[0 + dir] = xrun;
        if (u == L - 1) { sc[2 + dir] = xrun; sc[4 + dir] = bv[k]; }
      }
    }
    __syncthreads();
  }
  const int wq = wid & 3, kgrp = wid >> 2;
  const int dt0 = 3 * (wq >> 1), et0 = 3 * (wq & 1);
#pragma unroll 1
  for (int dirr = 0; dirr < 2 * REP_STATE; dirr++) {
    const int dir = dirr & 1;
    const int nprior_ch = dir ? nc - 1 - c : c;
    const bool need_final = (!latent) && (dir ? (c == 0) : (c == nc - 1));
    const float lgdir = dir ? lgd1 : lgd0;
    f32x4 acc[3][3];
    const float Xin = ML ? sc[0 + dir] : 0.f;
    {
      float f0 = 0.f;
      if (latent && kgrp == 0) f0 = ML ? __expf(sc[6 + dir] - Xin) : 1.f;
      const float* S0 = (ML ? p.state_c : p.state_ret) + ((size_t)((lb * DEPTH + layer) * 2 + dir) * 4 + h) * 9216;
#pragma unroll
      for (int a = 0; a < 3; a++)
#pragma unroll
        for (int b = 0; b < 3; b++)
#pragma unroll
          for (int r = 0; r < 4; r++) {
            float v = 0.f;
            if (latent && kgrp == 0) v = S0[((dt0 + a) * 16 + 4 * lg + r) * 96 + (et0 + b) * 16 + lr] * f0;
            acc[a][b][r] = v;
          }
    }
    float nacc[2][2] = {{0.f, 0.f}, {0.f, 0.f}};
    const int nsteps = nprior_ch + (need_final ? 1 : 0);
    float wret[2][8];
#pragma unroll
    for (int it = 0; it < 2; it++)
#pragma unroll
      for (int q = 0; q < 8; q++) { const int tl = ((tid + it * 512) & 15) * 8 + q; wret[it][q] = ML ? 0.f : __builtin_amdgcn_exp2f((float)(dir ? tl : 127 - tl) * lgdir) * KSCALE; }
    u32x4 pk1[2], pk2[2], pv[3];
#define MIX_PREFETCH(jj) { \
      _Pragma("unroll") for (int it = 0; it < 2; it++) { const int pi = tid + it * 512; if (pi < 768) { const int d = pi >> 4, cc = pi & 15; \
          pk1[it] = *(const u32x4*)(ktg + (size_t)d * T + (jj) * 128 + cc * 8); pk2[it] = *(const u32x4*)(ktg + (size_t)(d + 48) * T + (jj) * 128 + cc * 8); } } \
      _Pragma("unroll") for (int it = 0; it < 3; it++) { const int ci = tid + it * 512, e = ci >> 4, cc = ci & 15; pv[it] = *(const u32x4*)(vtg + (size_t)e * T + (jj) * 128 + cc * 8); } }
    if (nsteps > 0) { const int j0 = (0 == nprior_ch) ? c : (dir ? nc - 1 : 0); MIX_PREFETCH(j0); }
#pragma unroll 1
    for (int st = 0; st < nsteps; st++) {
      const bool fin = st == nprior_ch;
      const int j = fin ? c : (dir ? nc - 1 - st : st);
      const float Xref = ML ? (fin ? sc[2 + dir] : Xin) : 0.f;
      if (fin) {
        if (kgrp == 0) {
          const float resc = ML ? __expf(Xin - Xref) : 1.f;
#pragma unroll
          for (int a = 0; a < 3; a++)
#pragma unroll
            for (int b = 0; b < 3; b++) {
              f32x4 v = acc[a][b];
              uint2 o; o.x = pack2(v[0], v[1]); o.y = pack2(v[2], v[3]);
              *(uint2*)(smem + LST + dir * 19968 + ((et0 + b) * 16 + lr) * 208 + ((dt0 + a) * 16 + 4 * lg) * 2) = o;
              acc[a][b] = v * resc;
            }
        }
        if (ML && (tid & 15) == 0) {
          const float resc = __expf(Xin - Xref);
#pragma unroll
          for (int it = 0; it < 2; it++) {
            int d = (tid >> 4) + 32 * it;
            if (d < 48) { nin[dir * 96 + d] = nacc[it][0]; nin[dir * 96 + d + 48] = nacc[it][1]; nacc[it][0] *= resc; nacc[it][1] *= resc; }
          }
        }
      }
      __syncthreads();
#pragma unroll
      for (int it = 0; it < 2; it++) {
        const int pi = tid + it * 512;
        if (pi < 768) {
          const int d = pi >> 4, cc = pi & 15;
          const int t0 = j * 128 + cc * 8;
          const u32x4 k1 = pk1[it], k2 = pk2[it];
          float w[8];
          if (ML) {
            const float4 e0 = *(const float4*)(Eg + dir * 1024 + t0), e1 = *(const float4*)(Eg + dir * 1024 + t0 + 4);
            w[0] = e0.x; w[1] = e0.y; w[2] = e0.z; w[3] = e0.w; w[4] = e1.x; w[5] = e1.y; w[6] = e1.z; w[7] = e1.w;
#pragma unroll
            for (int q = 0; q < 8; q++) w[q] = __expf(w[q] - Xref) * KSCALE;
          } else {
#pragma unroll
            for (int q = 0; q < 8; q++) w[q] = wret[it][q];
          }
          float x1[8], x2[8];
          x1[0] = bflo(k1.x); x1[1] = bfhi(k1.x); x1[2] = bflo(k1.y); x1[3] = bfhi(k1.y); x1[4] = bflo(k1.z); x1[5] = bfhi(k1.z); x1[6] = bflo(k1.w); x1[7] = bfhi(k1.w);
          x2[0] = bflo(k2.x); x2[1] = bfhi(k2.x); x2[2] = bflo(k2.y); x2[3] = bfhi(k2.y); x2[4] = bflo(k2.z); x2[5] = bfhi(k2.z); x2[6] = bflo(k2.w); x2[7] = bfhi(k2.w);
          if (rope) {
            const float* ct = p.rope_cosT + d * 1024 + t0; const float* sn = p.rope_sinT + d * 1024 + t0;
            const float4 c0 = *(const float4*)ct, c1 = *(const float4*)(ct + 4), s0 = *(const float4*)sn, s1 = *(const float4*)(sn + 4);
            const float cv[8] = {c0.x, c0.y, c0.z, c0.w, c1.x, c1.y, c1.z, c1.w}, sv[8] = {s0.x, s0.y, s0.z, s0.w, s1.x, s1.y, s1.z, s1.w};
#pragma unroll
            for (int q = 0; q < 8; q++) { float a1 = x1[q] * cv[q] - x2[q] * sv[q], a2 = x2[q] * cv[q] + x1[q] * sv[q]; x1[q] = a1; x2[q] = a2; }
          }
          float s1 = 0.f, s2 = 0.f;
#pragma unroll
          for (int q = 0; q < 8; q++) { x1[q] *= w[q]; x2[q] *= w[q]; s1 += x1[q]; s2 += x2[q]; }
          uint4 o1, o2;
          o1.x = pack2(x1[0], x1[1]); o1.y = pack2(x1[2], x1[3]); o1.z = pack2(x1[4], x1[5]); o1.w = pack2(x1[6], x1[7]);
          o2.x = pack2(x2[0], x2[1]); o2.y = pack2(x2[2], x2[3]); o2.z = pack2(x2[4], x2[5]); o2.w = pack2(x2[6], x2[7]);
          *(uint4*)(smem + LKT + d * 256 + ((cc ^ (d & 15)) << 4)) = o1;
          *(uint4*)(smem + LKT + (d + 48) * 256 + ((cc ^ ((d + 48) & 15)) << 4)) = o2;
          if (ML) {
            { s1 = row16_sum(s1); s2 = row16_sum(s2); }
            nacc[it][0] += s1; nacc[it][1] += s2;
          }
        }
      }
#pragma unroll
      for (int it = 0; it < 3; it++) {
        const int ci = tid + it * 512, e = ci >> 4, cc = ci & 15;
        *(u32x4*)(smem + LVT + e * 256 + ((cc ^ (e & 15)) << 4)) = pv[it];
      }
      __syncthreads();
      if (st + 1 < nsteps) { const int jn = (st + 1 == nprior_ch) ? c : (dir ? nc - 2 - st : st + 1); MIX_PREFETCH(jn); }
      if (!ML) {
        const float g128 = __builtin_amdgcn_exp2f(128.f * lgdir);
#pragma unroll
        for (int a = 0; a < 3; a++)
#pragma unroll
          for (int b = 0; b < 3; b++) acc[a][b] = acc[a][b] * g128;
      }
      if (kgrp == 0)
#pragma unroll
      for (int kk = 0; kk < 4; kk++) {
        const int ch = kk * 4 + lg;
        bf16x8 af[3], bfr[3];
#pragma unroll
        for (int a = 0; a < 3; a++) { int row = (dt0 + a) * 16 + lr; af[a] = *(const bf16x8*)(smem + LKT + row * 256 + ((ch ^ (row & 15)) << 4)); }
#pragma unroll
        for (int b = 0; b < 3; b++) { int row = (et0 + b) * 16 + lr; bfr[b] = *(const bf16x8*)(smem + LVT + row * 256 + ((ch ^ (row & 15)) << 4)); }
#pragma unroll
        for (int a = 0; a < 3; a++)
#pragma unroll
          for (int b = 0; b < 3; b++) acc[a][b] = __builtin_amdgcn_mfma_f32_16x16x32_bf16(af[a], bfr[b], acc[a][b], 0, 0, 0);
      }
    }
#undef MIX_PREFETCH
    if (kgrp == 0) {
      const size_t sidx = ((size_t)(s * DEPTH + layer) * 2 + dir) * 4 + h;
#pragma unroll
      for (int a = 0; a < 3; a++)
#pragma unroll
        for (int b = 0; b < 3; b++) {
          f32x4 v = acc[a][b];
          if (need_final) {
            float* dst = p.out + (ML ? O_MC : O_SR) + sidx * 9216;
#pragma unroll
            for (int r = 0; r < 4; r++) dst[((dt0 + a) * 16 + 4 * lg + r) * 96 + (et0 + b) * 16 + lr] = v[r];
          } else {
            uint2 o; o.x = pack2(v[0], v[1]); o.y = pack2(v[2], v[3]);
            *(uint2*)(smem + LST + dir * 19968 + ((et0 + b) * 16 + lr) * 208 + ((dt0 + a) * 16 + 4 * lg) * 2) = o;
          }
        }
    }
    if (ML && (tid & 15) == 0) {
      const size_t sidx = ((size_t)(s * DEPTH + layer) * 2 + dir) * 4 + h;
      float f0 = 0.f; const float* n0 = p.state_n;
      if (latent) { f0 = __expf(sc[6 + dir] - Xin); n0 = p.state_n + ((size_t)((lb * DEPTH + layer) * 2 + dir) * 4 + h) * 96; }
#pragma unroll
      for (int it = 0; it < 2; it++) {
        int d = (tid >> 4) + 32 * it;
        if (d < 48) {
          if (need_final) { p.out[O_MN + sidx * 96 + d] = nacc[it][0]; p.out[O_MN + sidx * 96 + d + 48] = nacc[it][1]; }
          else {
            float a0 = nacc[it][0], a1 = nacc[it][1];
            if (latent) { a0 += f0 * n0[d]; a1 += f0 * n0[d + 48]; }
            nin[dir * 96 + d] = a0; nin[dir * 96 + d + 48] = a1;
          }
        }
      }
      if (need_final && tid == 0) p.out[O_MM + sidx] = sc[4 + dir] + sc[2 + dir];
    }
  }
#pragma unroll 1
  for (int orep = 0; orep < REP_OUT; orep++) {
  __syncthreads();
#pragma unroll
  for (int it = 0; it < 2; it++) {
    const int pi = tid + it * 512;
    if (pi < 768) {
      const int r = pi / 6, cc = pi % 6;
      const int pos = P0 + r;
      const bf16_t* pr = p.proj + (size_t)(row0 + pos) * INW + h * 96 + cc * 8;
      uint4 q1 = *(const uint4*)(pr + QOFF), q2 = *(const uint4*)(pr + QOFF + 48);
      uint4 k1 = *(const uint4*)(pr + KOFF), k2 = *(const uint4*)(pr + KOFF + 48);
      float a1[8], a2[8], b1[8], b2[8];
      a1[0] = bflo(q1.x); a1[1] = bfhi(q1.x); a1[2] = bflo(q1.y); a1[3] = bfhi(q1.y); a1[4] = bflo(q1.z); a1[5] = bfhi(q1.z); a1[6] = bflo(q1.w); a1[7] = bfhi(q1.w);
      a2[0] = bflo(q2.x); a2[1] = bfhi(q2.x); a2[2] = bflo(q2.y); a2[3] = bfhi(q2.y); a2[4] = bflo(q2.z); a2[5] = bfhi(q2.z); a2[6] = bflo(q2.w); a2[7] = bfhi(q2.w);
      b1[0] = bflo(k1.x); b1[1] = bfhi(k1.x); b1[2] = bflo(k1.y); b1[3] = bfhi(k1.y); b1[4] = bflo(k1.z); b1[5] = bfhi(k1.z); b1[6] = bflo(k1.w); b1[7] = bfhi(k1.w);
      b2[0] = bflo(k2.x); b2[1] = bfhi(k2.x); b2[2] = bflo(k2.y); b2[3] = bfhi(k2.y); b2[4] = bflo(k2.z); b2[5] = bfhi(k2.z); b2[6] = bflo(k2.w); b2[7] = bfhi(k2.w);
      if (rope) {
        const float* ct = p.rope_cos + pos * 48 + cc * 8; const float* sn = p.rope_sin + pos * 48 + cc * 8;
        const float4 c0 = *(const float4*)ct, c1 = *(const float4*)(ct + 4), s0 = *(const float4*)sn, s1 = *(const float4*)(sn + 4);
        const float cv[8] = {c0.x, c0.y, c0.z, c0.w, c1.x, c1.y, c1.z, c1.w}, sv[8] = {s0.x, s0.y, s0.z, s0.w, s1.x, s1.y, s1.z, s1.w};
#pragma unroll
        for (int q = 0; q < 8; q++) {
          float t1 = a1[q] * cv[q] - a2[q] * sv[q], t2 = a2[q] * cv[q] + a1[q] * sv[q]; a1[q] = t1; a2[q] = t2;
          float u1 = b1[q] * cv[q] - b2[q] * sv[q], u2 = b2[q] * cv[q] + b1[q] * sv[q]; b1[q] = u1; b2[q] = u2;
        }
      }
      uint4 o;
      o.x = pack2(a1[0], a1[1]); o.y = pack2(a1[2], a1[3]); o.z = pack2(a1[4], a1[5]); o.w = pack2(a1[6], a1[7]);
      *(uint4*)(smem + LQ + r * 208 + cc * 16) = o;
      o.x = pack2(a2[0], a2[1]); o.y = pack2(a2[2], a2[3]); o.z = pack2(a2[4], a2[5]); o.w = pack2(a2[6], a2[7]);
      *(uint4*)(smem + LQ + r * 208 + (cc + 6) * 16) = o;
      o.x = pack2(b1[0] * KSCALE, b1[1] * KSCALE); o.y = pack2(b1[2] * KSCALE, b1[3] * KSCALE); o.z = pack2(b1[4] * KSCALE, b1[5] * KSCALE); o.w = pack2(b1[6] * KSCALE, b1[7] * KSCALE);
      *(uint4*)(smem + LK + r * 208 + cc * 16) = o;
      o.x = pack2(b2[0] * KSCALE, b2[1] * KSCALE); o.y = pack2(b2[2] * KSCALE, b2[3] * KSCALE); o.z = pack2(b2[4] * KSCALE, b2[5] * KSCALE); o.w = pack2(b2[6] * KSCALE, b2[7] * KSCALE);
      *(uint4*)(smem + LK + r * 208 + (cc + 6) * 16) = o;
    }
  }
#pragma unroll
  for (int it = 0; it < 3; it++) {
    const int ci = tid + it * 512, e = ci >> 4, cc = ci & 15;
    uint4 v = *(const uint4*)(vtg + (size_t)e * T + P0 + cc * 8);
    *(uint4*)(smem + LVT + e * 256 + ((cc ^ (e & 15)) << 4)) = v;
  }
  __syncthreads();
  {
    const int i0 = wid * 16, il = i0 + lr;
    bf16x8 qf[3];
#pragma unroll
    for (int ks = 0; ks < 3; ks++) qf[ks] = *(const bf16x8*)(smem + LQ + il * 208 + (ks * 4 + lg) * 16);
    f32x4 pt[8];
#pragma unroll
    for (int jt = 0; jt < 8; jt++) {
      f32x4 a4 = zero4();
#pragma unroll
      for (int ks = 0; ks < 3; ks++) {
        bf16x8 kf = *(const bf16x8*)(smem + LK + (jt * 16 + lr) * 208 + (ks * 4 + lg) * 16);
        a4 = __builtin_amdgcn_mfma_f32_16x16x32_bf16(kf, qf[ks], a4, 0, 0, 0);
      }
      pt[jt] = a4;
      __builtin_amdgcn_sched_barrier(0);
    }
    constexpr int ND = ML ? 2 : 1;
    f32x4 o[ND][6];
    float den[2] = {0.f, 0.f};
    float xo[2] = {0.f, 0.f};
    if (ML) { xo[0] = Xo[il]; xo[1] = Xo[128 + il]; }
#pragma unroll
    for (int dd = 0; dd < ND; dd++) {
      bf16x8 pop[4];
#pragma unroll
      for (int jt2 = 0; jt2 < 4; jt2++) {
        float v[8];
#pragma unroll
        for (int q = 0; q < 8; q++) {
          const int jt = jt2 * 2 + (q >> 2), r = q & 3;
          const int jl = jt * 16 + 4 * lg + r;
          float w;
          if (!ML) {
            const int df = il - jl;
            w = df > 0 ? __builtin_amdgcn_exp2f((float)df * lgd0) : (df < 0 ? __builtin_amdgcn_exp2f((float)(-df) * lgd1) : 2.f);
          } else {
            const float e = Eg[dd * 1024 + P0 + jl];
            const bool ok = dd == 0 ? (jl <= il) : (jl >= il);
            w = ok ? __expf(e - xo[dd]) : 0.f;
          }
          v[q] = pt[jt][r] * w;
          den[dd] += v[q];
        }
        union { bf16x8 v8; uint4 u; } cv;
        cv.u.x = pack2(v[0], v[1]); cv.u.y = pack2(v[2], v[3]); cv.u.z = pack2(v[4], v[5]); cv.u.w = pack2(v[6], v[7]);
        pop[jt2] = cv.v8;
        __builtin_amdgcn_sched_barrier(0);
      }
#pragma unroll
      for (int et = 0; et < 6; et++) {
        f32x4 a4 = zero4();
        const int row = et * 16 + lr;
#pragma unroll
        for (int jt2 = 0; jt2 < 4; jt2++) {
          const int ch0 = jt2 * 4 + (lg >> 1), ch1 = ch0 + 2;
          union { bf16x8 v8; uint2 h2[2]; } vf;
          vf.h2[0] = *(const uint2*)(smem + LVT + row * 256 + ((ch0 ^ (row & 15)) << 4) + (lg & 1) * 8);
          vf.h2[1] = *(const uint2*)(smem + LVT + row * 256 + ((ch1 ^ (row & 15)) << 4) + (lg & 1) * 8);
          a4 = __builtin_amdgcn_mfma_f32_16x16x32_bf16(vf.v8, pop[jt2], a4, 0, 0, 0);
        }
        o[dd][et] = a4;
        __builtin_amdgcn_sched_barrier(0);
      }
    }
#pragma unroll
    for (int dir = 0; dir < 2; dir++) {
      float scale;
      if (!ML) scale = dir == 0 ? __builtin_amdgcn_exp2f((float)(il + 1) * lgd0) : __builtin_amdgcn_exp2f((float)(128 - il) * lgd1);
      else scale = __expf(sc[0 + dir] - xo[dir]);
#pragma unroll
      for (int et = 0; et < 6; et++) {
        f32x4 a4 = zero4();
#pragma unroll
        for (int ks = 0; ks < 3; ks++) {
          bf16x8 sf = *(const bf16x8*)(smem + LST + dir * 19968 + (et * 16 + lr) * 208 + (ks * 4 + lg) * 16);
          a4 = __builtin_amdgcn_mfma_f32_16x16x32_bf16(sf, qf[ks], a4, 0, 0, 0);
        }
        o[ML ? dir : 0][et] = o[ML ? dir : 0][et] + a4 * scale;
        __builtin_amdgcn_sched_barrier(0);
      }
      if (ML) {
        float dq = 0.f;
#pragma unroll
        for (int ks = 0; ks < 3; ks++) {
          union { bf16x8 v8; uint4 u; } cv; cv.v8 = qf[ks];
          const float* nn = nin + dir * 96 + ks * 32 + lg * 8;
          dq += bflo(cv.u.x) * nn[0] + bfhi(cv.u.x) * nn[1] + bflo(cv.u.y) * nn[2] + bfhi(cv.u.y) * nn[3] + bflo(cv.u.z) * nn[4] + bfhi(cv.u.z) * nn[5] + bflo(cv.u.w) * nn[6] + bfhi(cv.u.w) * nn[7];
        }
        den[dir] += scale * dq;
      }
    }
    f32x4 of[6];
    if (ML) {
      float nrm[2];
#pragma unroll
      for (int dir = 0; dir < 2; dir++) {
        float dsum = den[dir];
        dsum += __shfl_xor(dsum, 16); dsum += __shfl_xor(dsum, 32);
        const float M = Bo[dir * 128 + il] + xo[dir];
        nrm[dir] = __builtin_amdgcn_rcpf(fmaxf(fabsf(dsum), __expf(-M)));
      }
#pragma unroll
      for (int et = 0; et < 6; et++) of[et] = o[0][et] * nrm[0] + o[ND - 1][et] * nrm[1];
    } else {
#pragma unroll
      for (int et = 0; et < 6; et++) of[et] = o[0][et];
    }
    float ss = 0.f;
#pragma unroll
    for (int et = 0; et < 6; et++) ss += of[et][0] * of[et][0] + of[et][1] * of[et][1] + of[et][2] * of[et][2] + of[et][3] * of[et][3];
    ss += __shfl_xor(ss, 16); ss += __shfl_xor(ss, 32);
    const float rs = rsqrtf(ss * (1.f / 96.f) + EPS);
    const int row = row0 + P0 + il;
    const float* ng = (ML ? p.ml_norm_g : p.ret_norm_g) + layer * 384 + h * 96;
#pragma unroll
    for (int et = 0; et < 6; et++) {
      const int e0 = et * 16 + 4 * lg;
      const uint2 gg = *(const uint2*)(p.proj + (size_t)row * INW + GOFF + h * 96 + e0);
      const float4 n4 = *(const float4*)(ng + e0);
      float g[4] = {bflo(gg.x), bfhi(gg.x), bflo(gg.y), bfhi(gg.y)};
      float r4[4];
      const float nv[4] = {n4.x, n4.y, n4.z, n4.w};
#pragma unroll
      for (int r = 0; r < 4; r++) {
        const float gv = ML ? sigmoidf_(g[r]) : g[r] * sigmoidf_(g[r]);
        r4[r] = of[et][r] * rs * nv[r] * gv;
      }
      uint2 ov; ov.x = pack2(r4[0], r4[1]); ov.y = pack2(r4[2], r4[3]);
      *(uint2*)(p.mixed + (size_t)row * D + MOFF + h * 96 + e0) = ov;
    }
  }
  }
}

constexpr int HZ = 0, HX = 61440, HF = 94208, HO = 127488;
constexpr int FT_CTX = 2 * 256 * 2 * 512, FT_L = FT_CTX + 2 * 256 * 2 * 2048;
typedef float f32x16 __attribute__((ext_vector_type(16)));

__device__ __forceinline__ void hyena_unit(PR p, int layer, int path, int cg, char* smem) {
  const int tid = TIDX, lane = tid & 63, wid = tid >> 6;
  const int L = path ? 1024 : 256, lgL = path ? 10 : 8, NB = path ? 2 : 16, CH = path ? 4 : 2;
  const int c0 = cg * CH, ntok = NB * L, lgnt8 = path ? 8 : 9, tok0 = path ? TC : 0;
  const int ZL = 3 * L + ((3 * L) >> 2), ZO = L - 32;
  __syncthreads();
  u32x4 cvv[6]; unsigned hl[6], hr[6]; float cw0[6], cw1[6], cw2[6], cbb[6];
#pragma unroll
  for (int it = 0; it < 6; it++) {
    const int ci = tid + it * NT;
    const int t8 = ci & ((ntok >> 3) - 1), rest = ci >> lgnt8, arr = rest % 3, ch = rest / 3;
    const int tk = t8 * 8, tl = tk & (L - 1);
    const int col = arr * 256 + c0 + ch;
    const bf16_t* src = p.hyt + (size_t)col * T + tok0 + tk;
    cvv[it] = __builtin_nontemporal_load((const u32x4*)src);
    hl[it] = *(const unsigned short*)(src + (tl > 0 ? -1 : 0)); hr[it] = *(const unsigned short*)(src + (tl + 8 < L ? 8 : 7));
    cw0[it] = p.hy_conv_w[(layer * 3 + 0) * 768 + col]; cw1[it] = p.hy_conv_w[(layer * 3 + 1) * 768 + col]; cw2[it] = p.hy_conv_w[(layer * 3 + 2) * 768 + col]; cbb[it] = p.hy_conv_b[layer * 768 + col];
  }
  u32x4 fv[4];
#define HY_FLOAD(order_) { const int nch_ = CH * 2 * (L >> 2); \
    _Pragma("unroll") for (int j = 0; j < 4; j++) { const int ci = tid + j * NT; fv[j] = (u32x4){0u, 0u, 0u, 0u}; \
      if (ci < nch_) { const int u8 = ci & ((L >> 2) - 1), rest = ci >> (lgL - 2), cp = rest & 1, fc = rest >> 1; \
        fv[j] = __builtin_nontemporal_load((const u32x4*)(p.ft + (size_t)layer * FT_L + (path ? FT_CTX : 0) + ((size_t)(((order_) * 256 + c0 + fc) * 2 + cp) * 2 * L) + u8 * 8)); } } }
  HY_FLOAD(0);
  { unsigned zz_ = 0u; asm volatile("" : "+v"(zz_)); const uint4 z4_ = make_uint4(zz_, zz_, zz_, zz_);
    for (int i = tid; i < 61440 / 16; i += NT) ((uint4*)(smem + HZ))[i] = z4_; }
  __syncthreads();
#pragma unroll
  for (int it = 0; it < 6; it++) {
    const int ci = tid + it * NT;
    const int t8 = ci & ((ntok >> 3) - 1), rest = ci >> lgnt8, arr = rest % 3, ch = rest / 3;
    const int tk = t8 * 8, tl = tk & (L - 1), b = tk >> lgL;
    const u32x4 v = cvv[it];
    float x[10];
    x[0] = tl > 0 ? __uint_as_float(hl[it] << 16) : 0.f; x[9] = tl + 8 < L ? __uint_as_float(hr[it] << 16) : 0.f;
    x[1] = bflo(v.x); x[2] = bfhi(v.x); x[3] = bflo(v.y); x[4] = bfhi(v.y); x[5] = bflo(v.z); x[6] = bfhi(v.z); x[7] = bflo(v.w); x[8] = bfhi(v.w);
    float y[8];
#pragma unroll
    for (int q = 0; q < 8; q++) y[q] = cw0[it] * x[q] + cw1[it] * x[q + 1] + cw2[it] * x[q + 2] + cbb[it];
    uint4 o; o.x = pack2(y[0], y[1]); o.y = pack2(y[2], y[3]); o.z = pack2(y[4], y[5]); o.w = pack2(y[6], y[7]);
    if (arr == 0) { const int idx = ZO + tl, phys = idx + 8 * (idx >> 5); *(uint4*)(smem + HZ + ((ch * NB + b) * ZL + phys) * 2) = o; }
    else *(uint4*)(smem + HX + ((ch * 2 + arr - 1) * ntok + tk) * 2) = o;
  }
  const int cl = lane & 31, hh = lane >> 5;
  int ch, b, I;
  if (path) { ch = wid >> 1; b = wid & 1; I = cl; } else { ch = wid >> 2; b = (wid & 3) * 4 + (cl >> 3); I = cl & 7; }
  char* zb = smem + HZ + ((ch * NB + b) * ZL) * 2;
  const char* fbase = smem + HF + ((ch * 2 + (cl & 1)) * (2 * L + 32)) * 2;
#pragma unroll 1
  for (int order = 0; order < 2; order++) {
    {
      const int nch = CH * 2 * (L >> 2);
#pragma unroll
      for (int j = 0; j < 4; j++) {
        const int ci = tid + j * NT;
        if (ci < nch) {
          const int u8 = ci & ((L >> 2) - 1), rest = ci >> (lgL - 2), cp = rest & 1, fc = rest >> 1;
          *(u32x4*)(smem + HF + ((fc * 2 + cp) * (2 * L + 32) + u8 * 8) * 2) = fv[j];
        }
      }
    }
    __syncthreads();
    if (order == 0) HY_FLOAD(1);
    f32x16 acc;
#pragma unroll
    for (int r = 0; r < 16; r++) acc[r] = 0.f;
#pragma unroll 2
    for (int dl = -L + 16; dl <= L - 32; dl += 16) {
      const int u0 = L - dl - cl + 8 * hh - (cl & 1);
      const unsigned* fp = (const unsigned*)(fbase + u0 * 2);
      union { bf16x8 v8; unsigned u[4]; } af;
      af.u[0] = fp[0]; af.u[1] = fp[1]; af.u[2] = fp[2]; af.u[3] = fp[3];
      const int idx = ZO + 32 * I - dl + 8 * hh, phys = idx + 8 * (idx >> 5);
      const bf16x8 bfr = *(const bf16x8*)(zb + phys * 2);
      acc = __builtin_amdgcn_mfma_f32_32x32x16_bf16(af.v8, bfr, acc, 0, 0, 0);
    }
    __syncthreads();
    const float bias = p.hy_bias[(layer * 2 + order) * 256 + c0 + ch];
#pragma unroll
    for (int g = 0; g < 4; g++) {
      const int t = 32 * I + 8 * g + 4 * hh;
      const int idx = ZO + t, phys = idx + 8 * (idx >> 5);
      const uint2 z4 = *(const uint2*)(zb + phys * 2);
      const uint2 h4 = *(const uint2*)(smem + HX + ((ch * 2 + order) * ntok + b * L + t) * 2);
      const float zz[4] = {bflo(z4.x), bfhi(z4.x), bflo(z4.y), bfhi(z4.y)};
      const float hx[4] = {bflo(h4.x), bfhi(h4.x), bflo(h4.y), bfhi(h4.y)};
      float r4[4];
#pragma unroll
      for (int r = 0; r < 4; r++) r4[r] = hx[r] * (acc[4 * g + r] + bias * zz[r]);
      if (order == 0) { uint2 o; o.x = pack2(r4[0], r4[1]); o.y = pack2(r4[2], r4[3]); *(uint2*)(zb + phys * 2) = o; }
      else {
#pragma unroll
        for (int r = 0; r < 4; r++) *(bf16_t*)(smem + HO + ((b * L + t + r) * CH + ch) * 2) = f2bf(r4[r]);
      }
    }
    __syncthreads();
  }
#undef HY_FLOAD
  for (int tk = tid; tk < ntok; tk += NT) {
    bf16_t* dst = p.mixed + (size_t)(tok0 + tk) * D + 384 + c0;
    if (path) *(uint2*)dst = *(const uint2*)(smem + HO + tk * 8);
    else *(unsigned*)dst = *(const unsigned*)(smem + HO + tk * 4);
  }
}

#define XB_TMO      128
#define XB_XCNT(j)  (256  + 64 * (j))
#define XB_XSUB(j)  (1280 + 64 * (j))
#define XB_XGEN(j)  (2304 + 64 * (j))
#define XB_TOP      3328
#define XB_TOPGEN   3392
#define XCD_BAR_WORDS 3456
#define XB_SPIN_CAP (1u << 22)
__device__ __forceinline__ unsigned xb_ld(unsigned* p)              { return __hip_atomic_load(p, __ATOMIC_RELAXED, __HIP_MEMORY_SCOPE_AGENT); }
__device__ __forceinline__ unsigned xb_add(unsigned* p, unsigned v) { return __hip_atomic_fetch_add(p, v, __ATOMIC_RELAXED, __HIP_MEMORY_SCOPE_AGENT); }
__device__ __forceinline__ unsigned xb_xcc_id() { return (unsigned)__builtin_amdgcn_s_getreg((3 << 11) | 20) & 0xFu; }
#define XB_SPIN(cond, bar) do { unsigned _sp = 0; while (cond) { __builtin_amdgcn_s_sleep(1); \
    if ((++_sp & 255u) == 0u) { if (xb_ld(&(bar)[XB_TMO])) break; if (_sp > XB_SPIN_CAP) { atomicAdd(&(bar)[XB_TMO], 1u); break; } } } } while (0)
struct XcdBarrier { unsigned* bar; unsigned x; volatile LAS unsigned* st; };
__device__ __forceinline__ XcdBarrier xcd_barrier_post(unsigned* bar, volatile LAS unsigned* st) {
    XcdBarrier b; b.bar = bar; b.x = xb_xcc_id(); b.st = st;
    if (threadIdx.x == 0) (void)xb_add(&bar[XB_XCNT(b.x)], 1u);
    return b;
}
__device__ __forceinline__ void xcd_barrier_complete(unsigned* bar, unsigned x, unsigned& nloc, unsigned& nx) {
    const unsigned G = gridDim.x * gridDim.y * gridDim.z;
    unsigned sum, cnt, mine, sp = 0u;
    for (;;) {
        sum = 0u; cnt = 0u; mine = 0u;
#pragma unroll
        for (unsigned j = 0; j < 16; ++j) { const unsigned c = xb_ld(&bar[XB_XCNT(j)]); sum += c; cnt += (c > 0u) ? 1u : 0u; mine = (j == x) ? c : mine; }
        if (sum == G) break;
        __builtin_amdgcn_s_sleep(1);
        if ((++sp & 255u) == 0u) { if (xb_ld(&bar[XB_TMO])) break; if (sp > XB_SPIN_CAP) { atomicAdd(&bar[XB_TMO], 1u); break; } }
    }
    nloc = mine > 0u ? mine : 1u; nx = cnt > 0u ? cnt : 1u;
}
__device__ __forceinline__ void xcd_barrier(const XcdBarrier& b) {
    asm volatile("s_waitcnt vmcnt(0)" ::: "memory");
    __syncthreads();
    if (TIDX == 0) {
        unsigned* bar = b.bar;
        __builtin_amdgcn_s_waitcnt(0);
        unsigned nloc = b.st[0], nx = b.st[1];
        if (nloc == 0u) { xcd_barrier_complete(bar, b.x, nloc, nx); b.st[0] = nloc; b.st[1] = nx; }
        const unsigned old = xb_add(&bar[XB_XSUB(b.x)], 1u);
        const unsigned gen = old / nloc;
        if (old + 1u == (gen + 1u) * nloc) {
            __builtin_amdgcn_fence(__ATOMIC_RELEASE, "agent");
            asm volatile("s_waitcnt vmcnt(0)" ::: "memory");
            const unsigned og = xb_add(&bar[XB_TOP], 1u);
            const unsigned tg = og / nx;
            if (og + 1u == (tg + 1u) * nx) xb_add(&bar[XB_TOPGEN], 1u);
            else XB_SPIN(xb_ld(&bar[XB_TOPGEN]) == tg, bar);
            __builtin_amdgcn_fence(__ATOMIC_ACQUIRE, "agent");
            xb_add(&bar[XB_XGEN(b.x)], 1u);
            asm volatile("s_waitcnt vmcnt(0)" ::: "memory");
        } else {
            XB_SPIN(xb_ld(&bar[XB_XGEN(b.x)]) == gen, bar);
            __builtin_amdgcn_fence(__ATOMIC_ACQUIRE, "agent");
            asm volatile("s_waitcnt vmcnt(0)" ::: "memory");
        }
    }
    __syncthreads();
}


constexpr int MIXALL_UNITS = 576;
__device__ __forceinline__ void phase_mix_all(PR p, int layer, int rep, int bid, int nb, char* smem) {
  volatile LAS unsigned* bc = (volatile LAS unsigned*)(smem + SMEM_BYTES - 32);
  unsigned* ctr = p.bar + XCD_BAR_WORDS + layer + 8 * rep;
  for (int first = 1;; first = 0) {
    int u = bid;
    if (!first) {
      __syncthreads();
      if (TIDX == 0) *bc = atomicAdd(ctr, 1u) + (unsigned)nb;
      __syncthreads();
      u = (int)*bc;
    }
    if (u >= MIXALL_UNITS) break;
    int kind, a0 = 0, a1 = 0, a2 = 0;
    if (u < 128) { int v = u & 63; a0 = 16 + (v >> 5); a1 = (v >> 2) & 7; a2 = v & 3; kind = u < 64 ? 0 : 1; }
    else if (u < 192) { kind = 2; a0 = 1; a1 = u - 128; }
    else if (u < 448) { int v = (u - 192) & 127; a0 = v >> 3; a1 = (v >> 2) & 1; a2 = v & 3; kind = u < 320 ? 0 : 1; }
    else { kind = 2; a0 = 0; a1 = u - 448; }
    for (int rr = 0; rr < ((kind == PROBE_KIND) ? 2 : 1); rr++) {
    if (kind == 0) mix_unit<true>(p, layer, a0, a1, a2, smem);
    else if (kind == 1) mix_unit<false>(p, layer, a0, a1, a2, smem);
    else hyena_unit(p, layer, a0, a1, smem);
    }
  }
}


__device__ __forceinline__ void phase_prologue(PR p, char* smem) {
  volatile LAS unsigned* bc = (volatile LAS unsigned*)(smem + SMEM_BYTES - 32);
  unsigned* ctr = p.bar + XCD_BAR_WORDS + 40;
  constexpr int NF = DEPTH * 80, NM = DEPTH * 48, NR = 8, NTR = DEPTH * TR_L, NU = NF + NM + NR + NTR, FSTEP = 10;
  static_assert((NF - 1) * FSTEP < NU, "filter slots");
  for (int first = 1;; first = 0) {
    int u = (int)blockIdx.x;
    if (!first) {
      __syncthreads();
      if (TIDX == 0) *bc = atomicAdd(ctr, 1u) + gridDim.x;
      __syncthreads();
      u = (int)*bc;
    }
    if (u >= NU) break;
    const int fs = u / FSTEP;
    if (u - fs * FSTEP == 0 && fs < NF) { phase_filt(p, fs, 1 << 30, smem); continue; }
    const int v = u - (fs + 1 < NF ? fs + 1 : NF);
    if (v < NM) phase_mod(p, v, 1 << 30, smem);
    else if (v < NM + NR) phase_rope(p, v - NM, NR);
    else phase_transpose(p, v - NM - NR, 1 << 30, smem);
  }
}

enum { PH_TRANSPOSE = 0, PH_MOD, PH_ROPE, PH_FILT, PH_S0, PH_INPROJ, PH_RET, PH_ML, PH_RETST, PH_MLST, PH_HY1, PH_HY2A, PH_HY2B, PH_OUTPROJ, PH_S1, PH_UP, PH_ACT, PH_DOWN, PH_MIXF, PH_MIXALL, PH_OUTPROJ_F, PH_DOWN_F };

template <int ph>
__device__ __forceinline__ void run_phase(PR p, int layer, int bid, int nb, char* smem) {
  switch (ph) {
    case PH_TRANSPOSE: phase_transpose(p, bid, nb, smem); break;
    case PH_MOD: phase_mod(p, bid, nb, smem); break;
    case PH_ROPE: phase_rope(p, bid, nb); break;
    case PH_FILT: phase_filt(p, bid, nb, smem); break;
    case PH_S0: phase_rowpass(p, layer, 0, bid, nb); break;
    case PH_S1: phase_rowpass(p, layer, 1, bid, nb); break;
    case PH_INPROJ: {
      EpiProj e{p.proj, p.ktr, p.vtr, p.ktm, p.vtm, p.hyt, p.gates};
      phase_gemm<192, 256, USE_GLDS, EpiProj>(p.hbuf, p.wt_in + (size_t)layer * INWP * D, T, INWP, D, bid, nb, smem, e);
    } break;
    case PH_MIXALL: phase_mix_all(p, layer & 7, layer >> 3, bid, nb, smem); break;
    case PH_OUTPROJ: {
      EpiF32 e{p.raw, D};
      phase_gemm<192, 128, USE_GLDS, EpiF32>(p.mixed, p.wt_out + (size_t)layer * D * D, T, D, D, bid, nb, smem, e);
    } break;
    case PH_OUTPROJ_F: {
      const int slotid = layer * 2;
      EpiRow e{p.xbuf, p.x1buf, p.hbuf, p.mod + (size_t)layer * 3 * 6144, 2 * 1024, p.norm_mix_post + layer * D,
               p.mod + (size_t)layer * 3 * 6144, 3 * 1024, p.norm_ffn_pre + layer * D,
               p.rstats, (unsigned)(slotid + 1), p.bar + XCD_BAR_WORDS + 64 + 8 * 32 * 16};
      phase_gemm<192, 128, 2, EpiRow>(p.mixed, p.wt_out + (size_t)layer * D * D, T, D, D, bid, nb, smem, e);
    } break;
    case PH_DOWN_F: {
      const int slotid = layer * 2 + 1;
      const bool last = layer + 1 >= DEPTH;
      const int ln = last ? layer : layer + 1;
      EpiRow e{p.x1buf, last ? p.out : p.xbuf, last ? (bf16_t*)nullptr : p.hbuf, p.mod + (size_t)layer * 3 * 6144, 5 * 1024, p.norm_ffn_post + layer * D,
               p.mod + (size_t)ln * 3 * 6144, 0, p.norm_mix_pre + ln * D,
               p.rstats, (unsigned)(slotid + 1), p.bar + XCD_BAR_WORDS + 64 + 8 * 32 * 16};
      phase_gemm<192, 128, 2, EpiRow>(p.ubuf, p.wt_down + (size_t)layer * D * DFF, T, D, DFF, bid, nb, smem, e);
    } break;
    case PH_UP: {
      EpiUp e{p.ubuf, p.hbuf, p.wt_up + (size_t)layer * 2 * DFF * D, p.ffn_conv_w + (size_t)layer * 3 * DFF, p.ffn_conv_b + (size_t)layer * DFF};
#if UP8
      gemm_up8(p.hbuf, p.wt_up + (size_t)layer * 2 * DFF * D, bid, nb, smem, e);
#else
      phase_gemm<256, 256, USE_GLDS, EpiUp>(p.hbuf, p.wt_up + (size_t)layer * 2 * DFF * D, T, 2 * DFF, D, bid, nb, smem, e);
#endif
    } break;
    case PH_DOWN: {
      EpiF32 e{p.raw, D};
      phase_gemm<192, 128, USE_GLDS, EpiF32>(p.ubuf, p.wt_down + (size_t)layer * D * DFF, T, D, DFF, bid, nb, smem, e);
    } break;
  }
}

#ifndef MULTI_LAUNCH
#define MULTI_LAUNCH 0
#endif
__global__ void __launch_bounds__(NT) k_mega(Params p_) {
  extern __shared__ __attribute__((aligned(16))) char smem[];
  const int bid = blockIdx.x, nb = gridDim.x;
  volatile LAS unsigned* st = (volatile LAS unsigned*)(smem + SMEM_BYTES - 16);
  if (TIDX == 0) { st[0] = 0u; st[1] = 0u; st[2] = 0u; st[3] = 0u; }
  __syncthreads();
  (void)xcd_barrier_post(get_params()->bar, st);
#define BAR() { XcdBarrier xb_; xb_.bar = get_params()->bar; xb_.x = xb_xcc_id(); xb_.st = st; xcd_barrier(xb_); }
  phase_prologue(*get_params(), smem);
  BAR();
  run_phase<PH_S0>(*get_params(), 0, bid, nb, smem);
  BAR();
  for (int l = 0; l < DEPTH; l++) {
    for (int rep = 0; rep < REP_G1; rep++) { run_phase<PH_INPROJ>(*get_params(), l, bid, nb, smem); BAR(); }
    for (int rep = 0; rep < REP_MIX; rep++) { run_phase<PH_MIXALL>(*get_params(), l + 8 * rep, bid, nb, smem); BAR(); }
    for (int rep = 0; rep < REP_BAR; rep++) BAR();
    for (int rep = 0; rep < REP_G2; rep++) { run_phase<PH_OUTPROJ_F>(*get_params(), l, bid, nb, smem); BAR(); }
    for (int rep = 0; rep < REP_G3; rep++) { run_phase<PH_UP>(*get_params(), l, bid, nb, smem); BAR(); }
    for (int rep = 0; rep < REP_G4; rep++) { run_phase<PH_DOWN_F>(*get_params(), l, bid, nb, smem); if (rep + 1 < REP_G4) BAR(); }
    if (l + 1 < DEPTH) BAR();
  }
}

static inline size_t align_up(size_t x) { return (x + 255) & ~(size_t)255; }

extern "C" void kernel_launch(void* const* d_in, const int* in_sizes, int n_in, void* d_out, int out_size, void* d_ws, size_t ws_size, hipStream_t stream) {
  Params p{};
  const float* const* in = (const float* const*)d_in;
  p.x_prompt = in[0]; p.x_sample = in[1]; p.c = in[2]; p.state_ret = in[3]; p.state_c = in[4]; p.state_n = in[5]; p.state_m = in[6]; p.c_ctx = in[7];
  p.norm_mix_pre = in[8]; p.norm_mix_post = in[9]; p.norm_ffn_pre = in[10]; p.norm_ffn_post = in[11]; p.w_mod = in[12]; p.b_mod = in[13]; p.w_in = in[14]; p.w_out = in[15];
  p.ret_decay_logit = in[16]; p.ret_norm_g = in[17]; p.hy_conv_w = in[18]; p.hy_conv_b = in[19]; p.hy_f_w1 = in[20]; p.hy_f_b1 = in[21]; p.hy_f_w2 = in[22]; p.hy_f_b2 = in[23];
  p.hy_f_w3 = in[24]; p.hy_f_b3 = in[25]; p.hy_sin_freq = in[26]; p.hy_bias = in[27]; p.ml_gate_bias = in[28]; p.ml_norm_g = in[29];
  p.w_up = in[30]; p.ffn_conv_w = in[31]; p.ffn_conv_b = in[32]; p.w_down = in[33];
  p.out = (float*)d_out;
  char* w = (char*)d_ws; size_t off = 0;
  auto take = [&](size_t bytes) { char* r = w + off; off = align_up(off + bytes); return r; };
  p.wt_in = (bf16_t*)take((size_t)DEPTH * INWP * D * 2);
  p.wt_out = (bf16_t*)take((size_t)DEPTH * D * D * 2);
  p.wt_up = (bf16_t*)take((size_t)DEPTH * 2 * DFF * D * 2);
  p.wt_down = (bf16_t*)take((size_t)DEPTH * D * DFF * 2);
  p.mod = (float*)take((size_t)DEPTH * 3 * 6144 * 4);
  p.rope_cos = (float*)take(1024 * 48 * 4); p.rope_sin = (float*)take(1024 * 48 * 4);
  p.rope_cosT = (float*)take(1024 * 48 * 4); p.rope_sinT = (float*)take(1024 * 48 * 4);
  p.xbuf = (float*)take((size_t)T * D * 4); p.x1buf = (float*)take((size_t)T * D * 4); p.raw = (float*)take((size_t)T * D * 4);
  p.hbuf = (bf16_t*)take((size_t)T * D * 2);
  p.ubuf = (bf16_t*)take((size_t)T * DFF * 2);
  p.proj = (bf16_t*)take((size_t)T * INW * 2);
  p.ktr = (bf16_t*)take((size_t)384 * T * 2); p.vtr = (bf16_t*)take((size_t)384 * T * 2);
  p.ktm = (bf16_t*)take((size_t)384 * T * 2); p.vtm = (bf16_t*)take((size_t)384 * T * 2);
  p.hyt = (bf16_t*)take((size_t)768 * T * 2);
  p.mixed = (bf16_t*)take((size_t)T * D * 2);
  p.gates = (float*)take((size_t)T * 16 * 4);
  p.ft = (bf16_t*)take((size_t)DEPTH * (2 * 256 * 2 * 512 + 2 * 256 * 2 * 2048) * 2);
  p.bar = (unsigned*)take((XCD_BAR_WORDS + 64 + 8 * 32 * 16 + 16) * 4);
  p.rstats = (unsigned long long*)take((size_t)8 * 32 * 192 * 8 * 2 * 8);
  if (off > ws_size) { fprintf(stderr, "workspace too small: need %zu have %zu\n", off, ws_size); return; }

  {
    static int grid = 0;
    if (grid == 0) {
      int dev = 0, cus = 0;
      if (hipGetDevice(&dev) != hipSuccess || hipDeviceGetAttribute(&cus, hipDeviceAttributeMultiprocessorCount, dev) != hipSuccess || cus <= 0) { fprintf(stderr, "device query failed\n"); grid = -1; return; }
      if (hipFuncSetAttribute((const void*)k_mega, hipFuncAttributeMaxDynamicSharedMemorySize, SMEM_BYTES) != hipSuccess) { fprintf(stderr, "hipFuncSetAttribute failed\n"); grid = -1; return; }
      grid = cus;
    }
    if (grid < 0) return;
    if (hipMemsetAsync(p.bar, 0, (XCD_BAR_WORDS + 64 + 8 * 32 * 16 + 16) * 4, stream) != hipSuccess) { fprintf(stderr, "memset failed\n"); return; }
    p.fuse_rows = 1; p.pad_ = 0;
    if (grid < 256) { fprintf(stderr, "this kernel needs >= 256 CUs (one resident workgroup per column tile of the fused residual epilogues)\n"); return; }
    hipLaunchKernelGGL(k_mega, dim3(grid), dim3(NT), SMEM_BYTES, stream, p);
  }
}
```

```cpp
#include <hip/hip_runtime.h>
#include <stdint.h>
#include <stdio.h>

#define NT 512
#define LAS __attribute__((address_space(3)))
constexpr int SMEM_BYTES = 162816;
typedef unsigned short bf16_t;
typedef short bf16x8 __attribute__((ext_vector_type(8)));
typedef float f32x4 __attribute__((ext_vector_type(4)));
typedef unsigned u32x4 __attribute__((ext_vector_type(4)));
typedef unsigned u32x3 __attribute__((ext_vector_type(3)));
typedef unsigned u32x2 __attribute__((ext_vector_type(2)));
#define S0F_OFF (3456 + 64 + 8 * 32 * 16 + 16 + 768)

constexpr int D = 1024, T = 6144, TC = 4096, DEPTH = 4;
constexpr int INW = 3856, INWP = 4096, DFF = 4096;
constexpr float EPS = 1e-6f;
constexpr size_t O_YP = 0, O_YS = 4194304, O_SR = 6291456, O_MC = 11010048, O_MN = 15728640, O_MM = 15777792;

#ifndef REP_MIX
#define REP_MIX 1
#endif
#ifndef REP_ELT
#define REP_ELT 1
#endif
#ifndef REP_BAR
#define REP_BAR 0
#endif
#ifndef REP_TR
#define REP_TR 1
#endif
#ifndef REP_MOD
#define REP_MOD 1
#endif
#ifndef REP_FILT
#define REP_FILT 1
#endif
#ifndef REP_STATE
#define REP_STATE 1
#endif
#ifndef REP_OUT
#define REP_OUT 1
#endif
#ifndef UP8
#define UP8 1
#endif
#ifndef USE_GLDS
#define USE_GLDS 1
#endif
#ifndef PROBE_KIND
#define PROBE_KIND 9
#endif
#ifndef SEAMS
#define SEAMS 1
#endif
#ifndef REP_EPI
#define REP_EPI 1
#endif
#ifndef REP_G1
#define REP_G1 1
#endif
#ifndef REP_G2
#define REP_G2 1
#endif
#ifndef REP_G3
#define REP_G3 1
#endif
#ifndef REP_G4
#define REP_G4 1
#endif
#ifndef NAIVE_MIX
#define NAIVE_MIX 0
#endif
#ifndef NAIVE_GEMM
#define NAIVE_GEMM 0
#endif

struct Params {
  const float *x_prompt, *x_sample, *c, *state_ret, *state_c, *state_n, *state_m, *c_ctx;
  const float *norm_mix_pre, *norm_mix_post, *norm_ffn_pre, *norm_ffn_post, *w_mod, *b_mod, *w_in, *w_out;
  const float *ret_decay_logit, *ret_norm_g, *hy_conv_w, *hy_conv_b, *hy_f_w1, *hy_f_b1, *hy_f_w2, *hy_f_b2, *hy_f_w3, *hy_f_b3, *hy_sin_freq, *hy_bias, *ml_gate_bias, *ml_norm_g;
  const float *w_up, *ffn_conv_w, *ffn_conv_b, *w_down;
  float* out;
  bf16_t *wt_in, *wt_out, *wt_up, *wt_down;
  float *mod, *rope_cos, *rope_sin, *rope_cosT, *rope_sinT;
  float *xbuf, *x1buf, *raw;
  bf16_t *hbuf, *proj, *ktr, *vtr, *ktm, *vtm, *hyt, *mixed, *ubuf;
  float *gates;
  bf16_t* ft;
  unsigned* bar;
  unsigned long long* rstats;
  int fuse_rows; int pad_;
};

#define CONSTAS __attribute__((address_space(4)))
typedef const CONSTAS Params& PR;
__device__ __forceinline__ const CONSTAS Params* get_params() {
  const CONSTAS Params* pp = (const CONSTAS Params*)__builtin_amdgcn_kernarg_segment_ptr();
  asm volatile("" : "+s"(pp));
  return pp;
}
__device__ __forceinline__ int opaque_tid() { int t = threadIdx.x; asm volatile("" : "+v"(t)); return t; }
#define TIDX opaque_tid()

__device__ __forceinline__ unsigned cvt_pk_bf16(float lo, float hi) { unsigned r; asm("v_cvt_pk_bf16_f32 %0, %1, %2" : "=v"(r) : "v"(lo), "v"(hi)); return r; }
__device__ __forceinline__ bf16_t f2bf(float f) { return (bf16_t)(cvt_pk_bf16(f, 0.f) & 0xffffu); }
__device__ __forceinline__ float bf2f(bf16_t h) { return __uint_as_float(((unsigned)h) << 16); }
__device__ __forceinline__ float bflo(unsigned u) { return __uint_as_float(u << 16); }
__device__ __forceinline__ float bfhi(unsigned u) { return __uint_as_float(u & 0xffff0000u); }
__device__ __forceinline__ unsigned pack2(float a, float b) { return cvt_pk_bf16(a, b); }
__device__ __forceinline__ f32x4 zero4() { float z = 0.f; asm volatile("" : "+v"(z)); return (f32x4){z, z, z, z}; }
__device__ __forceinline__ float row16_sum(float v) {
  v += __int_as_float(__builtin_amdgcn_update_dpp(0, __float_as_int(v), 0xB1, 0xF, 0xF, false));
  v += __int_as_float(__builtin_amdgcn_update_dpp(0, __float_as_int(v), 0x4E, 0xF, 0xF, false));
  v += __int_as_float(__builtin_amdgcn_update_dpp(0, __float_as_int(v), 0x141, 0xF, 0xF, false));
  v += __int_as_float(__builtin_amdgcn_update_dpp(0, __float_as_int(v), 0x140, 0xF, 0xF, false));
  return v;
}
__device__ __forceinline__ float wave_sum(float v) {
  v = row16_sum(v);
  v += __shfl_xor(v, 16); v += __shfl_xor(v, 32);
  return v;
}
__device__ __forceinline__ float sigmoidf_(float x) { return __builtin_amdgcn_rcpf(1.f + __expf(-x)); }
__device__ __forceinline__ float log_sigmoidf_(float x) { return fminf(x, 0.f) - log1pf(__expf(-fabsf(x))); }
__device__ __forceinline__ float gelu_tanh(float x) {
  const float k = 0.7978845608028654f;
  float u = k * (x + 0.044715f * x * x * x);
  return 0.5f * x * (1.f + tanhf(u));
}
__device__ __forceinline__ int seq_len(int s) { return s < 16 ? 256 : 1024; }
__device__ __forceinline__ int seq_row0(int s) { return s < 16 ? s * 256 : TC + (s - 16) * 1024; }
__device__ __forceinline__ int row_mod(int row) { return row < TC ? 0 : 1 + ((row - TC) >> 10); }

template <class RowFn>
__device__ __forceinline__ void tr_batch(const float* __restrict__ src, int K, int N, int k0, int nt0, int cnt, bf16_t* __restrict__ dst, RowFn drow, float* lds) {
  const int tid = TIDX;
  float4 v[4][2];
#pragma unroll
  for (int b = 0; b < 4; b++)
#pragma unroll
    for (int i = 0; i < 2; i++) {
      const int k = (tid >> 4) + 32 * i, n = (nt0 + b) * 64 + (tid & 15) * 4;
      v[b][i] = make_float4(0.f, 0.f, 0.f, 0.f);
      if (b < cnt && n < N) { const f32x4 t_ = __builtin_nontemporal_load((const f32x4*)(src + (size_t)(k0 + k) * N + n)); v[b][i] = make_float4(t_[0], t_[1], t_[2], t_[3]); }
    }
  __syncthreads();
#pragma unroll
  for (int b = 0; b < 4; b++)
#pragma unroll
    for (int i = 0; i < 2; i++) {
      const int k = (tid >> 4) + 32 * i, n4 = (tid & 15) * 4;
      float* l = lds + b * 64 * 65;
      l[(n4 + 0) * 65 + k] = v[b][i].x; l[(n4 + 1) * 65 + k] = v[b][i].y; l[(n4 + 2) * 65 + k] = v[b][i].z; l[(n4 + 3) * 65 + k] = v[b][i].w;
    }
  __syncthreads();
#pragma unroll
  for (int b = 0; b < 4; b++) if (b < cnt) {
    const int n = tid >> 3, kc = (tid & 7) * 8;
    const float* r = lds + b * 64 * 65 + n * 65 + kc;
    uint4 o;
    o.x = pack2(r[0], r[1]); o.y = pack2(r[2], r[3]); o.z = pack2(r[4], r[5]); o.w = pack2(r[6], r[7]);
    __builtin_nontemporal_store((u32x4){o.x, o.y, o.z, o.w}, (u32x4*)(dst + (size_t)(drow(nt0 + b) + n) * K + k0 + kc));
  }
}

constexpr int TR_IN = 16 * 16, TR_OUT = 16 * 4, TR_UP = 16 * 32, TR_DN = 64 * 4, TR_L = TR_IN + TR_OUT + TR_UP + TR_DN;
__device__ __forceinline__ void phase_transpose(PR p, int bid, int nb, char* smem) {
  float* lds = (float*)smem;
  {
    const int u = bid;
    int l = u / TR_L, r = u % TR_L;
    if (r < TR_IN) {
      int kt = r >> 4, nb4 = r & 15;
      tr_batch(p.w_in + (size_t)l * D * INW, D, INW, kt * 64, nb4 * 4, 4, p.wt_in + (size_t)l * INWP * D, [](int nt) { return nt * 64; }, lds);
    } else if ((r -= TR_IN) < TR_OUT) {
      int kt = r >> 2, nb4 = r & 3;
      tr_batch(p.w_out + (size_t)l * D * D, D, D, kt * 64, nb4 * 4, 4, p.wt_out + (size_t)l * D * D, [](int nt) { return nt * 64; }, lds);
    } else if ((r -= TR_OUT) < TR_UP) {
      int kt = r >> 5, nb4 = r & 31;
      tr_batch(p.w_up + (size_t)l * D * 2 * DFF, D, 2 * DFF, kt * 64, nb4 * 4, 4, p.wt_up + (size_t)l * 2 * DFF * D, [](int nt) { return nt < 64 ? (nt >> 1) * 256 + (nt & 1) * 64 : ((nt - 64) >> 1) * 256 + 128 + (nt & 1) * 64; }, lds);
    } else {
      r -= TR_UP;
      int kt = r >> 2, nb4 = r & 3;
      tr_batch(p.w_down + (size_t)l * DFF * D, DFF, D, kt * 64, nb4 * 4, 4, p.wt_down + (size_t)l * D * DFF, [](int nt) { return nt * 64; }, lds);
    }
  }
}

__device__ __forceinline__ void phase_mod(PR p, int bid, int nb, char* smem) {
  float* sv = (float*)smem;
  float* red = sv + 3 * 1024;
  const int tid = TIDX, lane = tid & 63, wid = tid >> 6;
  for (int i = tid; i < 3 * 1024; i += NT) {
    int v = i >> 10, k = i & 1023;
    float x = v == 0 ? p.c_ctx[k] : p.c[(v - 1) * 1024 + k];
    sv[i] = x * sigmoidf_(x);
  }
  __syncthreads();
  {
    const int u = bid;
    int l = u / 48, cb = u % 48;
    int kg = wid * 2 + (lane >> 5), cl = lane & 31;
    const float* w = p.w_mod + (size_t)l * D * 6144 + cb * 128 + cl * 4;
    float acc[3][4] = {};
#pragma unroll 16
    for (int k = kg * 64; k < kg * 64 + 64; k++) {
      const f32x4 wv_ = __builtin_nontemporal_load((const f32x4*)(w + (size_t)k * 6144)); const float4 wv = make_float4(wv_[0], wv_[1], wv_[2], wv_[3]);
#pragma unroll
      for (int v = 0; v < 3; v++) {
        float s = sv[v * 1024 + k];
        acc[v][0] += s * wv.x; acc[v][1] += s * wv.y; acc[v][2] += s * wv.z; acc[v][3] += s * wv.w;
      }
    }
#pragma unroll
    for (int v = 0; v < 3; v++)
#pragma unroll
      for (int j = 0; j < 4; j++) red[(kg * 3 + v) * 128 + cl * 4 + j] = acc[v][j];
    __syncthreads();
    if (tid < 384) {
      int v = tid >> 7, cidx = tid & 127;
      float s = 0.f;
      for (int g = 0; g < 16; g++) s += red[(g * 3 + v) * 128 + cidx];
      int col = cb * 128 + cidx;
      p.mod[((size_t)l * 3 + v) * 6144 + col] = s + p.b_mod[(size_t)l * 6144 + col];
    }
    __syncthreads();
  }
}

__device__ __forceinline__ void phase_rope(PR p, int bid, int nb) {
  for (int i = bid * NT + TIDX; i < 1024 * 48; i += nb * NT) {
    int pos = i / 48, j = i % 48;
    int f = j < 24 ? j : j - 24;
    float base = j < 24 ? (float)(pos >> 6) : (float)(pos & 63);
    float freq = __builtin_amdgcn_exp2f(-(float)f * (13.287712379549449f / 24.f));
    float a = base * freq;
    float cv = cosf(a), sv = sinf(a);
    p.rope_cos[i] = cv; p.rope_sin[i] = sv; p.rope_cosT[j * 1024 + pos] = cv; p.rope_sinT[j * 1024 + pos] = sv;
  }
}

constexpr int FT_CTX_ = 2 * 256 * 2 * 512, FT_L_ = FT_CTX_ + 2 * 256 * 2 * 2048;
#define FSIN(x) __builtin_amdgcn_sinf((x) * 0.15915494309189535f)
__device__ __forceinline__ void phase_filt(PR p, int bid, int nb, char* smem) {
  float* feat = (float*)smem;
  float* h1 = feat + 128 * 33;
  float* h2 = h1 + 128 * 64;
  float* w3s = h2 + 128 * 65;
  float* w1s = w3s + 64 * 128;
  float* w2s = w1s + 33 * 64;
  const int tid = TIDX, lane = tid & 63, wid = tid >> 6;
  {
    const int u = bid;
    const int l = u / 80, r = u % 80;
    const int path = r < 16 ? 0 : 1;
    const int Lp = path ? 1024 : 256;
    const int pb = path ? (r - 16) >> 3 : r >> 3, nblk = r & 7;
    const int pos0 = pb * 128;
    __syncthreads();
    for (int i = tid; i < 128 * 33; i += NT) {
      int pp = i / 33, j = i % 33;
      float tn = (float)(pos0 + pp) / (float)Lp;
      float v;
      if (j == 0) v = tn;
      else {
        int bi = (j - 1) & 15;
        float band = 1e-4f + (float)bi * ((15.f - 1e-4f) / 15.f);
        const float rev = tn * band;
        v = j <= 16 ? __builtin_amdgcn_cosf(rev) : __builtin_amdgcn_sinf(rev);
      }
      feat[i] = v;
    }
    {
      float4 t3[4], t1[2], t2[2];
#pragma unroll
      for (int j = 0; j < 4; j++) { const int i4 = tid + j * NT, k = i4 >> 5, n4 = i4 & 31; t3[j] = *(const float4*)(p.hy_f_w3 + ((size_t)l * 64 + k) * 1024 + nblk * 128 + n4 * 4); }
#pragma unroll
      for (int j = 0; j < 2; j++) { const int i4 = tid + j * NT; t1[j] = i4 < 528 ? *(const float4*)(p.hy_f_w1 + (size_t)l * 33 * 64 + i4 * 4) : make_float4(0.f, 0.f, 0.f, 0.f); t2[j] = *(const float4*)(p.hy_f_w2 + (size_t)l * 64 * 64 + i4 * 4); }
#pragma unroll
      for (int j = 0; j < 4; j++) *(float4*)(w3s + (tid + j * NT) * 4) = t3[j];
#pragma unroll
      for (int j = 0; j < 2; j++) { const int i4 = tid + j * NT; if (i4 < 528) *(float4*)(w1s + i4 * 4) = t1[j]; *(float4*)(w2s + i4 * 4) = t2[j]; }
    }
    __syncthreads();
    {
      const int jq = tid & 15, pg = tid >> 4;
      float acc[4][4];
      {
        const float4 b1 = *(const float4*)(p.hy_f_b1 + l * 64 + 4 * jq);
#pragma unroll
        for (int pp = 0; pp < 4; pp++) { acc[pp][0] = b1.x; acc[pp][1] = b1.y; acc[pp][2] = b1.z; acc[pp][3] = b1.w; }
      }
#pragma unroll 3
      for (int k = 0; k < 33; k++) {
        const float4 w = *(const float4*)(w1s + k * 64 + 4 * jq);
#pragma unroll
        for (int pp = 0; pp < 4; pp++) { const float f = feat[(pg * 4 + pp) * 33 + k]; acc[pp][0] += f * w.x; acc[pp][1] += f * w.y; acc[pp][2] += f * w.z; acc[pp][3] += f * w.w; }
      }
      const float4 fr = *(const float4*)(p.hy_sin_freq + l * 64 + 4 * jq);
#pragma unroll
      for (int pp = 0; pp < 4; pp++)
        *(float4*)(h1 + (pg * 4 + pp) * 64 + 4 * jq) = make_float4(FSIN(fr.x * acc[pp][0]), FSIN(fr.y * acc[pp][1]), FSIN(fr.z * acc[pp][2]), FSIN(fr.w * acc[pp][3]));
    }
    __syncthreads();
    {
      const int jq = tid & 15, pg = tid >> 4;
      float acc[4][4];
      {
        const float4 b2 = *(const float4*)(p.hy_f_b2 + l * 64 + 4 * jq);
#pragma unroll
        for (int pp = 0; pp < 4; pp++) { acc[pp][0] = b2.x; acc[pp][1] = b2.y; acc[pp][2] = b2.z; acc[pp][3] = b2.w; }
      }
#pragma unroll 4
      for (int k = 0; k < 64; k++) {
        const float4 w = *(const float4*)(w2s + k * 64 + 4 * jq);
#pragma unroll
        for (int pp = 0; pp < 4; pp++) { const float f = h1[(pg * 4 + pp) * 64 + k]; acc[pp][0] += f * w.x; acc[pp][1] += f * w.y; acc[pp][2] += f * w.z; acc[pp][3] += f * w.w; }
      }
      const float4 fr = *(const float4*)(p.hy_sin_freq + l * 64 + 4 * jq);
#pragma unroll
      for (int pp = 0; pp < 4; pp++) {
        float* d = h2 + (pg * 4 + pp) * 65 + 4 * jq;
        d[0] = FSIN(fr.x * acc[pp][0]); d[1] = FSIN(fr.y * acc[pp][1]); d[2] = FSIN(fr.z * acc[pp][2]); d[3] = FSIN(fr.w * acc[pp][3]);
      }
    }
    __syncthreads();
    {
      const int pp = (wid & 1) * 64 + lane, ng = wid >> 1;
      float acc[32];
#pragma unroll
      for (int j = 0; j < 32; j++) acc[j] = 0.f;
#pragma unroll 2
      for (int k = 0; k < 64; k++) {
        const float hv = h2[pp * 65 + k];
        const float4* wr = (const float4*)(w3s + k * 128 + ng * 32);
#pragma unroll
        for (int j4 = 0; j4 < 8; j4++) { const float4 w = wr[j4]; acc[j4 * 4 + 0] += hv * w.x; acc[j4 * 4 + 1] += hv * w.y; acc[j4 * 4 + 2] += hv * w.z; acc[j4 * 4 + 3] += hv * w.w; }
      }
      const int pos = pos0 + pp;
      const float tn = (float)pos / (float)Lp;
      const float lo = logf(0.01f) / 1.5f, hi = logf(0.01f) / 0.3f;
      bf16_t* ftb = p.ft + (size_t)l * FT_L_ + (path ? FT_CTX_ : 0);
#pragma unroll
      for (int j = 0; j < 32; j++) {
        const int n = nblk * 128 + ng * 32 + j;
        const int ch = n & 255, fdir = n >> 9, ford = (n >> 8) & 1;
        const float delta = fabsf(lo + (hi - lo) * (float)ch / 255.f);
        const float v = (acc[j] + p.hy_f_b3[l * 1024 + n]) * (__expf(-tn * delta) + 0.05f);
        bf16_t* ftc = ftb + (size_t)((ford * 256 + ch) * 2) * 2 * Lp;
        if (fdir == 0 || pos > 0) {
          const int uu = fdir == 0 ? Lp - pos : Lp + pos;
          const bf16_t bv = f2bf(v);
          ftc[uu] = bv; ftc[2 * Lp + uu - 1] = bv;
        }
        if (fdir == 0 && pos == 0) { ftc[0] = 0; ftc[2 * Lp + 2 * Lp - 1] = 0; }
      }
    }
  }
}

__device__ __forceinline__ void phase_rowpass(PR p, int layer, int which, int bid, int nb) {
  const int lane = TIDX & 63, wid = TIDX >> 6;
  if (which == 0 && layer == 0 && nb * 8 * 3 == T) {
    f32x4 x[3][4];
#pragma unroll
    for (int k = 0; k < 3; k++) {
      const int row = bid * 24 + wid * 3 + k;
      const float* xs = row < TC ? p.x_prompt + (size_t)row * D : p.x_sample + (size_t)(row - TC) * D;
#pragma unroll
      for (int i = 0; i < 4; i++) x[k][i] = __builtin_nontemporal_load((const f32x4*)(xs + lane * 4 + 256 * i));
    }
    const float* gpre = p.norm_mix_pre;
    const auto rsH0 = __builtin_amdgcn_make_buffer_rsrc((void*)p.hbuf, 0, 0x7fffffff, 0x00020000);
#pragma unroll
    for (int k = 0; k < 3; k++) {
      const int row = bid * 24 + wid * 3 + k;
      const float* sh = p.mod + (size_t)row_mod(row) * 6144; const float* sc = sh + 1024;
      float ss = 0.f;
#pragma unroll
      for (int i = 0; i < 4; i++) { uint2 xb; xb.x = pack2(x[k][i][0], x[k][i][1]); xb.y = pack2(x[k][i][2], x[k][i][3]); *(uint2*)((bf16_t*)p.xbuf + (size_t)row * D + lane * 4 + 256 * i) = xb; ss += x[k][i][0] * x[k][i][0] + x[k][i][1] * x[k][i][1] + x[k][i][2] * x[k][i][2] + x[k][i][3] * x[k][i][3]; }
      ss = wave_sum(ss);
      const float rs = rsqrtf(ss * (1.f / 1024.f) + EPS);
#pragma unroll
      for (int i = 0; i < 4; i++) {
        const int e = lane * 4 + 256 * i;
        const float4 g = *(const float4*)(gpre + e), s1 = *(const float4*)(sc + e), s0 = *(const float4*)(sh + e);
        uint2 o;
        o.x = pack2(x[k][i][0] * rs * g.x * (1.f + s1.x) + s0.x, x[k][i][1] * rs * g.y * (1.f + s1.y) + s0.y);
        o.y = pack2(x[k][i][2] * rs * g.z * (1.f + s1.z) + s0.z, x[k][i][3] * rs * g.w * (1.f + s1.w) + s0.w);
        __builtin_amdgcn_raw_buffer_store_b64((u32x2){o.x, o.y}, rsH0, (unsigned)((row * D + e) * 2), 0, SEAMS ? 16 : 0);
      }
    }
    if (SEAMS) {
      asm volatile("s_waitcnt vmcnt(0)" ::: "memory");
      __syncthreads();
      if (TIDX == 0) __hip_atomic_store(p.bar + S0F_OFF + bid, 1u, __ATOMIC_RELAXED, __HIP_MEMORY_SCOPE_AGENT);
    }
    return;
  }
  for (int row = bid * 8 + wid; row < T; row += nb * 8) {
    const int mi = row_mod(row);
    const float* xs;
    const float* gate = nullptr; const float* gpost = nullptr;
    float* xd; bf16_t* hd = nullptr; const float *gpre = nullptr, *sc = nullptr, *sh = nullptr;
    bool has_raw;
    if (which == 0) {
      if (layer == 0) { xs = row < TC ? p.x_prompt + (size_t)row * D : p.x_sample + (size_t)(row - TC) * D; has_raw = false; }
      else { xs = p.x1buf + (size_t)row * D; has_raw = true; gate = p.mod + ((size_t)(layer - 1) * 3 + mi) * 6144 + 5 * 1024; gpost = p.norm_ffn_post + (layer - 1) * D; }
      if (layer < DEPTH) { xd = p.xbuf + (size_t)row * D; hd = p.hbuf + (size_t)row * D; gpre = p.norm_mix_pre + layer * D;
        sh = p.mod + ((size_t)layer * 3 + mi) * 6144; sc = sh + 1024; }
      else xd = p.out + (size_t)row * D;
    } else {
      xs = p.xbuf + (size_t)row * D; has_raw = true; gate = p.mod + ((size_t)layer * 3 + mi) * 6144 + 2 * 1024; gpost = p.norm_mix_post + layer * D;
      xd = p.x1buf + (size_t)row * D; hd = p.hbuf + (size_t)row * D; gpre = p.norm_ffn_pre + layer * D;
      sh = p.mod + ((size_t)layer * 3 + mi) * 6144 + 3 * 1024; sc = sh + 1024;
    }
    float4 x[4];
#pragma unroll
    for (int i = 0; i < 4; i++) x[i] = *(const float4*)(xs + lane * 4 + 256 * i);
    if (has_raw) {
      float4 r[4]; float ss = 0.f;
      const float* rp = p.raw + (size_t)row * D;
#pragma unroll
      for (int i = 0; i < 4; i++) { r[i] = *(const float4*)(rp + lane * 4 + 256 * i); ss += r[i].x * r[i].x + r[i].y * r[i].y + r[i].z * r[i].z + r[i].w * r[i].w; }
      ss = wave_sum(ss);
      float rs = rsqrtf(ss * (1.f / 1024.f) + EPS);
#pragma unroll
      for (int i = 0; i < 4; i++) {
        float4 g = *(const float4*)(gate + lane * 4 + 256 * i), gp = *(const float4*)(gpost + lane * 4 + 256 * i);
        x[i].x += g.x * gp.x * r[i].x * rs; x[i].y += g.y * gp.y * r[i].y * rs; x[i].z += g.z * gp.z * r[i].z * rs; x[i].w += g.w * gp.w * r[i].w * rs;
      }
    }
#pragma unroll
    for (int i = 0; i < 4; i++) {
      if (layer < DEPTH) { uint2 xb; xb.x = pack2(x[i].x, x[i].y); xb.y = pack2(x[i].z, x[i].w); *(uint2*)((bf16_t*)(xd - (size_t)row * D) + (size_t)row * D + lane * 4 + 256 * i) = xb; }
      else *(float4*)(xd + lane * 4 + 256 * i) = x[i];
    }
    if (hd) {
      float ss = 0.f;
#pragma unroll
      for (int i = 0; i < 4; i++) ss += x[i].x * x[i].x + x[i].y * x[i].y + x[i].z * x[i].z + x[i].w * x[i].w;
      ss = wave_sum(ss);
      float rs = rsqrtf(ss * (1.f / 1024.f) + EPS);
#pragma unroll
      for (int i = 0; i < 4; i++) {
        int e = lane * 4 + 256 * i;
        float4 g = *(const float4*)(gpre + e), s1 = *(const float4*)(sc + e), s0 = *(const float4*)(sh + e);
        float h0 = x[i].x * rs * g.x * (1.f + s1.x) + s0.x, h1 = x[i].y * rs * g.y * (1.f + s1.y) + s0.y;
        float h2 = x[i].z * rs * g.z * (1.f + s1.z) + s0.z, h3 = x[i].w * rs * g.w * (1.f + s1.w) + s0.w;
        uint2 o; o.x = pack2(h0, h1); o.y = pack2(h2, h3);
        *(uint2*)(hd + e) = o;
      }
    }
  }
}

__device__ __forceinline__ void seam_wait_up(const unsigned* upf, unsigned epoch, unsigned* tmo, int mlo, int mhi) {
  const int tid = TIDX;
  if (tid < 96) {
    const int m = mlo + (tid >> 5);
    if (m <= mhi) {
      const unsigned* f = upf + m * 32 + (tid & 31);
      for (unsigned spins = 0; __hip_atomic_load(f, __ATOMIC_RELAXED, __HIP_MEMORY_SCOPE_AGENT) < epoch;) {
        if (++spins > (1u << 20)) { __hip_atomic_store(tmo, 1u, __ATOMIC_RELAXED, __HIP_MEMORY_SCOPE_AGENT); break; }
        __builtin_amdgcn_s_sleep(1);
      }
    }
  }
  __syncthreads();
  if (tid == 0) { __builtin_amdgcn_fence(__ATOMIC_ACQUIRE, "agent"); asm volatile("s_waitcnt vmcnt(0)" ::: "memory"); }
  __syncthreads();
}
__device__ __forceinline__ void seam_poll(const unsigned* done, unsigned epoch, unsigned* tmo, int mtlo, int mthi) {
  const int tid = TIDX;
  if (tid < 24) {
    const int mt = mtlo + (tid >> 3);
    if (mt <= mthi) {
      const unsigned* f = done + (mt * 8 + (tid & 7)) * 16;
      for (unsigned spins = 0; __hip_atomic_load(f, __ATOMIC_RELAXED, __HIP_MEMORY_SCOPE_AGENT) < epoch;) {
        if (++spins > (1u << 20)) { __hip_atomic_store(tmo, 1u, __ATOMIC_RELAXED, __HIP_MEMORY_SCOPE_AGENT); break; }
        __builtin_amdgcn_s_sleep(1);
      }
    }
  }
}
__device__ __forceinline__ void seam_acquire() {
  __syncthreads();
  if (TIDX == 0) { __builtin_amdgcn_fence(__ATOMIC_ACQUIRE, "agent"); asm volatile("s_waitcnt vmcnt(0)" ::: "memory"); }
  __syncthreads();
}
__device__ __forceinline__ void seam_wait(const unsigned* done, unsigned epoch, unsigned* tmo, int mtlo, int mthi) { seam_poll(done, epoch, tmo, mtlo, mthi); seam_acquire(); }
struct EpiProj {
  bf16_t *proj, *ktr, *vtr, *ktm, *vtm, *hyt; float* gates;
  const unsigned* done; unsigned epoch; unsigned* tmo;
  const unsigned* s0f;
  __device__ __forceinline__ void operator()(int row, int col, f32x4 v) const {
    if (col >= INW) return;
    uint2 o; o.x = pack2(v[0], v[1]); o.y = pack2(v[2], v[3]);
    *(uint2*)(proj + (size_t)row * INW + col) = o;
    bf16_t* tp = nullptr; int tc = 0;
    if (col >= 384 && col < 768) { tp = ktr; tc = col - 384; }
    else if (col >= 768 && col < 1152) { tp = vtr; tc = col - 768; }
    else if (col >= 1536 && col < 2304) { tp = hyt; tc = col - 1536; }
    else if (col >= 2688 && col < 3072) { tp = ktm; tc = col - 2688; }
    else if (col >= 3072 && col < 3456) { tp = vtm; tc = col - 3072; }
    if (tp) {
#pragma unroll
      for (int r = 0; r < 4; r++) tp[(size_t)(tc + r) * T + row] = f2bf(v[r]);
    }
    if (col >= 3840) *(float4*)(gates + (size_t)row * 16 + (col - 3840)) = make_float4(v[0], v[1], v[2], v[3]);
  }
};
struct EpiF32 {
  float* out; int ld;
  __device__ __forceinline__ void operator()(int row, int col, f32x4 v) const {
    *(float4*)(out + (size_t)row * ld + col) = make_float4(v[0], v[1], v[2], v[3]);
  }
};
struct EpiRow {
  const bf16_t* x; void* xo; bool xo32; bf16_t* ho;
  const float* modl; int goff; const float* gpost;
  const float* modn; int shoff; const float* gpre;
  unsigned* done;
  const unsigned* upf; unsigned upepoch;
  unsigned long long* gran; unsigned epoch; unsigned* tmo;
  __device__ __forceinline__ void operator()(int, int, f32x4) const {}
};
template <class E> struct epi_proj { static constexpr bool value = false; };
template <> struct epi_proj<EpiProj> { static constexpr bool value = true; };
template <class E> struct epi_row { static constexpr bool value = false; };
template <> struct epi_row<EpiRow> { static constexpr bool value = true; };
struct EpiUp {
  static constexpr bool kFused = true;
  const unsigned* done; unsigned epoch; unsigned* tmo;
  unsigned* upf; unsigned upepoch;
  bf16_t* u; const bf16_t* h; const bf16_t* wt; const float* cw; const float* cb;
  __device__ __forceinline__ void operator()(int, int, f32x4) const {}
};
template <class E> struct epi_fused { static constexpr bool value = false; };
template <> struct epi_fused<EpiUp> { static constexpr bool value = true; };

typedef float f32x2 __attribute__((ext_vector_type(2)));
typedef __bf16 bf16x2_t __attribute__((ext_vector_type(2)));
#ifndef WT_AUX
#define WT_AUX 16
#endif
template <int BM, int BN, int GL, class Epi>
__device__ __forceinline__ void gemm_tiles(const bf16_t* __restrict__ A, const bf16_t* __restrict__ Bt, int M, int N, int K, int bid, int nb, char* smem, const Epi& epi) {
  constexpr int MT = BM / 64, NTW = BN / 32;
  constexpr int ACH = BM * 8 / NT, BCH = BN * 8 / NT;
  constexpr int ABYTES = BM * 128, BBYTES = BN * 128, STAGE = ABYTES + BBYTES;
  const int nm = M / BM, nn = N / BN;
  const int tid = TIDX, lane = tid & 63, wid = tid >> 6;
  const int wm = wid >> 1, wn = wid & 1;
  const int lr = lane & 15, lg = lane >> 4;
  u32x4 ra[ACH], rb[BCH];
  const unsigned voff = (unsigned)(((tid >> 3) * K + (tid & 7) * 8) * 2);
  const unsigned soff = (unsigned)((tid >> 3) * 128 + (((tid & 7) ^ ((tid >> 3) & 7)) << 4));
#define GLOAD(Ab, Bb) { \
    _Pragma("unroll") for (int i = 0; i < ACH; i++) ra[i] = *(const u32x4*)((const char*)((Ab) + (size_t)i * 64 * K) + voff); \
    _Pragma("unroll") for (int i = 0; i < BCH; i++) rb[i] = *(const u32x4*)((const char*)((Bb) + (size_t)i * 64 * K) + voff); }
#define SWRITE(buf) { char* sa_ = smem + (buf) * STAGE + soff; char* sb_ = sa_ + ABYTES; \
    _Pragma("unroll") for (int i = 0; i < ACH; i++) *(u32x4*)(sa_ + i * 8192) = ra[i]; \
    _Pragma("unroll") for (int i = 0; i < BCH; i++) *(u32x4*)(sb_ + i * 8192) = rb[i]; }
  const unsigned goff = (unsigned)(((tid >> 3) * K + (((tid & 7) ^ ((tid >> 3) & 7)) * 8)) * 2);
  const int wu = __builtin_amdgcn_readfirstlane(wid);
#define GLDS(buf, Ab, Bb) { \
    _Pragma("unroll") for (int i = 0; i < ACH; i++) __builtin_amdgcn_global_load_lds((const unsigned*)((const char*)((Ab) + (size_t)i * 64 * K) + goff), (LAS unsigned*)(smem + (buf) * STAGE + i * 8192 + wu * 1024), 16, 0, 0); \
    _Pragma("unroll") for (int i = 0; i < BCH; i++) __builtin_amdgcn_global_load_lds((const unsigned*)((const char*)((Bb) + (size_t)i * 64 * K) + goff), (LAS unsigned*)(smem + (buf) * STAGE + ABYTES + i * 8192 + wu * 1024), 16, 0, 0); }
#define GWAIT() { asm volatile("s_waitcnt vmcnt(0)" ::: "memory"); __syncthreads(); }
  const unsigned lds0 = (unsigned)(uintptr_t)(LAS char*)smem;
  const unsigned offA0 = (unsigned)((wm * (BM / 4) + lr) * 128 + ((lg ^ (lr & 7)) << 4));
  const unsigned offB0 = (unsigned)(ABYTES + (wn * (BN / 2) + lr) * 128 + ((lg ^ (lr & 7)) << 4));
  unsigned offAp[epi_proj<Epi>::value ? MT : 1];
  if constexpr (epi_proj<Epi>::value) {
#pragma unroll
    for (int mi = 0; mi < MT; mi++) { const int rp = wm * (BM / 4) + (lr >> 1) * 6 + mi * 2 + (lr & 1); offAp[mi] = (unsigned)(rp * 128 + ((lg ^ (rp & 7)) << 4)); }
  }
  const int grp = bid & 7, jg = bid >> 3, ng = (nb + 7 - grp) >> 3;
  const int mpg = nm >> 3, tpg = mpg * nn;
  if (jg >= tpg) return;
#define TILE_M0(q) ((grp * mpg + (q) % mpg) * BM)
#define TILE_N0(q) (((q) / mpg) * BN)
  {
    const bf16_t* Ab = A + (size_t)TILE_M0(jg) * K; const bf16_t* Bb = Bt + (size_t)TILE_N0(jg) * K;
    if constexpr (GL == 2) {
    } else if constexpr (GL == 1) {
      if constexpr (epi_proj<Epi>::value) {
        if (epi.done) { const int mt_ = grp * mpg + jg % mpg; seam_wait(epi.done, epi.epoch, epi.tmo, mt_, mt_); }
        if (epi.s0f) {
          const int mt_ = grp * mpg + jg % mpg;
          if (tid < 8) {
            const unsigned* f = epi.s0f + mt_ * 8 + tid;
            for (unsigned spins = 0; __hip_atomic_load(f, __ATOMIC_RELAXED, __HIP_MEMORY_SCOPE_AGENT) < 1u;) {
              if (++spins > (1u << 20)) { __hip_atomic_store(epi.tmo, 1u, __ATOMIC_RELAXED, __HIP_MEMORY_SCOPE_AGENT); break; }
              __builtin_amdgcn_s_sleep(1);
            }
          }
          seam_acquire();
        }
      }
      __syncthreads();
      GLDS(0, Ab, Bb);
      GWAIT();
    } else {
      GLOAD(Ab, Bb);
      __syncthreads();
      SWRITE(0);
      GLOAD(Ab + 64, Bb + 64);
      __syncthreads();
    }
  }
  const int nk = K / 64;
  for (int q = jg; q < tpg; q += ng) {
    const int m0 = TILE_M0(q), n0 = TILE_N0(q);
    const int q2 = q + ng; const bool hn = q2 < tpg;
    const bf16_t* Ab = A + (size_t)m0 * K;
    const bf16_t* Bb = Bt + (size_t)n0 * K;
    const bf16_t* Abn = hn ? A + (size_t)TILE_M0(q2) * K : Ab;
    const bf16_t* Bbn = hn ? Bt + (size_t)TILE_N0(q2) * K : Bb;
    f32x4 acc[MT][NTW];
#pragma unroll
    for (int i = 0; i < MT; i++)
#pragma unroll
      for (int j = 0; j < NTW; j++) acc[i][j] = zero4();
    static_assert(MT == 3 && (NTW == 8 || NTW == 4), "fragment wait operand lists");
#define DSR128(dst, addr, off) asm volatile("ds_read_b128 %0, %1 offset:%2" : "=v"(dst) : "v"(addr), "n"(off) : "memory")
    auto compute = [&](int buf) {
      const unsigned sa = lds0 + (unsigned)(buf * STAGE);
      bf16x8 af[2][MT], bfr[2][NTW];
#pragma unroll
      for (int ks = 0; ks < 2; ks++) {
        if constexpr (epi_proj<Epi>::value) {
          const unsigned a0 = sa + (offAp[0] ^ (ks << 6)), a1 = sa + (offAp[1] ^ (ks << 6)), a2 = sa + (offAp[2] ^ (ks << 6));
          DSR128(af[ks][0], a0, 0); DSR128(af[ks][1], a1, 0); DSR128(af[ks][2], a2, 0);
        } else {
          const unsigned a0 = sa + (offA0 ^ (ks << 6));
          DSR128(af[ks][0], a0, 0); DSR128(af[ks][1], a0, 2048); DSR128(af[ks][2], a0, 4096);
        }
        const unsigned b0 = sa + (offB0 ^ (ks << 6));
        DSR128(bfr[ks][0], b0, 0); DSR128(bfr[ks][1], b0, 2048); DSR128(bfr[ks][2], b0, 4096); DSR128(bfr[ks][3], b0, 6144);
        if constexpr (NTW == 8) { DSR128(bfr[ks][4], b0, 8192); DSR128(bfr[ks][5], b0, 10240); DSR128(bfr[ks][6], b0, 12288); DSR128(bfr[ks][7], b0, 14336); }
      }
      __builtin_amdgcn_sched_barrier(0);
#pragma unroll
      for (int ks = 0; ks < 2; ks++) {
        if constexpr (NTW == 8) {
          if (ks == 0) asm volatile("s_waitcnt lgkmcnt(11)" : "+v"(af[0][0]), "+v"(af[0][1]), "+v"(af[0][2]), "+v"(bfr[0][0]), "+v"(bfr[0][1]), "+v"(bfr[0][2]), "+v"(bfr[0][3]), "+v"(bfr[0][4]), "+v"(bfr[0][5]), "+v"(bfr[0][6]), "+v"(bfr[0][7]) :: "memory");
          else asm volatile("s_waitcnt lgkmcnt(0)" : "+v"(af[1][0]), "+v"(af[1][1]), "+v"(af[1][2]), "+v"(bfr[1][0]), "+v"(bfr[1][1]), "+v"(bfr[1][2]), "+v"(bfr[1][3]), "+v"(bfr[1][4]), "+v"(bfr[1][5]), "+v"(bfr[1][6]), "+v"(bfr[1][7]) :: "memory");
        } else {
          if (ks == 0) asm volatile("s_waitcnt lgkmcnt(7)" : "+v"(af[0][0]), "+v"(af[0][1]), "+v"(af[0][2]), "+v"(bfr[0][0]), "+v"(bfr[0][1]), "+v"(bfr[0][2]), "+v"(bfr[0][3]) :: "memory");
          else asm volatile("s_waitcnt lgkmcnt(0)" : "+v"(af[1][0]), "+v"(af[1][1]), "+v"(af[1][2]), "+v"(bfr[1][0]), "+v"(bfr[1][1]), "+v"(bfr[1][2]), "+v"(bfr[1][3]) :: "memory");
        }
        __builtin_amdgcn_sched_barrier(0);
#pragma unroll
        for (int ni = 0; ni < NTW; ni++)
#pragma unroll
          for (int mi = 0; mi < MT; mi++) acc[mi][ni] = __builtin_amdgcn_mfma_f32_16x16x32_bf16(bfr[ks][ni], af[ks][mi], acc[mi][ni], 0, 0, 0);
        __builtin_amdgcn_sched_barrier(0);
      }
    };
#undef DSR128
    u32x4 xl[epi_row<Epi>::value ? MT : 1][epi_row<Epi>::value ? NTW / 2 : 1];
    float* tabG = (float*)(smem + 3 * STAGE); float* tabP = tabG + 384; float* tabS = tabP + 384;
    if constexpr (epi_row<Epi>::value) {
      static_assert(3 * STAGE + 3 * 384 * 4 <= SMEM_BYTES - 64, "row tables");
      if (tid < 384) {
        const int v = tid >> 7, col = n0 + (tid & 127);
        tabG[tid] = epi.modl[v * 6144 + epi.goff + col] * epi.gpost[col];
        if (epi.ho) { tabP[tid] = epi.gpre[col] * (1.f + epi.modn[v * 6144 + epi.shoff + 1024 + col]); tabS[tid] = epi.modn[v * 6144 + epi.shoff + col]; }
      }
    }
    auto row_preload = [&]() {
      if constexpr (epi_row<Epi>::value) {
#pragma unroll
        for (int mi = 0; mi < MT; mi++) {
          const int row = m0 + wm * 48 + mi * 16 + lr;
#pragma unroll
          for (int np = 0; np < NTW / 2; np++)
            xl[mi][np] = __builtin_amdgcn_raw_buffer_load_b128(__builtin_amdgcn_make_buffer_rsrc((void*)epi.x, 0, 0x7fffffff, 0x00020000),
                                                               (unsigned)(((wm * 48 + lr) * D + wn * 64 + (lg & 1) * 16 + (lg >> 1) * 8) * 2), ((m0 + mi * 16) * D + n0 + np * 32) * 2, 2);
        }
      }
    };
    if constexpr (GL != 2) row_preload();
    if constexpr (GL == 2) {
      static_assert(3 * STAGE <= SMEM_BYTES - 64, "ring");
      constexpr int PL = ACH + BCH;
      if (epi.upf) { const int rlo_ = m0 > 0 ? m0 - 1 : 0, rhi_ = m0 + BM < M ? m0 + BM : M - 1; seam_wait_up(epi.upf, epi.upepoch, epi.tmo, rlo_ >> 8, rhi_ >> 8); }
      __syncthreads();
      GLDS(0, Ab, Bb);
      GLDS(1, Ab + 64, Bb + 64);
      asm volatile("s_waitcnt vmcnt(%0)" :: "n"(PL) : "memory");
      __builtin_amdgcn_s_barrier();
      static_assert(NTW == 4 && MT == 3, "ring fragment sets");
      bf16x8 fA0[MT], fB0[NTW], fA1[MT], fB1[NTW];
#define DSR128(dst, addr, off) asm volatile("ds_read_b128 %0, %1 offset:%2" : "=v"(dst) : "v"(addr), "n"(off) : "memory")
#define FWAIT(n, A, B) asm volatile("s_waitcnt lgkmcnt(" #n ")" : "+v"(A[0]), "+v"(A[1]), "+v"(A[2]), "+v"(B[0]), "+v"(B[1]), "+v"(B[2]), "+v"(B[3]) :: "memory")
#define FRD1(i, a0, b0, A, B) do { if ((i) < 3) DSR128(A[(i) < 3 ? (i) : 0], a0, ((i) < 3 ? (i) : 0) * 2048); else DSR128(B[(i) >= 3 ? (i) - 3 : 0], b0, ((i) >= 3 ? (i) - 3 : 0) * 2048); } while (0)
#define MFM(j, A, B) acc[(j) % 3][(j) / 3] = __builtin_amdgcn_mfma_f32_16x16x32_bf16(B[(j) / 3], A[(j) % 3], acc[(j) % 3][(j) / 3], 0, 0, 0)
#define PIN __builtin_amdgcn_sched_barrier(0)
      const auto rsAd = __builtin_amdgcn_make_buffer_rsrc((void*)A, 0, 0x7fffffff, 0x00020000);
      const auto rsBd = __builtin_amdgcn_make_buffer_rsrc((void*)Bt, 0, 0x7fffffff, 0x00020000);
      auto dma1 = [&](int i, int buf, int kcol) {
        if (i < ACH) __builtin_amdgcn_raw_ptr_buffer_load_lds(rsAd, (LAS void*)(smem + buf * STAGE + i * 8192 + wu * 1024), 16, goff, ((m0 + i * 64) * K + kcol) * 2, 0, 0);
        else __builtin_amdgcn_raw_ptr_buffer_load_lds(rsBd, (LAS void*)(smem + buf * STAGE + ABYTES + (i - ACH) * 8192 + wu * 1024), 16, goff, ((n0 + (i - ACH) * 64) * K + kcol) * 2, 0, 0);
      };
      static_assert(PL == 5, "DMA pieces per K-tile");
      int cur = 0;
      const int kpre = nk > 8 ? nk - 8 : 0;
      GLDS(2, Ab + 128, Bb + 128);
      { const unsigned a0 = lds0 + offA0, b0 = lds0 + offB0;
        FRD1(0, a0, b0, fA0, fB0); FRD1(1, a0, b0, fA0, fB0); FRD1(2, a0, b0, fA0, fB0); FRD1(3, a0, b0, fA0, fB0); FRD1(4, a0, b0, fA0, fB0); FRD1(5, a0, b0, fA0, fB0); FRD1(6, a0, b0, fA0, fB0); }
#pragma unroll 1
      for (int kt = 0; kt < nk; kt++) {
        FWAIT(0, fA0, fB0);
        PIN;
        {
          const unsigned a0 = lds0 + (unsigned)(cur * STAGE) + (offA0 ^ 64u), b0 = lds0 + (unsigned)(cur * STAGE) + (offB0 ^ 64u);
          MFM(0, fA0, fB0); PIN; FRD1(0, a0, b0, fA1, fB1); PIN; MFM(1, fA0, fB0); PIN; FRD1(1, a0, b0, fA1, fB1); PIN; MFM(2, fA0, fB0); PIN; FRD1(2, a0, b0, fA1, fB1); PIN;
          MFM(3, fA0, fB0); PIN; FRD1(3, a0, b0, fA1, fB1); PIN; MFM(4, fA0, fB0); PIN; FRD1(4, a0, b0, fA1, fB1); PIN; MFM(5, fA0, fB0); PIN; FRD1(5, a0, b0, fA1, fB1); PIN;
          MFM(6, fA0, fB0); PIN; FRD1(6, a0, b0, fA1, fB1); PIN; MFM(7, fA0, fB0); MFM(8, fA0, fB0); MFM(9, fA0, fB0); MFM(10, fA0, fB0); MFM(11, fA0, fB0); PIN; }
        FWAIT(0, fA1, fB1);
        if (kt + 1 < nk) {
          if (kt + 2 < nk) asm volatile("s_waitcnt vmcnt(%0)" :: "n"(PL) : "memory");
          else asm volatile("s_waitcnt vmcnt(0)" ::: "memory");
          __builtin_amdgcn_s_barrier();
          const int nxt = cur == 2 ? 0 : cur + 1;
          if (kt == kpre) row_preload();
          const bool dm = kt + 3 < nk;
          const int kc3 = (kt + 3) * 64;
          const unsigned a0 = lds0 + (unsigned)(nxt * STAGE) + offA0, b0 = lds0 + (unsigned)(nxt * STAGE) + offB0;
          PIN;
          MFM(0, fA1, fB1); PIN; if (dm) dma1(0, cur, kc3); PIN; MFM(1, fA1, fB1); PIN; if (dm) dma1(1, cur, kc3); PIN; MFM(2, fA1, fB1); PIN; if (dm) dma1(2, cur, kc3); PIN;
          MFM(3, fA1, fB1); PIN; if (dm) dma1(3, cur, kc3); PIN; MFM(4, fA1, fB1); PIN; if (dm) dma1(4, cur, kc3); PIN;
          MFM(5, fA1, fB1); PIN; FRD1(0, a0, b0, fA0, fB0); PIN; MFM(6, fA1, fB1); PIN; FRD1(1, a0, b0, fA0, fB0); PIN; MFM(7, fA1, fB1); PIN; FRD1(2, a0, b0, fA0, fB0); PIN;
          MFM(8, fA1, fB1); PIN; FRD1(3, a0, b0, fA0, fB0); PIN; MFM(9, fA1, fB1); PIN; FRD1(4, a0, b0, fA0, fB0); PIN; MFM(10, fA1, fB1); PIN; FRD1(5, a0, b0, fA0, fB0); PIN;
          MFM(11, fA1, fB1); PIN; FRD1(6, a0, b0, fA0, fB0); PIN;
          cur = nxt;
        } else {
          __builtin_amdgcn_s_barrier();
          PIN;
          MFM(0, fA1, fB1); MFM(1, fA1, fB1); MFM(2, fA1, fB1); MFM(3, fA1, fB1); MFM(4, fA1, fB1); MFM(5, fA1, fB1);
          MFM(6, fA1, fB1); MFM(7, fA1, fB1); MFM(8, fA1, fB1); MFM(9, fA1, fB1); MFM(10, fA1, fB1); MFM(11, fA1, fB1); PIN;
        }
      }
#undef FRD1
#undef MFM
#undef PIN
#undef DSR128
#undef FWAIT
    } else if constexpr (GL == 1) {
      for (int kt = 0; kt < nk; kt += 2) {
        GLDS(1, Ab + (kt + 1) * 64, Bb + (kt + 1) * 64);
        __builtin_amdgcn_sched_barrier(0);
        compute(0);
        __builtin_amdgcn_sched_barrier(0);
        GWAIT();
        { const bool in = kt + 2 < nk; GLDS(0, in ? Ab + (kt + 2) * 64 : Abn, in ? Bb + (kt + 2) * 64 : Bbn); }
        __builtin_amdgcn_sched_barrier(0);
        compute(1);
        __builtin_amdgcn_sched_barrier(0);
        GWAIT();
      }
    } else
    for (int kt = 0; kt < nk; kt += 2) {
      SWRITE(1);
      { const bool in = kt + 2 < nk; GLOAD(in ? Ab + (kt + 2) * 64 : Abn, in ? Bb + (kt + 2) * 64 : Bbn); }
      __builtin_amdgcn_sched_barrier(0);
      compute(0);
      __builtin_amdgcn_sched_barrier(0);
      __syncthreads();
      SWRITE(0);
      { const bool in = kt + 3 < nk; GLOAD(in ? Ab + (kt + 3) * 64 : Abn + 64, in ? Bb + (kt + 3) * 64 : Bbn + 64); }
      __builtin_amdgcn_sched_barrier(0);
      compute(1);
      __builtin_amdgcn_sched_barrier(0);
      __syncthreads();
    }
    if constexpr (epi_row<Epi>::value) {
      static_assert(BM == 192 && BN == 128, "row-fused epilogue geometry");
      float* sst = (float*)(smem + STAGE);
      float* srr = sst + 2 * 192 * 4;
      const int mt = m0 / 192, ntile = n0 >> 7;
#pragma unroll
      for (int mi = 0; mi < MT; mi++) {
        const int mrow = row_mod(m0 + wm * 48 + mi * 16 + lr);
        float sA = 0.f, sB = 0.f, sC = 0.f, sD = 0.f;
#pragma unroll
        for (int np = 0; np < NTW / 2; np++) {
          const auto q0 = __builtin_amdgcn_permlane16_swap(xl[mi][np][0], xl[mi][np][2], false, false);
          const auto q1 = __builtin_amdgcn_permlane16_swap(xl[mi][np][1], xl[mi][np][3], false, false);
          xl[mi][np] = (u32x4){q0[0], q1[0], q0[1], q1[1]};
        }
#pragma unroll
        for (int ni = 0; ni < NTW; ni++) {
          const float xf[4] = {bflo(xl[mi][ni >> 1][(ni & 1) * 2]), bfhi(xl[mi][ni >> 1][(ni & 1) * 2]), bflo(xl[mi][ni >> 1][(ni & 1) * 2 + 1]), bfhi(xl[mi][ni >> 1][(ni & 1) * 2 + 1])};
          const float4 g4 = *(const float4*)(tabG + mrow * 128 + wn * 64 + ni * 16 + lg * 4);
          const float gg[4] = {g4.x, g4.y, g4.z, g4.w};
#pragma unroll
          for (int r = 0; r < 4; r++) {
            const float raw = acc[mi][ni][r], gr = gg[r] * raw, xx = xf[r];
            sA += raw * raw; sB += xx * gr; sC += gr * gr; sD += xx * xx;
          }
        }
        sA += __shfl_xor(sA, 16); sA += __shfl_xor(sA, 32); sB += __shfl_xor(sB, 16); sB += __shfl_xor(sB, 32);
        sC += __shfl_xor(sC, 16); sC += __shfl_xor(sC, 32); sD += __shfl_xor(sD, 16); sD += __shfl_xor(sD, 32);
        if (lg == 0) *(float4*)(sst + (wn * 192 + wm * 48 + mi * 16 + lr) * 4) = make_float4(sA, sB, sC, sD);
      }
      __syncthreads();
      if (tid < 192) {
        unsigned long long* gbase = epi.gran + (size_t)mt * 8 * 4 * 192 + tid;
        const unsigned long long tag = (unsigned long long)epi.epoch << 32;
        {
          const float4 a = *(const float4*)(sst + tid * 4), b = *(const float4*)(sst + (192 + tid) * 4);
          unsigned long long* g = gbase + (size_t)ntile * 4 * 192;
          __hip_atomic_store(g + 0 * 192, tag | __float_as_uint(a.x + b.x), __ATOMIC_RELAXED, __HIP_MEMORY_SCOPE_AGENT);
          __hip_atomic_store(g + 1 * 192, tag | __float_as_uint(a.y + b.y), __ATOMIC_RELAXED, __HIP_MEMORY_SCOPE_AGENT);
          __hip_atomic_store(g + 2 * 192, tag | __float_as_uint(a.z + b.z), __ATOMIC_RELAXED, __HIP_MEMORY_SCOPE_AGENT);
          __hip_atomic_store(g + 3 * 192, tag | __float_as_uint(a.w + b.w), __ATOMIC_RELAXED, __HIP_MEMORY_SCOPE_AGENT);
        }
        float tA = 0.f, tB = 0.f, tC = 0.f, tD = 0.f;
        for (unsigned spins = 0;;) {
          bool ok = true; float q0 = 0.f, q1 = 0.f, q2 = 0.f, q3 = 0.f;
#pragma unroll 2
          for (int t = 0; t < 8; t++) {
            const unsigned long long w0 = __hip_atomic_load(gbase + (size_t)(t * 4 + 0) * 192, __ATOMIC_RELAXED, __HIP_MEMORY_SCOPE_AGENT);
            const unsigned long long w1 = __hip_atomic_load(gbase + (size_t)(t * 4 + 1) * 192, __ATOMIC_RELAXED, __HIP_MEMORY_SCOPE_AGENT);
            const unsigned long long w2 = __hip_atomic_load(gbase + (size_t)(t * 4 + 2) * 192, __ATOMIC_RELAXED, __HIP_MEMORY_SCOPE_AGENT);
            const unsigned long long w3 = __hip_atomic_load(gbase + (size_t)(t * 4 + 3) * 192, __ATOMIC_RELAXED, __HIP_MEMORY_SCOPE_AGENT);
            ok = ok && (unsigned)(w0 >> 32) == epi.epoch && (unsigned)(w1 >> 32) == epi.epoch && (unsigned)(w2 >> 32) == epi.epoch && (unsigned)(w3 >> 32) == epi.epoch;
            q0 += __uint_as_float((unsigned)w0); q1 += __uint_as_float((unsigned)w1); q2 += __uint_as_float((unsigned)w2); q3 += __uint_as_float((unsigned)w3);
          }
          if (ok) { tA = q0; tB = q1; tC = q2; tD = q3; break; }
          if (++spins > (1u << 18)) { __hip_atomic_store(epi.tmo, 1u, __ATOMIC_RELAXED, __HIP_MEMORY_SCOPE_AGENT); break; }
          __builtin_amdgcn_s_sleep(1);
        }
        const float r1 = rsqrtf(tA * (1.f / 1024.f) + EPS);
        const float ss = tD + 2.f * r1 * tB + r1 * r1 * tC;
        srr[tid * 2] = r1; srr[tid * 2 + 1] = rsqrtf(fmaxf(ss, 0.f) * (1.f / 1024.f) + EPS);
      }
      __syncthreads();
      const auto rsXo = __builtin_amdgcn_make_buffer_rsrc((void*)epi.xo, 0, 0x7fffffff, 0x00020000);
      const auto rsHo = __builtin_amdgcn_make_buffer_rsrc((void*)epi.ho, 0, 0x7fffffff, 0x00020000);
#pragma unroll
      for (int mi = 0; mi < MT; mi++) {
        const int rl = wm * 48 + mi * 16 + lr, row = m0 + rl;
        const int mrow = row_mod(row);
        const float r1 = srr[rl * 2], r2 = srr[rl * 2 + 1];
        unsigned hw[NTW][2], xw[NTW][2];
#pragma unroll
        for (int ni = 0; ni < NTW; ni++) {
          const int cl = wn * 64 + ni * 16 + lg * 4, col = n0 + cl;
          const float4 g4 = *(const float4*)(tabG + mrow * 128 + cl);
          const float gg[4] = {g4.x, g4.y, g4.z, g4.w};
          const float xf[4] = {bflo(xl[mi][ni >> 1][(ni & 1) * 2]), bfhi(xl[mi][ni >> 1][(ni & 1) * 2]), bflo(xl[mi][ni >> 1][(ni & 1) * 2 + 1]), bfhi(xl[mi][ni >> 1][(ni & 1) * 2 + 1])};
          f32x4 xo;
#pragma unroll
          for (int r = 0; r < 4; r++) xo[r] = xf[r] + gg[r] * acc[mi][ni][r] * r1;
          if (epi.xo32) __builtin_amdgcn_raw_buffer_store_b128((u32x4){__float_as_uint(xo[0]), __float_as_uint(xo[1]), __float_as_uint(xo[2]), __float_as_uint(xo[3])}, rsXo, (unsigned)((row * D + col) * 4), 0, WT_AUX);
          else { xw[ni][0] = pack2(xo[0], xo[1]); xw[ni][1] = pack2(xo[2], xo[3]); }
          if (epi.ho) {
            const float4 pp = *(const float4*)(tabP + mrow * 128 + cl), s0 = *(const float4*)(tabS + mrow * 128 + cl);
            hw[ni][0] = pack2(xo[0] * r2 * pp.x + s0.x, xo[1] * r2 * pp.y + s0.y);
            hw[ni][1] = pack2(xo[2] * r2 * pp.z + s0.z, xo[3] * r2 * pp.w + s0.w);
          }
        }
        if (!epi.xo32) {
#pragma unroll
          for (int np = 0; np < NTW / 2; np++) {
            const auto q0 = __builtin_amdgcn_permlane16_swap(xw[2 * np][0], xw[2 * np + 1][0], false, false);
            const auto q1 = __builtin_amdgcn_permlane16_swap(xw[2 * np][1], xw[2 * np + 1][1], false, false);
            __builtin_amdgcn_raw_buffer_store_b128((u32x4){q0[0], q1[0], q0[1], q1[1]}, rsXo, (unsigned)((row * D + n0 + wn * 64 + np * 32 + (lg & 1) * 16 + (lg >> 1) * 8) * 2), 0, WT_AUX);
          }
        }
        if (epi.ho) {
#pragma unroll
          for (int np = 0; np < NTW / 2; np++) {
            const auto q0 = __builtin_amdgcn_permlane16_swap(hw[2 * np][0], hw[2 * np + 1][0], false, false);
            const auto q1 = __builtin_amdgcn_permlane16_swap(hw[2 * np][1], hw[2 * np + 1][1], false, false);
            __builtin_amdgcn_raw_buffer_store_b128((u32x4){q0[0], q1[0], q0[1], q1[1]}, rsHo, (unsigned)((row * D + n0 + wn * 64 + np * 32 + (lg & 1) * 16 + (lg >> 1) * 8) * 2), 0, WT_AUX);
          }
        }
      }
      if (epi.done) {
        asm volatile("s_waitcnt vmcnt(0)" ::: "memory");
        __syncthreads();
        if (tid == 0) __hip_atomic_store(epi.done + (mt * 8 + ntile) * 16, epi.epoch, __ATOMIC_RELAXED, __HIP_MEMORY_SCOPE_AGENT);
      }
    } else
    if constexpr (epi_fused<Epi>::value) {
     constexpr int UP_LA = STAGE, UP_LB = UP_LA + 258 * 144;
     static_assert(UP_LB + 256 * 144 <= SMEM_BYTES - 32, "fused epilogue images");
#pragma unroll
     for (int ph = 0; ph < NTW / 4; ph++) {
      {
        char* base = smem + (wn == 0 ? UP_LA + 144 : UP_LB);
#pragma unroll
        for (int mi = 0; mi < MT; mi++)
#pragma unroll
          for (int ni = 0; ni < 4; ni++) {
            const int r = wm * (BM / 4) + mi * 16 + lr, cidx = ni * 16 + lg * 4;
            uint2 o; o.x = pack2(acc[mi][ph * 4 + ni][0], acc[mi][ph * 4 + ni][1]); o.y = pack2(acc[mi][ph * 4 + ni][2], acc[mi][ph * 4 + ni][3]);
            *(uint2*)(base + r * 144 + cidx * 2) = o;
          }
      }
      {
        const int pos0 = m0 >= TC ? ((m0 - TC) & 1023) : 0;
        const bool top = m0 >= TC && pos0 != 0, bot = m0 >= TC && pos0 + BM != 1024;
        if (top || bot) {
          unsigned z0_ = 0u; asm volatile("" : "+v"(z0_)); uint4 ht0 = make_uint4(z0_, z0_, z0_, z0_), ht1 = ht0, hb0 = ht0, hb1 = ht0;
          if (top) { const bf16_t* hr = epi.h + (size_t)(m0 - 1) * K + lane * 8; ht0 = *(const uint4*)hr; ht1 = *(const uint4*)(hr + 512); }
          if (bot) { const bf16_t* hr = epi.h + (size_t)(m0 + BM) * K + lane * 8; hb0 = *(const uint4*)hr; hb1 = *(const uint4*)(hr + 512); }
#define DOT8(a, b) (bflo(a.x) * bflo(b.x) + bfhi(a.x) * bfhi(b.x) + bflo(a.y) * bflo(b.y) + bfhi(a.y) * bfhi(b.y) + bflo(a.z) * bflo(b.z) + bfhi(a.z) * bfhi(b.z) + bflo(a.w) * bflo(b.w) + bfhi(a.w) * bfhi(b.w))
#pragma unroll 1
          for (int fb = 0; fb < 2; fb++) {
            uint4 w0[4], w1[4];
#pragma unroll
            for (int fi = 0; fi < 4; fi++) { const bf16_t* wr = epi.wt + (size_t)(n0 + ph * 64 + wid * 8 + fb * 4 + fi) * K + lane * 8; w0[fi] = *(const uint4*)wr; w1[fi] = *(const uint4*)(wr + 512); }
#pragma unroll
            for (int fi = 0; fi < 4; fi++) {
              float st = DOT8(ht0, w0[fi]) + DOT8(ht1, w1[fi]), sb = DOT8(hb0, w0[fi]) + DOT8(hb1, w1[fi]);
              st = wave_sum(st); sb = wave_sum(sb);
              const int f = wid * 8 + fb * 4 + fi;
              if (lane == 0) { *(bf16_t*)(smem + UP_LA + f * 2) = f2bf(st); *(bf16_t*)(smem + UP_LA + 257 * 144 + f * 2) = f2bf(sb); }
            }
          }
#undef DOT8
        } else if (tid < 128) {
          *(bf16_t*)(smem + UP_LA + (tid >> 6) * 257 * 144 + (tid & 63) * 2) = 0;
        }
      }
      __syncthreads();
      {
        const int fc = tid & 7, f0 = (n0 >> 1) + ph * 64 + fc * 8;
        float w0[8], w1[8], w2[8], bb[8];
        {
          const float* cw = epi.cw + f0;
          const float4 a0 = *(const float4*)cw, a1 = *(const float4*)(cw + 4), b0 = *(const float4*)(cw + DFF), b1 = *(const float4*)(cw + DFF + 4);
          const float4 c0 = *(const float4*)(cw + 2 * DFF), c1 = *(const float4*)(cw + 2 * DFF + 4), d0 = *(const float4*)(epi.cb + f0), d1 = *(const float4*)(epi.cb + f0 + 4);
          w0[0] = a0.x; w0[1] = a0.y; w0[2] = a0.z; w0[3] = a0.w; w0[4] = a1.x; w0[5] = a1.y; w0[6] = a1.z; w0[7] = a1.w;
          w1[0] = b0.x; w1[1] = b0.y; w1[2] = b0.z; w1[3] = b0.w; w1[4] = b1.x; w1[5] = b1.y; w1[6] = b1.z; w1[7] = b1.w;
          w2[0] = c0.x; w2[1] = c0.y; w2[2] = c0.z; w2[3] = c0.w; w2[4] = c1.x; w2[5] = c1.y; w2[6] = c1.z; w2[7] = c1.w;
          bb[0] = d0.x; bb[1] = d0.y; bb[2] = d0.z; bb[3] = d0.w; bb[4] = d1.x; bb[5] = d1.y; bb[6] = d1.z; bb[7] = d1.w;
        }
#pragma unroll
        for (int j = 0; j < BM / 64; j++) {
          const int r = (tid >> 3) + 64 * j;
          const char* ap = smem + UP_LA + r * 144 + fc * 16;
          const uint4 x0 = *(const uint4*)ap, x1 = *(const uint4*)(ap + 144), x2 = *(const uint4*)(ap + 288);
          const uint4 bv = *(const uint4*)(smem + UP_LB + r * 144 + fc * 16);
          const unsigned xa[4] = {x0.x, x0.y, x0.z, x0.w}, xb[4] = {x1.x, x1.y, x1.z, x1.w}, xc[4] = {x2.x, x2.y, x2.z, x2.w}, bw[4] = {bv.x, bv.y, bv.z, bv.w};
          float o[8];
#pragma unroll
          for (int q = 0; q < 8; q++) {
            const float a0 = (q & 1) ? bfhi(xa[q >> 1]) : bflo(xa[q >> 1]), a1 = (q & 1) ? bfhi(xb[q >> 1]) : bflo(xb[q >> 1]), a2 = (q & 1) ? bfhi(xc[q >> 1]) : bflo(xc[q >> 1]);
            const float bq = (q & 1) ? bfhi(bw[q >> 1]) : bflo(bw[q >> 1]);
            const float a = a0 * w0[q] + a1 * w1[q] + a2 * w2[q] + bb[q];
            const float t2 = 1.5957691216057308f * (a + 0.044715f * a * a * a);
            o[q] = a * __builtin_amdgcn_rcpf(1.f + __expf(-t2)) * bq;
          }
          uint4 ov; ov.x = pack2(o[0], o[1]); ov.y = pack2(o[2], o[3]); ov.z = pack2(o[4], o[5]); ov.w = pack2(o[6], o[7]);
          *(uint4*)(epi.u + (size_t)(m0 + r) * DFF + f0) = ov;
        }
      }
      __syncthreads();
     }
    } else if constexpr (epi_proj<Epi>::value) {
      const auto rsP = __builtin_amdgcn_make_buffer_rsrc((void*)epi.proj, 0, 0x7fffffff, 0x00020000);
      const auto rsT = __builtin_amdgcn_make_buffer_rsrc((void*)epi.ktr, 0, 0x7fffffff, 0x00020000);
      const auto rsG = __builtin_amdgcn_make_buffer_rsrc((void*)epi.gates, 0, 0x7fffffff, 0x00020000);
      const int wns = wu & 1;
      const bool even = (lane & 1) == 0;
      static_assert(MT == 3, "six-token transposed stores");
      unsigned voffP[MT], voffG[MT];
      const unsigned voffT = (unsigned)(((lg * 4 + (lane & 1) * 2) * T + m0 + wm * (BM / 4) + (lr >> 1) * 6) * 2);
#pragma unroll
      for (int mi = 0; mi < MT; mi++) {
        const int row = m0 + wm * (BM / 4) + (lr >> 1) * 6 + mi * 2 + (lr & 1);
        voffP[mi] = (unsigned)((row * INW + (lg & 1) * 16 + (lg >> 1) * 8) * 2); voffG[mi] = (unsigned)((row * 16 + lg * 4) * 4);
      }
#pragma unroll
      for (int np = 0; np < NTW / 2; np++) {
        const int col0 = n0 + wns * (BN / 2) + np * 32;
        const bool tonly = (col0 >= 768 && col0 < 1152) || (col0 >= 1536 && col0 < 2304) || (col0 >= 3072 && col0 < 3456);
        if (col0 < 3840 && !tonly) {
#pragma unroll
          for (int mi = 0; mi < MT; mi++) {
            const f32x4 g = acc[mi][2 * np], hh = acc[mi][2 * np + 1];
            const unsigned g01 = pack2(g[0], g[1]), g23 = pack2(g[2], g[3]), h01 = pack2(hh[0], hh[1]), h23 = pack2(hh[2], hh[3]);
            const auto r0 = __builtin_amdgcn_permlane16_swap(g01, h01, false, false);
            const auto r1 = __builtin_amdgcn_permlane16_swap(g23, h23, false, false);
            __builtin_amdgcn_raw_buffer_store_b128((u32x4){r0[0], r1[0], r0[1], r1[1]}, rsP, voffP[mi], (unsigned)(col0 * 2), 0);
          }
        }
      }
#pragma unroll
      for (int ni = 0; ni < NTW; ni++) {
        const int col0 = n0 + wns * (BN / 2) + ni * 16;
        long tel = -1;
        if (col0 >= 384 && col0 < 768) tel = (long)(col0 - 384) * T;
        else if (col0 >= 768 && col0 < 1152) tel = (epi.vtr - epi.ktr) + (long)(col0 - 768) * T;
        else if (col0 >= 1536 && col0 < 2304) tel = (epi.hyt - epi.ktr) + (long)(col0 - 1536) * T;
        else if (col0 >= 2688 && col0 < 3072) tel = (epi.ktm - epi.ktr) + (long)(col0 - 2688) * T;
        else if (col0 >= 3072 && col0 < 3456) tel = (epi.vtm - epi.ktr) + (long)(col0 - 3072) * T;
        const unsigned tso = (unsigned)(tel * 2);
        unsigned p0[MT], p1[MT];
#pragma unroll
        for (int mi = 0; mi < MT; mi++) {
          const f32x4 v = acc[mi][ni];
          if (col0 == 3840) __builtin_amdgcn_raw_buffer_store_b128((u32x4){__float_as_uint(v[0]), __float_as_uint(v[1]), __float_as_uint(v[2]), __float_as_uint(v[3])}, rsG, voffG[mi], 0, 0);
          if (tel >= 0) {
            float nb[4];
#pragma unroll
            for (int r = 0; r < 4; r++) nb[r] = __int_as_float(__builtin_amdgcn_update_dpp(0, __float_as_int(v[r]), 0xB1, 0xF, 0xF, false));
            p0[mi] = pack2(even ? v[0] : nb[2], even ? nb[0] : v[2]); p1[mi] = pack2(even ? v[1] : nb[3], even ? nb[1] : v[3]);
          }
        }
        if (tel >= 0) {
          __builtin_amdgcn_raw_buffer_store_b96((u32x3){p0[0], p0[1], p0[2]}, rsT, voffT, tso, 0);
          __builtin_amdgcn_raw_buffer_store_b96((u32x3){p1[0], p1[1], p1[2]}, rsT, voffT, tso + (unsigned)(T * 2), 0);
        }
      }
    } else {
#pragma unroll
      for (int mi = 0; mi < MT; mi++)
#pragma unroll
        for (int ni = 0; ni < NTW; ni++) epi(m0 + wm * (BM / 4) + mi * 16 + lr, n0 + wn * (BN / 2) + ni * 16 + lg * 4, acc[mi][ni]);
    }
  }
#undef GLOAD
#undef SWRITE
#undef GLDS
#undef GWAIT
#undef TILE_M0
#undef TILE_N0
}


namespace up8 {
constexpr int BM = 256, BK = 64, HALF = 128, HT = HALF * BK, SHM_B = 8 * HT * 2;
__device__ __forceinline__ int lds_byte(int r, int c) { int st = (r >> 4) * 2 + (c >> 5), rr = r & 15, cc = c & 31, ob = rr * 64 + cc * 2; return st * 1024 + (ob ^ (((ob >> 9) & 1) << 5)); }
__device__ __forceinline__ void stage_rc(int b, int& R, int& C) { int st = b / 1024, sb = b % 1024, swz = sb ^ (((sb >> 9) & 1) << 5); R = (st >> 1) * 16 + swz / 64; C = (st & 1) * 32 + (swz % 64) / 2; }
}
__device__ __forceinline__ void gemm_up8(const bf16_t* __restrict__ A, const bf16_t* __restrict__ Bt, int bid, int nb, char* smem, const EpiUp& epi) {
  using namespace up8;
  constexpr int K = D;
  static_assert(SHM_B <= SMEM_BYTES - 64, "LDS");
  const int tid = TIDX, wid = tid >> 6, lane = tid & 63, wr = wid >> 2, wc = wid & 3, fr = lane & 15, fq = lane >> 4;
  const int wu = __builtin_amdgcn_readfirstlane(wid);
  bf16_t* shm = (bf16_t*)smem;
#define SA(b, h) (shm + ((b) * 2 + (h)) * HT)
#define SB(b, h) (shm + (4 + (b) * 2 + (h)) * HT)
  int sR0, sC0, sR1, sC1; stage_rc(tid * 16, sR0, sC0); stage_rc(tid * 16 + 8192, sR1, sC1);
  const unsigned so0 = (unsigned)((sR0 * K + sC0) * 2), so1 = (unsigned)((sR1 * K + sC1) * 2);
  const auto rsA = __builtin_amdgcn_make_buffer_rsrc((void*)A, 0, 0x7fffffff, 0x00020000);
  const auto rsB = __builtin_amdgcn_make_buffer_rsrc((void*)Bt, 0, 0x7fffffff, 0x00020000);
  const auto rsU = __builtin_amdgcn_make_buffer_rsrc((void*)epi.u, 0, 0x7fffffff, 0x00020000);
#define rs_A rsA
#define rs_Bt rsB
#define STAGE(P, BASE, br, kt) do { const int so_ = ((br) * K + (kt) * BK) * 2; \
    __builtin_amdgcn_raw_ptr_buffer_load_lds(rs_##BASE, (LAS void*)((char*)(P) + wu * 1024), 16, so0, so_, 0, 0); \
    __builtin_amdgcn_raw_ptr_buffer_load_lds(rs_##BASE, (LAS void*)((char*)(P) + 8192 + wu * 1024), 16, so1, so_, 0, 0); } while (0)
#define LDA(dst, b, h) _Pragma("unroll") for (int m = 0; m < 4; ++m) _Pragma("unroll") for (int k = 0; k < 2; ++k) \
    dst[m][k] = *reinterpret_cast<const bf16x8*>((const char*)SA(b, h) + lds_byte(wr * 64 + m * 16 + fr, k * 32 + fq * 8))
#define LDB(dst, b, h) _Pragma("unroll") for (int n = 0; n < 2; ++n) _Pragma("unroll") for (int k = 0; k < 2; ++k) \
    dst[n][k] = *reinterpret_cast<const bf16x8*>((const char*)SB(b, h) + lds_byte(wc * 32 + n * 16 + fr, k * 32 + fq * 8))
#define MMA(ai, bj, At_, Bt_) do { __builtin_amdgcn_s_setprio(1); \
    _Pragma("unroll") for (int m = 0; m < 4; ++m) _Pragma("unroll") for (int n = 0; n < 2; ++n) _Pragma("unroll") for (int k = 0; k < 2; ++k) \
      acc[ai][bj][m][n] = __builtin_amdgcn_mfma_f32_16x16x32_bf16(Bt_[n][k], At_[m][k], acc[ai][bj][m][n], 0, 0, 0); \
    __builtin_amdgcn_s_setprio(0); } while (0)
#define WAIT_V(n) asm volatile("s_waitcnt vmcnt(" #n ")" ::: "memory")
#define WAIT_L(n) asm volatile("s_waitcnt lgkmcnt(" #n ")" ::: "memory")
#define BARX __builtin_amdgcn_s_barrier()
#define SCHED __builtin_amdgcn_sched_barrier(0)
  const int grp = bid & 7, jg = bid >> 3, ng = (nb + 7 - grp) >> 3;
  constexpr int mpg = 6, nn = 16, tpg = mpg * nn, nt = K / BK;
  if (epi.done) {
    for (int q = jg; q < tpg; q += ng) {
      const int mi_ = q % mpg, mt_ = mi_ < 4 ? (grp & 3) * 4 + mi_ : 16 + (grp & 3) * 2 + (mi_ - 4), m0 = mt_ * 256;
      const int rlo_ = m0 > 0 ? m0 - 1 : 0, rhi_ = m0 + 256 < T ? m0 + 256 : T - 1;
      seam_poll(epi.done, epi.epoch, epi.tmo, rlo_ / 192, rhi_ / 192);
    }
    seam_acquire();
  }
  int pend = -1;
  for (int q = jg; q < tpg; q += ng) {
    const int mi_ = q % mpg, mt_ = mi_ < 4 ? (grp & 3) * 4 + mi_ : 16 + (grp & 3) * 2 + (mi_ - 4);
    const int m0 = mt_ * 256, n0 = ((grp >> 2) * nn + q / mpg) * 256;
    const int brow = m0, bcol = n0;
    f32x4 acc[2][2][4][2];
    { float zero_ = 0.f; asm volatile("" : "+v"(zero_));
#pragma unroll
      for (int a_ = 0; a_ < 2; a_++)
#pragma unroll
        for (int b_ = 0; b_ < 2; b_++)
#pragma unroll
          for (int m = 0; m < 4; m++)
#pragma unroll
            for (int n = 0; n < 2; n++) acc[a_][b_][m][n] = (f32x4){zero_, zero_, zero_, zero_}; }
    bf16x8 At[4][2], B0[2][2], B1[2][2];
    __syncthreads();
    STAGE(SB(0, 0), Bt, bcol, 0); STAGE(SA(0, 0), A, brow, 0);
    STAGE(SB(0, 1), Bt, bcol + HALF, 0); STAGE(SA(0, 1), A, brow + HALF, 0);
    if (wr == 1) BARX;
    WAIT_V(4); BARX;
    STAGE(SB(1, 0), Bt, bcol, 1); STAGE(SA(1, 0), A, brow, 1); STAGE(SB(1, 1), Bt, bcol + HALF, 1);
    WAIT_V(6); BARX;
#pragma unroll 1
    for (int t = 0; t < nt - 2; t += 2) {
      LDB(B0, 0, 0); SCHED; LDA(At, 0, 0); STAGE(SA(1, 1), A, brow + HALF, t + 1);
      WAIT_L(8); BARX; WAIT_L(0); MMA(0, 0, At, B0); BARX; SCHED;
      LDB(B1, 0, 1); STAGE(SB(0, 0), Bt, bcol, t + 2);
      BARX; WAIT_L(0); MMA(0, 1, At, B1); BARX;
      LDA(At, 0, 1); STAGE(SA(0, 0), A, brow, t + 2);
      BARX; WAIT_L(0); MMA(1, 0, At, B0); BARX; SCHED;
      STAGE(SB(0, 1), Bt, bcol + HALF, t + 2);
      WAIT_V(6); BARX; MMA(1, 1, At, B1); BARX;
      LDB(B0, 1, 0); SCHED; LDA(At, 1, 0); STAGE(SA(0, 1), A, brow + HALF, t + 2);
      WAIT_L(8); BARX; WAIT_L(0); MMA(0, 0, At, B0); BARX; SCHED;
      LDB(B1, 1, 1); STAGE(SB(1, 0), Bt, bcol, t + 3);
      BARX; WAIT_L(0); MMA(0, 1, At, B1); BARX;
      LDA(At, 1, 1); STAGE(SA(1, 0), A, brow, t + 3);
      BARX; WAIT_L(0); MMA(1, 0, At, B0); BARX; SCHED;
      STAGE(SB(1, 1), Bt, bcol + HALF, t + 3);
      WAIT_V(6); BARX; MMA(1, 1, At, B1); BARX;
    }
    { LDB(B0, 0, 0); LDA(At, 0, 0); STAGE(SA(1, 1), A, brow + HALF, nt - 1);
      BARX; WAIT_L(0); MMA(0, 0, At, B0); BARX;
      LDB(B1, 0, 1); BARX; WAIT_L(0); MMA(0, 1, At, B1); BARX;
      LDA(At, 0, 1); WAIT_V(4); BARX; WAIT_L(0); MMA(1, 0, At, B0); MMA(1, 1, At, B1); BARX; }
    { LDB(B0, 1, 0); LDA(At, 1, 0); WAIT_V(2); BARX; WAIT_L(0); MMA(0, 0, At, B0); BARX;
      LDB(B1, 1, 1); WAIT_V(0); BARX; WAIT_L(0); MMA(0, 1, At, B1); BARX;
      LDA(At, 1, 1); BARX; WAIT_L(0); MMA(1, 0, At, B0); MMA(1, 1, At, B1); BARX; }
    if (wr == 0) BARX;
    constexpr int RS = 272, UP_LA = 0, UP_LB = UP_LA + 258 * RS;
    static_assert(UP_LB + 256 * RS <= SMEM_BYTES - 64, "fused epilogue images");
    __syncthreads();
    if (epi.upf && pend >= 0 && tid == 0) __hip_atomic_store(epi.upf + pend, epi.upepoch, __ATOMIC_RELAXED, __HIP_MEMORY_SCOPE_AGENT);
    pend = mt_ * 32 + (n0 >> 8);
    int tid_e = tid; asm volatile("" : "+v"(tid_e));
    const int lane_e = tid_e & 63, wid_e = tid_e >> 6, wr_e = wid_e >> 2, wc_e = wid_e & 3, fr_e = lane_e & 15, fq_e = lane_e >> 4;
#pragma unroll
    for (int ai = 0; ai < 2; ai++)
#pragma unroll
      for (int m = 0; m < 4; m++)
#pragma unroll
        for (int n = 0; n < 2; n++) {
          const int r = ai * 128 + wr_e * 64 + m * 16 + fr_e, cidx = wc_e * 32 + n * 16 + fq_e * 4;
          uint2 oa, ob;
          oa.x = pack2(acc[ai][0][m][n][0], acc[ai][0][m][n][1]); oa.y = pack2(acc[ai][0][m][n][2], acc[ai][0][m][n][3]);
          ob.x = pack2(acc[ai][1][m][n][0], acc[ai][1][m][n][1]); ob.y = pack2(acc[ai][1][m][n][2], acc[ai][1][m][n][3]);
          *(uint2*)(smem + UP_LA + RS + r * RS + cidx * 2) = oa;
          *(uint2*)(smem + UP_LB + r * RS + cidx * 2) = ob;
        }
    const int fc = tid_e & 15, f0 = (n0 >> 1) + fc * 8;
    f32x2 w0[4], w1[4], w2[4], bb[4];
    {
        const float* cw = epi.cw + f0;
        const float4 a0 = *(const float4*)cw, a1 = *(const float4*)(cw + 4), b0 = *(const float4*)(cw + DFF), b1 = *(const float4*)(cw + DFF + 4);
        const float4 c0 = *(const float4*)(cw + 2 * DFF), c1 = *(const float4*)(cw + 2 * DFF + 4), d0 = *(const float4*)(epi.cb + f0), d1 = *(const float4*)(epi.cb + f0 + 4);
        w0[0] = (f32x2){a0.x, a0.y}; w0[1] = (f32x2){a0.z, a0.w}; w0[2] = (f32x2){a1.x, a1.y}; w0[3] = (f32x2){a1.z, a1.w};
        w1[0] = (f32x2){b0.x, b0.y}; w1[1] = (f32x2){b0.z, b0.w}; w1[2] = (f32x2){b1.x, b1.y}; w1[3] = (f32x2){b1.z, b1.w};
        w2[0] = (f32x2){c0.x, c0.y}; w2[1] = (f32x2){c0.z, c0.w}; w2[2] = (f32x2){c1.x, c1.y}; w2[3] = (f32x2){c1.z, c1.w};
        bb[0] = (f32x2){d0.x, d0.y}; bb[1] = (f32x2){d0.z, d0.w}; bb[2] = (f32x2){d1.x, d1.y}; bb[3] = (f32x2){d1.z, d1.w};
    }
    {
      const int pos0 = m0 >= TC ? ((m0 - TC) & 1023) : 0;
      const bool top = m0 >= TC && pos0 != 0, bot = m0 >= TC && pos0 + 256 != 1024;
      if (top || bot) {
        unsigned z0_ = 0u; asm volatile("" : "+v"(z0_)); uint4 ht0 = make_uint4(z0_, z0_, z0_, z0_), ht1 = ht0, hb0 = ht0, hb1 = ht0;
        if (top) { const bf16_t* hr = epi.h + (size_t)(m0 - 1) * K + lane_e * 8; ht0 = *(const uint4*)hr; ht1 = *(const uint4*)(hr + 512); }
        if (bot) { const bf16_t* hr = epi.h + (size_t)(m0 + 256) * K + lane_e * 8; hb0 = *(const uint4*)hr; hb1 = *(const uint4*)(hr + 512); }
#define DOT2_(a, b, c) __builtin_amdgcn_fdot2_f32_bf16(__builtin_bit_cast(bf16x2_t, (a)), __builtin_bit_cast(bf16x2_t, (b)), (c), false)
#define DOT8A(acc, a, b) acc = DOT2_(a.x, b.x, DOT2_(a.y, b.y, DOT2_(a.z, b.z, DOT2_(a.w, b.w, acc))))
#define DOT8(a, b) (bflo(a.x) * bflo(b.x) + bfhi(a.x) * bfhi(b.x) + bflo(a.y) * bflo(b.y) + bfhi(a.y) * bfhi(b.y) + bflo(a.z) * bflo(b.z) + bfhi(a.z) * bfhi(b.z) + bflo(a.w) * bflo(b.w) + bfhi(a.w) * bfhi(b.w))
#pragma unroll 1
        for (int fb = 0; fb < 4; fb++) {
          uint4 w0[4], w1[4];
#pragma unroll
          for (int fi = 0; fi < 4; fi++) { const bf16_t* wrow = epi.wt + (size_t)(n0 + wid_e * 16 + fb * 4 + fi) * K + lane_e * 8; w0[fi] = *(const uint4*)wrow; w1[fi] = *(const uint4*)(wrow + 512); }
#pragma unroll
          for (int fi = 0; fi < 4; fi++) {
            float st = 0.f, sb = 0.f;
            DOT8A(st, ht0, w0[fi]); DOT8A(st, ht1, w1[fi]); DOT8A(sb, hb0, w0[fi]); DOT8A(sb, hb1, w1[fi]);
            st = wave_sum(st); sb = wave_sum(sb);
            const int f = wid_e * 16 + fb * 4 + fi;
            if (lane_e == 0) { *(bf16_t*)(smem + UP_LA + f * 2) = f2bf(st); *(bf16_t*)(smem + UP_LA + 257 * RS + f * 2) = f2bf(sb); }
          }
        }
#undef DOT8
#undef DOT8A
#undef DOT2_
      } else if (tid_e < 256) {
        *(bf16_t*)(smem + UP_LA + (tid_e >> 7) * 257 * RS + (tid_e & 127) * 2) = 0;
      }
    }
    __syncthreads();
    {
      constexpr float GC0 = -1.5957691216057308f * 1.4426950408889634f, GC1 = GC0 * 0.044715f;
#pragma unroll 2
      for (int j = 0; j < 8; j++) {
        const int r = (tid_e >> 4) + 32 * j;
        const char* ap = smem + UP_LA + r * RS + fc * 16;
        const uint4 x0 = *(const uint4*)ap, x1 = *(const uint4*)(ap + RS), x2 = *(const uint4*)(ap + 2 * RS);
        const uint4 bv = *(const uint4*)(smem + UP_LB + r * RS + fc * 16);
        const unsigned xa[4] = {x0.x, x0.y, x0.z, x0.w}, xb[4] = {x1.x, x1.y, x1.z, x1.w}, xc[4] = {x2.x, x2.y, x2.z, x2.w}, bw[4] = {bv.x, bv.y, bv.z, bv.w};
        unsigned ow[4];
#pragma unroll
        for (int q = 0; q < 4; q++) {
          const f32x2 a0 = {bflo(xa[q]), bfhi(xa[q])}, a1 = {bflo(xb[q]), bfhi(xb[q])}, a2 = {bflo(xc[q]), bfhi(xc[q])}, bq = {bflo(bw[q]), bfhi(bw[q])};
          const f32x2 a = a0 * w0[q] + (a1 * w1[q] + (a2 * w2[q] + bb[q]));
          const f32x2 v = a * (a * a * GC1 + GC0);
          const f32x2 d = (f32x2){__builtin_amdgcn_exp2f(v[0]), __builtin_amdgcn_exp2f(v[1])} + 1.f;
          const f32x2 o = a * (f32x2){__builtin_amdgcn_rcpf(d[0]), __builtin_amdgcn_rcpf(d[1])} * bq;
          ow[q] = pack2(o[0], o[1]);
        }
        uint4 ov; ov.x = ow[0]; ov.y = ow[1]; ov.z = ow[2]; ov.w = ow[3];
        __builtin_amdgcn_raw_buffer_store_b128((u32x4){ov.x, ov.y, ov.z, ov.w}, rsU, (unsigned)(((m0 + r) * DFF + f0) * 2), 0, WT_AUX);
      }
    }
  }
  if (epi.upf && pend >= 0) {
    asm volatile("s_waitcnt vmcnt(0)" ::: "memory");
    __syncthreads();
    if (tid == 0) __hip_atomic_store(epi.upf + pend, epi.upepoch, __ATOMIC_RELAXED, __HIP_MEMORY_SCOPE_AGENT);
  }
#undef SA
#undef SB
#undef STAGE
#undef rs_A
#undef rs_Bt
#undef LDA
#undef LDB
#undef MMA
#undef WAIT_V
#undef WAIT_L
#undef BARX
#undef SCHED
}

template <int BM, int BN, int GL, class Epi>
__device__ __forceinline__ void phase_gemm(const bf16_t* A, const bf16_t* Bt, int M, int N, int K, int bid, int nb, char* smem, const Epi& epi) {
  gemm_tiles<BM, BN, GL, Epi>(A, Bt, M, N, K, bid, nb, smem, epi);
}

constexpr int LQ = 0, LK = 26624;
constexpr int LRED = 0;
constexpr int LKT = 36864;
constexpr int LVT = 61440;
constexpr int LST = 86016;
constexpr int LGT = 125952;
constexpr int MIX_LDS_END = LGT + (2048 + 256 + 256 + 16 + 192) * 4;
static_assert(MIX_LDS_END + 24576 <= SMEM_BYTES - 64 && 24576 <= LKT, "second staging buffer");
constexpr int LKT1 = 0, LVT1 = MIX_LDS_END;
constexpr float KSCALE = 0.10206207261596577f;
constexpr float LOG2E = 1.4426950408889634f;


template <bool ML>
__device__ __forceinline__ void mix_unit(PR p, int layer, int s, int c, int h, char* smem) {
  const int tid = TIDX, lane = tid & 63, wid = tid >> 6, lr = lane & 15, lg = lane >> 4;
  const int L = seq_len(s), row0 = seq_row0(s), nc = L >> 7;
  const bool latent = s >= 16; const int lb = s - 16;
  const int P0 = c * 128;
  const int QOFF = ML ? 2304 : 0, KOFF = ML ? 2688 : 384, GOFF = ML ? 3456 : 1152, MOFF = ML ? 640 : 0;
  const bf16_t* ktg = (ML ? p.ktm : p.ktr) + (size_t)h * 96 * T + row0;
  const bf16_t* vtg = (ML ? p.vtm : p.vtr) + (size_t)h * 96 * T + row0;
  const bool rope = (!ML) && latent;
  float* red = (float*)(smem + LRED);
  float* Eg = (float*)(smem + LGT); float* Xo = Eg + 2048; float* Bo = Xo + 256; float* sc = Bo + 256; float* nin = sc + 16;
  float lgd0 = 0.f, lgd1 = 0.f;
  if (!ML) {
    lgd0 = log_sigmoidf_(p.ret_decay_logit[layer * 8 + h]) * LOG2E;
    lgd1 = log_sigmoidf_(p.ret_decay_logit[layer * 8 + 4 + h]) * LOG2E;
  }
  __syncthreads();
  if (ML) {
    for (int t = tid; t < L; t += NT) {
      const float4* g4 = (const float4*)(p.gates + (size_t)(row0 + t) * 16);
      const float4 gA = g4[0], gB = g4[1], gC = g4[2], gD = g4[3];
      const float ga[4] = {gA.x, gA.y, gA.z, gA.w}, gb[4] = {gB.x, gB.y, gB.z, gB.w}, gc[4] = {gC.x, gC.y, gC.z, gC.w}, gd[4] = {gD.x, gD.y, gD.z, gD.w};
      float gi0 = 0.f, gf0 = 0.f, gi1 = 0.f, gf1 = 0.f;
#pragma unroll
      for (int q = 0; q < 4; q++) if (q == h) { gi0 = ga[q]; gf0 = gb[q]; gi1 = gc[q]; gf1 = gd[q]; }
      const float* gbias = p.ml_gate_bias + layer * 16;
      Eg[t] = gi0 + gbias[h]; Eg[1024 + t] = gi1 + gbias[8 + h];
      red[t] = log_sigmoidf_(gf0 + gbias[4 + h]); red[1024 + t] = log_sigmoidf_(gf1 + gbias[12 + h]);
    }
    __syncthreads();
    if (wid < 2) {
      const int dir = wid; const int per = L >> 6;
      const float m0 = latent ? p.state_m[((lb * DEPTH + layer) * 2 + dir) * 4 + h] : 0.f;
      float ev[16], bv[16];
      float run = 0.f;
#pragma unroll
      for (int k = 0; k < 16; k++) {
        ev[k] = 0.f; bv[k] = 0.f;
        if (k < per) {
          int u = lane * per + k; int t = dir ? L - 1 - u : u;
          ev[k] = Eg[dir * 1024 + t];
          run += red[dir * 1024 + t];
          bv[k] = run;
        }
      }
      float incl = run;
#pragma unroll
      for (int o = 1; o < 64; o <<= 1) { float v = __shfl_up(incl, o); if (lane >= o) incl += v; }
      const float excl = incl - run;
      float xm = -3.0e38f;
#pragma unroll
      for (int k = 0; k < 16; k++) if (k < per) { bv[k] += excl; ev[k] -= bv[k]; xm = fmaxf(xm, ev[k]); }
      float inclm = xm;
#pragma unroll
      for (int o = 1; o < 64; o <<= 1) { float v = __shfl_up(inclm, o); if (lane >= o) inclm = fmaxf(inclm, v); }
      float xrun = __shfl_up(inclm, 1); if (lane == 0) xrun = -3.0e38f;
      xrun = fmaxf(xrun, m0);
      const int nprior = dir ? L - P0 - 128 : P0;
      if (lane == 0) { sc[6 + dir] = m0; if (nprior == 0) sc[0 + dir] = m0; }
#pragma unroll
      for (int k = 0; k < 16; k++) if (k < per) {
        int u = lane * per + k; int t = dir ? L - 1 - u : u;
        xrun = fmaxf(xrun, ev[k]);
        Eg[dir * 1024 + t] = ev[k];
        if (t >= P0 && t < P0 + 128) { Xo[dir * 128 + t - P0] = xrun; Bo[dir * 128 + t - P0] = bv[k]; }
        if (u == nprior - 1) sc[0 + dir] = xrun;
        if (u == L - 1) { sc[2 + dir] = xrun; sc[4 + dir] = bv[k]; }
      }
    }
    __syncthreads();
  }
  const int wq = wid & 3, kgrp = wid >> 2;
  const int dt0 = 3 * (wq >> 1), et0 = 3 * (wq & 1);
#pragma unroll 1
  for (int dirr = 0; dirr < 2 * REP_STATE; dirr++) {
    const int dir = dirr & 1;
    const int nprior_ch = dir ? nc - 1 - c : c;
    const bool need_final = (!latent) && (dir ? (c == 0) : (c == nc - 1));
    const float lgdir = dir ? lgd1 : lgd0;
    f32x4 acc[3][3];
    const float Xin = ML ? sc[0 + dir] : 0.f;
    {
      float f0 = 0.f;
      if (latent && kgrp == 0) f0 = ML ? __expf(sc[6 + dir] - Xin) : 1.f;
      const float* S0 = (ML ? p.state_c : p.state_ret) + ((size_t)((lb * DEPTH + layer) * 2 + dir) * 4 + h) * 9216;
#pragma unroll
      for (int a = 0; a < 3; a++)
#pragma unroll
        for (int b = 0; b < 3; b++)
#pragma unroll
          for (int r = 0; r < 4; r++) {
            float v = 0.f;
            if (latent && kgrp == 0) v = S0[((dt0 + a) * 16 + 4 * lg + r) * 96 + (et0 + b) * 16 + lr] * f0;
            acc[a][b][r] = v;
          }
    }
    float nacc[2][2] = {{0.f, 0.f}, {0.f, 0.f}};
    const int nsteps = nprior_ch + (need_final ? 1 : 0);
    float wret[2][8];
#pragma unroll
    for (int it = 0; it < 2; it++)
#pragma unroll
      for (int q = 0; q < 8; q++) { const int tl = ((tid + it * 512) & 15) * 8 + q; wret[it][q] = ML ? 0.f : __builtin_amdgcn_exp2f((float)(dir ? tl : 127 - tl) * lgdir) * KSCALE; }
    u32x4 pk1[2], pk2[2], pv[3];
#define MIX_PREFETCH(jj) { \
      _Pragma("unroll") for (int it = 0; it < 2; it++) { const int pi = tid + it * 512; if (pi < 768) { const int d = pi >> 4, cc = pi & 15; \
          pk1[it] = *(const u32x4*)(ktg + (size_t)d * T + (jj) * 128 + cc * 8); pk2[it] = *(const u32x4*)(ktg + (size_t)(d + 48) * T + (jj) * 128 + cc * 8); } } \
      _Pragma("unroll") for (int it = 0; it < 3; it++) { const int ci = tid + it * 512, e = ci >> 4, cc = ci & 15; pv[it] = *(const u32x4*)(vtg + (size_t)e * T + (jj) * 128 + cc * 8); } }
#define CHUNK_OF(ST_) (((ST_) == nprior_ch) ? c : (dir ? nc - 1 - (ST_) : (ST_)))
#define MIX_STAGE(ST_, BUF_) { \
      const bool sfin_ = (ST_) == nprior_ch; const int j = CHUNK_OF(ST_); \
      const float Xref = ML ? (sfin_ ? sc[2 + dir] : Xin) : 0.f; \
      const int lkt_ = (BUF_) ? LKT1 : LKT, lvt_ = (BUF_) ? LVT1 : LVT; \
      if (ML && sfin_ && (tid & 15) == 0) {       \
        const float resc = __expf(Xin - Xref); \
        _Pragma("unroll") for (int it = 0; it < 2; it++) { const int d = (tid >> 4) + 32 * it; \
          if (d < 48) { nin[dir * 96 + d] = nacc[it][0]; nin[dir * 96 + d + 48] = nacc[it][1]; nacc[it][0] *= resc; nacc[it][1] *= resc; } } \
      } \
      _Pragma("unroll") for (int it = 0; it < 2; it++) { \
        const int pi = tid + it * 512; \
        if (pi < 768) { \
          const int d = pi >> 4, cc = pi & 15; \
          const int t0 = j * 128 + cc * 8; \
          const u32x4 k1 = pk1[it], k2 = pk2[it]; \
          float w[8]; \
          if (ML) { \
            const float4 e0 = *(const float4*)(Eg + dir * 1024 + t0), e1 = *(const float4*)(Eg + dir * 1024 + t0 + 4); \
            w[0] = e0.x; w[1] = e0.y; w[2] = e0.z; w[3] = e0.w; w[4] = e1.x; w[5] = e1.y; w[6] = e1.z; w[7] = e1.w; \
            _Pragma("unroll") for (int q = 0; q < 8; q++) w[q] = __expf(w[q] - Xref) * KSCALE; \
          } else { \
            _Pragma("unroll") for (int q = 0; q < 8; q++) w[q] = wret[it][q]; \
          } \
          float x1[8], x2[8]; \
          x1[0] = bflo(k1.x); x1[1] = bfhi(k1.x); x1[2] = bflo(k1.y); x1[3] = bfhi(k1.y); x1[4] = bflo(k1.z); x1[5] = bfhi(k1.z); x1[6] = bflo(k1.w); x1[7] = bfhi(k1.w); \
          x2[0] = bflo(k2.x); x2[1] = bfhi(k2.x); x2[2] = bflo(k2.y); x2[3] = bfhi(k2.y); x2[4] = bflo(k2.z); x2[5] = bfhi(k2.z); x2[6] = bflo(k2.w); x2[7] = bfhi(k2.w); \
          if (rope) { \
            const float* ct = p.rope_cosT + d * 1024 + t0; const float* sn = p.rope_sinT + d * 1024 + t0; \
            const float4 c0 = *(const float4*)ct, c1 = *(const float4*)(ct + 4), s0 = *(const float4*)sn, s1 = *(const float4*)(sn + 4); \
            const float cv[8] = {c0.x, c0.y, c0.z, c0.w, c1.x, c1.y, c1.z, c1.w}, sv[8] = {s0.x, s0.y, s0.z, s0.w, s1.x, s1.y, s1.z, s1.w}; \
            _Pragma("unroll") for (int q = 0; q < 8; q++) { float a1 = x1[q] * cv[q] - x2[q] * sv[q], a2 = x2[q] * cv[q] + x1[q] * sv[q]; x1[q] = a1; x2[q] = a2; } \
          } \
          float s1 = 0.f, s2 = 0.f; \
          _Pragma("unroll") for (int q = 0; q < 8; q++) { x1[q] *= w[q]; x2[q] *= w[q]; s1 += x1[q]; s2 += x2[q]; } \
          uint4 o1, o2; \
          o1.x = pack2(x1[0], x1[1]); o1.y = pack2(x1[2], x1[3]); o1.z = pack2(x1[4], x1[5]); o1.w = pack2(x1[6], x1[7]); \
          o2.x = pack2(x2[0], x2[1]); o2.y = pack2(x2[2], x2[3]); o2.z = pack2(x2[4], x2[5]); o2.w = pack2(x2[6], x2[7]); \
          *(uint4*)(smem + lkt_ + d * 256 + ((cc ^ (d & 15)) << 4)) = o1; \
          *(uint4*)(smem + lkt_ + (d + 48) * 256 + ((cc ^ ((d + 48) & 15)) << 4)) = o2; \
          if (ML) { s1 = row16_sum(s1); s2 = row16_sum(s2); nacc[it][0] += s1; nacc[it][1] += s2; } \
        } \
      } \
      _Pragma("unroll") for (int it = 0; it < 3; it++) { \
        const int ci = tid + it * 512, e = ci >> 4, cc = ci & 15; \
        *(u32x4*)(smem + lvt_ + e * 256 + ((cc ^ (e & 15)) << 4)) = pv[it]; \
      } }
    if (nsteps > 0) {
      MIX_PREFETCH(CHUNK_OF(0));
      MIX_STAGE(0, 0);
      if (nsteps > 1) MIX_PREFETCH(CHUNK_OF(1));
      __syncthreads();
    }
#pragma unroll 1
    for (int st = 0; st < nsteps; st++) {
      const int bsel = st & 1;
      if (st == nprior_ch && kgrp == 0) {
        const float resc = ML ? __expf(Xin - sc[2 + dir]) : 1.f;
#pragma unroll
        for (int a = 0; a < 3; a++)
#pragma unroll
          for (int b = 0; b < 3; b++) {
            f32x4 v = acc[a][b];
            uint2 o; o.x = pack2(v[0], v[1]); o.y = pack2(v[2], v[3]);
            *(uint2*)(smem + LST + dir * 19968 + ((et0 + b) * 16 + lr) * 208 + ((dt0 + a) * 16 + 4 * lg) * 2) = o;
            acc[a][b] = v * resc;
          }
      }
      if (st + 1 < nsteps) {
        MIX_STAGE(st + 1, bsel ^ 1);
        if (st + 2 < nsteps) MIX_PREFETCH(CHUNK_OF(st + 2));
      }
      if (kgrp == 0) {
        if (!ML) {
          const float g128 = __builtin_amdgcn_exp2f(128.f * lgdir);
#pragma unroll
          for (int a = 0; a < 3; a++)
#pragma unroll
            for (int b = 0; b < 3; b++) acc[a][b] = acc[a][b] * g128;
        }
        const int lkt_ = bsel ? LKT1 : LKT, lvt_ = bsel ? LVT1 : LVT;
#pragma unroll
        for (int kk = 0; kk < 4; kk++) {
          const int ch = kk * 4 + lg;
          bf16x8 af[3], bfr[3];
#pragma unroll
          for (int a = 0; a < 3; a++) { int row = (dt0 + a) * 16 + lr; af[a] = *(const bf16x8*)(smem + lkt_ + row * 256 + ((ch ^ (row & 15)) << 4)); }
#pragma unroll
          for (int b = 0; b < 3; b++) { int row = (et0 + b) * 16 + lr; bfr[b] = *(const bf16x8*)(smem + lvt_ + row * 256 + ((ch ^ (row & 15)) << 4)); }
#pragma unroll
          for (int a = 0; a < 3; a++)
#pragma unroll
            for (int b = 0; b < 3; b++) acc[a][b] = __builtin_amdgcn_mfma_f32_16x16x32_bf16(af[a], bfr[b], acc[a][b], 0, 0, 0);
        }
      }
      __syncthreads();
    }
#undef MIX_STAGE
#undef CHUNK_OF
#undef MIX_PREFETCH
    if (kgrp == 0) {
      const size_t sidx = ((size_t)(s * DEPTH + layer) * 2 + dir) * 4 + h;
#pragma unroll
      for (int a = 0; a < 3; a++)
#pragma unroll
        for (int b = 0; b < 3; b++) {
          f32x4 v = acc[a][b];
          if (need_final) {
            float* dst = p.out + (ML ? O_MC : O_SR) + sidx * 9216;
#pragma unroll
            for (int r = 0; r < 4; r++) dst[((dt0 + a) * 16 + 4 * lg + r) * 96 + (et0 + b) * 16 + lr] = v[r];
          } else {
            uint2 o; o.x = pack2(v[0], v[1]); o.y = pack2(v[2], v[3]);
            *(uint2*)(smem + LST + dir * 19968 + ((et0 + b) * 16 + lr) * 208 + ((dt0 + a) * 16 + 4 * lg) * 2) = o;
          }
        }
    }
    if (ML && (tid & 15) == 0) {
      const size_t sidx = ((size_t)(s * DEPTH + layer) * 2 + dir) * 4 + h;
      float f0 = 0.f; const float* n0 = p.state_n;
      if (latent) { f0 = __expf(sc[6 + dir] - Xin); n0 = p.state_n + ((size_t)((lb * DEPTH + layer) * 2 + dir) * 4 + h) * 96; }
#pragma unroll
      for (int it = 0; it < 2; it++) {
        int d = (tid >> 4) + 32 * it;
        if (d < 48) {
          if (need_final) { p.out[O_MN + sidx * 96 + d] = nacc[it][0]; p.out[O_MN + sidx * 96 + d + 48] = nacc[it][1]; }
          else {
            float a0 = nacc[it][0], a1 = nacc[it][1];
            if (latent) { a0 += f0 * n0[d]; a1 += f0 * n0[d + 48]; }
            nin[dir * 96 + d] = a0; nin[dir * 96 + d + 48] = a1;
          }
        }
      }
      if (need_final && tid == 0) p.out[O_MM + sidx] = sc[4 + dir] + sc[2 + dir];
    }
  }
#pragma unroll 1
  for (int orep = 0; orep < REP_OUT; orep++) {
  __syncthreads();
#pragma unroll
  for (int it = 0; it < 2; it++) {
    const int pi = tid + it * 512;
    if (pi < 768) {
      const int r = pi / 6, cc = pi % 6;
      const int pos = P0 + r;
      const bf16_t* pr = p.proj + (size_t)(row0 + pos) * INW + h * 96 + cc * 8;
      uint4 q1 = *(const uint4*)(pr + QOFF), q2 = *(const uint4*)(pr + QOFF + 48);
      uint4 k1 = *(const uint4*)(pr + KOFF), k2 = *(const uint4*)(pr + KOFF + 48);
      float a1[8], a2[8], b1[8], b2[8];
      a1[0] = bflo(q1.x); a1[1] = bfhi(q1.x); a1[2] = bflo(q1.y); a1[3] = bfhi(q1.y); a1[4] = bflo(q1.z); a1[5] = bfhi(q1.z); a1[6] = bflo(q1.w); a1[7] = bfhi(q1.w);
      a2[0] = bflo(q2.x); a2[1] = bfhi(q2.x); a2[2] = bflo(q2.y); a2[3] = bfhi(q2.y); a2[4] = bflo(q2.z); a2[5] = bfhi(q2.z); a2[6] = bflo(q2.w); a2[7] = bfhi(q2.w);
      b1[0] = bflo(k1.x); b1[1] = bfhi(k1.x); b1[2] = bflo(k1.y); b1[3] = bfhi(k1.y); b1[4] = bflo(k1.z); b1[5] = bfhi(k1.z); b1[6] = bflo(k1.w); b1[7] = bfhi(k1.w);
      b2[0] = bflo(k2.x); b2[1] = bfhi(k2.x); b2[2] = bflo(k2.y); b2[3] = bfhi(k2.y); b2[4] = bflo(k2.z); b2[5] = bfhi(k2.z); b2[6] = bflo(k2.w); b2[7] = bfhi(k2.w);
      if (rope) {
        const float* ct = p.rope_cos + pos * 48 + cc * 8; const float* sn = p.rope_sin + pos * 48 + cc * 8;
        const float4 c0 = *(const float4*)ct, c1 = *(const float4*)(ct + 4), s0 = *(const float4*)sn, s1 = *(const float4*)(sn + 4);
        const float cv[8] = {c0.x, c0.y, c0.z, c0.w, c1.x, c1.y, c1.z, c1.w}, sv[8] = {s0.x, s0.y, s0.z, s0.w, s1.x, s1.y, s1.z, s1.w};
#pragma unroll
        for (int q = 0; q < 8; q++) {
          float t1 = a1[q] * cv[q] - a2[q] * sv[q], t2 = a2[q] * cv[q] + a1[q] * sv[q]; a1[q] = t1; a2[q] = t2;
          float u1 = b1[q] * cv[q] - b2[q] * sv[q], u2 = b2[q] * cv[q] + b1[q] * sv[q]; b1[q] = u1; b2[q] = u2;
        }
      }
      uint4 o;
      o.x = pack2(a1[0], a1[1]); o.y = pack2(a1[2], a1[3]); o.z = pack2(a1[4], a1[5]); o.w = pack2(a1[6], a1[7]);
      *(uint4*)(smem + LQ + r * 208 + cc * 16) = o;
      o.x = pack2(a2[0], a2[1]); o.y = pack2(a2[2], a2[3]); o.z = pack2(a2[4], a2[5]); o.w = pack2(a2[6], a2[7]);
      *(uint4*)(smem + LQ + r * 208 + (cc + 6) * 16) = o;
      o.x = pack2(b1[0] * KSCALE, b1[1] * KSCALE); o.y = pack2(b1[2] * KSCALE, b1[3] * KSCALE); o.z = pack2(b1[4] * KSCALE, b1[5] * KSCALE); o.w = pack2(b1[6] * KSCALE, b1[7] * KSCALE);
      *(uint4*)(smem + LK + r * 208 + cc * 16) = o;
      o.x = pack2(b2[0] * KSCALE, b2[1] * KSCALE); o.y = pack2(b2[2] * KSCALE, b2[3] * KSCALE); o.z = pack2(b2[4] * KSCALE, b2[5] * KSCALE); o.w = pack2(b2[6] * KSCALE, b2[7] * KSCALE);
      *(uint4*)(smem + LK + r * 208 + (cc + 6) * 16) = o;
    }
  }
#pragma unroll
  for (int it = 0; it < 3; it++) {
    const int ci = tid + it * 512, e = ci >> 4, cc = ci & 15;
    uint4 v = *(const uint4*)(vtg + (size_t)e * T + P0 + cc * 8);
    *(uint4*)(smem + LVT + e * 256 + ((cc ^ (e & 15)) << 4)) = v;
  }
  __syncthreads();
  {
    const int i0 = wid * 16, il = i0 + lr;
    const int wuo = __builtin_amdgcn_readfirstlane(wid);
    uint2 ggv[6]; float4 ngv[6];
    { const bf16_t* gp_ = p.proj + (size_t)(row0 + P0 + il) * INW + GOFF + h * 96 + 4 * lg; const float* np_ = (ML ? p.ml_norm_g : p.ret_norm_g) + layer * 384 + h * 96 + 4 * lg;
#pragma unroll
      for (int et = 0; et < 6; et++) { ggv[et] = *(const uint2*)(gp_ + et * 16); ngv[et] = *(const float4*)(np_ + et * 16); } }
    bf16x8 qf[3];
#pragma unroll
    for (int ks = 0; ks < 3; ks++) qf[ks] = *(const bf16x8*)(smem + LQ + il * 208 + (ks * 4 + lg) * 16);
    f32x4 pt[8];
    {
      bf16x8 kf[3];
#pragma unroll
      for (int ks = 0; ks < 3; ks++) kf[ks] = *(const bf16x8*)(smem + LK + lr * 208 + (ks * 4 + lg) * 16);
#pragma unroll
      for (int jt = 0; jt < 8; jt++) {
        bf16x8 kn[3];
        if (jt < 7) {
#pragma unroll
          for (int ks = 0; ks < 3; ks++) kn[ks] = *(const bf16x8*)(smem + LK + ((jt + 1) * 16 + lr) * 208 + (ks * 4 + lg) * 16);
        }
        __builtin_amdgcn_sched_barrier(0);
        f32x4 a4 = zero4();
#pragma unroll
        for (int ks = 0; ks < 3; ks++) a4 = __builtin_amdgcn_mfma_f32_16x16x32_bf16(kf[ks], qf[ks], a4, 0, 0, 0);
        pt[jt] = a4;
        __builtin_amdgcn_sched_barrier(0);
        if (jt < 7) {
#pragma unroll
          for (int ks = 0; ks < 3; ks++) kf[ks] = kn[ks];
        }
      }
    }
    constexpr int ND = ML ? 2 : 1;
    f32x4 o[ND][6];
    float den[2] = {0.f, 0.f};
    float xo[2] = {0.f, 0.f};
    if (ML) { xo[0] = Xo[il]; xo[1] = Xo[128 + il]; }
#pragma unroll
    for (int dd = 0; dd < ND; dd++) {
      bf16x8 pop[4];
#pragma unroll
      for (int jt2 = 0; jt2 < 4; jt2++) {
        if (ML && !(dd == 0 ? (jt2 * 2 <= wuo) : (jt2 * 2 + 1 >= wuo))) continue;
        float v[8];
#pragma unroll
        for (int q = 0; q < 8; q++) {
          const int jt = jt2 * 2 + (q >> 2), r = q & 3;
          const int jl = jt * 16 + 4 * lg + r;
          float w;
          if (!ML) {
            const int df = il - jl;
            w = __builtin_amdgcn_exp2f(df > 0 ? (float)df * lgd0 : (float)(-df) * lgd1);
            w = df == 0 ? 2.f : w;
          } else {
            const float e = Eg[dd * 1024 + P0 + jl];
            const bool ok = dd == 0 ? (jl <= il) : (jl >= il);
            w = ok ? __expf(e - xo[dd]) : 0.f;
          }
          v[q] = pt[jt][r] * w;
          den[dd] += v[q];
        }
        union { bf16x8 v8; uint4 u; } cv;
        cv.u.x = pack2(v[0], v[1]); cv.u.y = pack2(v[2], v[3]); cv.u.z = pack2(v[4], v[5]); cv.u.w = pack2(v[6], v[7]);
        pop[jt2] = cv.v8;
        __builtin_amdgcn_sched_barrier(0);
      }
#pragma unroll
      for (int et = 0; et < 6; et++) {
        f32x4 a4 = zero4();
        const int row = et * 16 + lr;
#pragma unroll
        for (int jt2 = 0; jt2 < 4; jt2++) {
          if (ML && !(dd == 0 ? (jt2 * 2 <= wuo) : (jt2 * 2 + 1 >= wuo))) continue;
          const int ch0 = jt2 * 4 + (lg >> 1), ch1 = ch0 + 2;
          union { bf16x8 v8; uint2 h2[2]; } vf;
          vf.h2[0] = *(const uint2*)(smem + LVT + row * 256 + ((ch0 ^ (row & 15)) << 4) + (lg & 1) * 8);
          vf.h2[1] = *(const uint2*)(smem + LVT + row * 256 + ((ch1 ^ (row & 15)) << 4) + (lg & 1) * 8);
          a4 = __builtin_amdgcn_mfma_f32_16x16x32_bf16(vf.v8, pop[jt2], a4, 0, 0, 0);
        }
        o[dd][et] = a4;
        __builtin_amdgcn_sched_barrier(0);
      }
    }
#pragma unroll
    for (int dir = 0; dir < 2; dir++) {
      float scale;
      if (!ML) scale = dir == 0 ? __builtin_amdgcn_exp2f((float)(il + 1) * lgd0) : __builtin_amdgcn_exp2f((float)(128 - il) * lgd1);
      else scale = __expf(sc[0 + dir] - xo[dir]);
      bf16x8 sf[3];
#pragma unroll
      for (int ks = 0; ks < 3; ks++) sf[ks] = *(const bf16x8*)(smem + LST + dir * 19968 + lr * 208 + (ks * 4 + lg) * 16);
#pragma unroll
      for (int et = 0; et < 6; et++) {
        bf16x8 sn[3];
        if (et < 5) {
#pragma unroll
          for (int ks = 0; ks < 3; ks++) sn[ks] = *(const bf16x8*)(smem + LST + dir * 19968 + ((et + 1) * 16 + lr) * 208 + (ks * 4 + lg) * 16);
        }
        __builtin_amdgcn_sched_barrier(0);
        f32x4 a4 = zero4();
#pragma unroll
        for (int ks = 0; ks < 3; ks++) a4 = __builtin_amdgcn_mfma_f32_16x16x32_bf16(sf[ks], qf[ks], a4, 0, 0, 0);
        o[ML ? dir : 0][et] = o[ML ? dir : 0][et] + a4 * scale;
        __builtin_amdgcn_sched_barrier(0);
        if (et < 5) {
#pragma unroll
          for (int ks = 0; ks < 3; ks++) sf[ks] = sn[ks];
        }
      }
      if (ML) {
        float dq = 0.f;
#pragma unroll
        for (int ks = 0; ks < 3; ks++) {
          union { bf16x8 v8; uint4 u; } cv; cv.v8 = qf[ks];
          const float* nn = nin + dir * 96 + ks * 32 + lg * 8;
          dq += bflo(cv.u.x) * nn[0] + bfhi(cv.u.x) * nn[1] + bflo(cv.u.y) * nn[2] + bfhi(cv.u.y) * nn[3] + bflo(cv.u.z) * nn[4] + bfhi(cv.u.z) * nn[5] + bflo(cv.u.w) * nn[6] + bfhi(cv.u.w) * nn[7];
        }
        den[dir] += scale * dq;
      }
    }
    f32x4 of[6];
    if (ML) {
      float nrm[2];
#pragma unroll
      for (int dir = 0; dir < 2; dir++) {
        float dsum = den[dir];
        dsum += __shfl_xor(dsum, 16); dsum += __shfl_xor(dsum, 32);
        const float M = Bo[dir * 128 + il] + xo[dir];
        nrm[dir] = __builtin_amdgcn_rcpf(fmaxf(fabsf(dsum), __expf(-M)));
      }
#pragma unroll
      for (int et = 0; et < 6; et++) of[et] = o[0][et] * nrm[0] + o[ND - 1][et] * nrm[1];
    } else {
#pragma unroll
      for (int et = 0; et < 6; et++) of[et] = o[0][et];
    }
    float ss = 0.f;
#pragma unroll
    for (int et = 0; et < 6; et++) ss += of[et][0] * of[et][0] + of[et][1] * of[et][1] + of[et][2] * of[et][2] + of[et][3] * of[et][3];
    ss += __shfl_xor(ss, 16); ss += __shfl_xor(ss, 32);
    const float rs = rsqrtf(ss * (1.f / 96.f) + EPS);
    const int row = row0 + P0 + il;
    const float* ng = (ML ? p.ml_norm_g : p.ret_norm_g) + layer * 384 + h * 96;
    unsigned mw[6][2];
#pragma unroll
    for (int et = 0; et < 6; et++) {
      const int e0 = et * 16 + 4 * lg;
      const uint2 gg = ggv[et];
      const float4 n4 = ngv[et];
      float g[4] = {bflo(gg.x), bfhi(gg.x), bflo(gg.y), bfhi(gg.y)};
      float r4[4];
      const float nv[4] = {n4.x, n4.y, n4.z, n4.w};
#pragma unroll
      for (int r = 0; r < 4; r++) {
        const float gv = ML ? sigmoidf_(g[r]) : g[r] * sigmoidf_(g[r]);
        r4[r] = of[et][r] * rs * nv[r] * gv;
      }
      mw[et][0] = pack2(r4[0], r4[1]); mw[et][1] = pack2(r4[2], r4[3]);
    }
#pragma unroll
    for (int ep = 0; ep < 3; ep++) {
      const auto q0 = __builtin_amdgcn_permlane16_swap(mw[2 * ep][0], mw[2 * ep + 1][0], false, false);
      const auto q1 = __builtin_amdgcn_permlane16_swap(mw[2 * ep][1], mw[2 * ep + 1][1], false, false);
      *(u32x4*)(p.mixed + (size_t)row * D + MOFF + h * 96 + ep * 32 + (lg & 1) * 16 + (lg >> 1) * 8) = (u32x4){q0[0], q1[0], q0[1], q1[1]};
    }
  }
  }
}

constexpr int HZ = 0, HX = 61440, HF = 94208, HO = 127488;
constexpr int FT_CTX = 2 * 256 * 2 * 512, FT_L = FT_CTX + 2 * 256 * 2 * 2048;
typedef float f32x16 __attribute__((ext_vector_type(16)));

__device__ __forceinline__ void hyena_unit(PR p, int layer, int path, int cg, char* smem) {
  const int tid = TIDX, lane = tid & 63, wid = tid >> 6;
  const int L = path ? 1024 : 256, lgL = path ? 10 : 8, NB = path ? 2 : 4, CH = path ? 4 : 8;
  const int c0 = path ? cg * 4 : (cg >> 2) * 8, ntok = NB * L, lgnt8 = path ? 8 : 7, tok0 = path ? TC : (cg & 3) * 1024;
  const int ZL = 3 * L + ((3 * L) >> 2), ZO = L - 32;
  __syncthreads();
  u32x4 cvv[6]; unsigned hl[6], hr[6]; float cw0[6], cw1[6], cw2[6], cbb[6];
#pragma unroll
  for (int it = 0; it < 6; it++) {
    const int ci = tid + it * NT;
    const int t8 = ci & ((ntok >> 3) - 1), rest = ci >> lgnt8, arr = rest % 3, ch = rest / 3;
    const int tk = t8 * 8, tl = tk & (L - 1);
    const int col = arr * 256 + c0 + ch;
    const bf16_t* src = p.hyt + (size_t)col * T + tok0 + tk;
    cvv[it] = __builtin_nontemporal_load((const u32x4*)src);
    hl[it] = *(const unsigned short*)(src + (tl > 0 ? -1 : 0)); hr[it] = *(const unsigned short*)(src + (tl + 8 < L ? 8 : 7));
    cw0[it] = p.hy_conv_w[(layer * 3 + 0) * 768 + col]; cw1[it] = p.hy_conv_w[(layer * 3 + 1) * 768 + col]; cw2[it] = p.hy_conv_w[(layer * 3 + 2) * 768 + col]; cbb[it] = p.hy_conv_b[layer * 768 + col];
  }
  u32x4 fv[4];
#define HY_FLOAD(order_) { const int nch_ = CH * 2 * (L >> 2); \
    _Pragma("unroll") for (int j = 0; j < 4; j++) { const int ci = tid + j * NT; fv[j] = (u32x4){0u, 0u, 0u, 0u}; \
      if (ci < nch_) { const int u8 = ci & ((L >> 2) - 1), rest = ci >> (lgL - 2), cp = rest & 1, fc = rest >> 1; \
        fv[j] = __builtin_nontemporal_load((const u32x4*)(p.ft + (size_t)layer * FT_L + (path ? FT_CTX : 0) + ((size_t)(((order_) * 256 + c0 + fc) * 2 + cp) * 2 * L) + u8 * 8)); } } }
  HY_FLOAD(0);
  { unsigned zz_ = 0u; asm volatile("" : "+v"(zz_)); const uint4 z4_ = make_uint4(zz_, zz_, zz_, zz_);
    for (int i = tid; i < 61440 / 16; i += NT) ((uint4*)(smem + HZ))[i] = z4_; }
  __syncthreads();
#pragma unroll
  for (int it = 0; it < 6; it++) {
    const int ci = tid + it * NT;
    const int t8 = ci & ((ntok >> 3) - 1), rest = ci >> lgnt8, arr = rest % 3, ch = rest / 3;
    const int tk = t8 * 8, tl = tk & (L - 1), b = tk >> lgL;
    const u32x4 v = cvv[it];
    float x[10];
    x[0] = tl > 0 ? __uint_as_float(hl[it] << 16) : 0.f; x[9] = tl + 8 < L ? __uint_as_float(hr[it] << 16) : 0.f;
    x[1] = bflo(v.x); x[2] = bfhi(v.x); x[3] = bflo(v.y); x[4] = bfhi(v.y); x[5] = bflo(v.z); x[6] = bfhi(v.z); x[7] = bflo(v.w); x[8] = bfhi(v.w);
    float y[8];
#pragma unroll
    for (int q = 0; q < 8; q++) y[q] = cw0[it] * x[q] + cw1[it] * x[q + 1] + cw2[it] * x[q + 2] + cbb[it];
    uint4 o; o.x = pack2(y[0], y[1]); o.y = pack2(y[2], y[3]); o.z = pack2(y[4], y[5]); o.w = pack2(y[6], y[7]);
    if (arr == 0) { const int idx = ZO + tl, phys = idx + 8 * (idx >> 5); *(uint4*)(smem + HZ + ((ch * NB + b) * ZL + phys) * 2) = o; }
    else *(uint4*)(smem + HX + ((ch * 2 + arr - 1) * ntok + tk) * 2) = o;
  }
  const int cl = lane & 31, hh = lane >> 5;
  int ch, b, I;
  if (path) { ch = wid >> 1; b = wid & 1; I = cl; } else { ch = wid; b = cl >> 3; I = cl & 7; }
  char* zb = smem + HZ + ((ch * NB + b) * ZL) * 2;
  const float bias0 = p.hy_bias[(layer * 2 + 0) * 256 + c0 + ch], bias1 = p.hy_bias[(layer * 2 + 1) * 256 + c0 + ch];
  const char* fbase = smem + HF + ((ch * 2 + (cl & 1)) * (2 * L + 32)) * 2;
#pragma unroll 1
  for (int order = 0; order < 2; order++) {
    {
      const int nch = CH * 2 * (L >> 2);
#pragma unroll
      for (int j = 0; j < 4; j++) {
        const int ci = tid + j * NT;
        if (ci < nch) {
          const int u8 = ci & ((L >> 2) - 1), rest = ci >> (lgL - 2), cp = rest & 1, fc = rest >> 1;
          *(u32x4*)(smem + HF + ((fc * 2 + cp) * (2 * L + 32) + u8 * 8) * 2) = fv[j];
        }
      }
    }
    __syncthreads();
    if (order == 0) HY_FLOAD(1);
    f32x16 acc;
#pragma unroll
    for (int r = 0; r < 16; r++) acc[r] = 0.f;
#pragma unroll 2
    for (int dl = -L + 16; dl <= L - 32; dl += 16) {
      const int u0 = L - dl - cl + 8 * hh - (cl & 1);
      const unsigned* fp = (const unsigned*)(fbase + u0 * 2);
      union { bf16x8 v8; unsigned u[4]; } af;
      af.u[0] = fp[0]; af.u[1] = fp[1]; af.u[2] = fp[2]; af.u[3] = fp[3];
      const int idx = ZO + 32 * I - dl + 8 * hh, phys = idx + 8 * (idx >> 5);
      const bf16x8 bfr = *(const bf16x8*)(zb + phys * 2);
      acc = __builtin_amdgcn_mfma_f32_32x32x16_bf16(af.v8, bfr, acc, 0, 0, 0);
    }
    __syncthreads();
    const float bias = order == 0 ? bias0 : bias1;
#pragma unroll
    for (int g = 0; g < 4; g++) {
      const int t = 32 * I + 8 * g + 4 * hh;
      const int idx = ZO + t, phys = idx + 8 * (idx >> 5);
      const uint2 z4 = *(const uint2*)(zb + phys * 2);
      const uint2 h4 = *(const uint2*)(smem + HX + ((ch * 2 + order) * ntok + b * L + t) * 2);
      const float zz[4] = {bflo(z4.x), bfhi(z4.x), bflo(z4.y), bfhi(z4.y)};
      const float hx[4] = {bflo(h4.x), bfhi(h4.x), bflo(h4.y), bfhi(h4.y)};
      float r4[4];
#pragma unroll
      for (int r = 0; r < 4; r++) r4[r] = hx[r] * (acc[4 * g + r] + bias * zz[r]);
      if (order == 0) { uint2 o; o.x = pack2(r4[0], r4[1]); o.y = pack2(r4[2], r4[3]); *(uint2*)(zb + phys * 2) = o; }
      else {
#pragma unroll
        for (int r = 0; r < 4; r++) *(bf16_t*)(smem + HO + ((b * L + t + r) * CH + ch) * 2) = f2bf(r4[r]);
      }
    }
    __syncthreads();
  }
#undef HY_FLOAD
  for (int tk = tid; tk < ntok; tk += NT) {
    bf16_t* dst = p.mixed + (size_t)(tok0 + tk) * D + 384 + c0;
    if (path) *(uint2*)dst = *(const uint2*)(smem + HO + tk * 8);
    else *(uint4*)dst = *(const uint4*)(smem + HO + tk * 16);
  }
}

#define XB_TMO      128
#define XB_XCNT(j)  (256  + 64 * (j))
#define XB_XSUB(j)  (1280 + 64 * (j))
#define XB_XGEN(j)  (2304 + 64 * (j))
#define XB_TOP      3328
#define XB_TOPGEN   3392
#define XCD_BAR_WORDS 3456
#define XB_SPIN_CAP (1u << 22)
__device__ __forceinline__ unsigned xb_ld(unsigned* p)              { return __hip_atomic_load(p, __ATOMIC_RELAXED, __HIP_MEMORY_SCOPE_AGENT); }
__device__ __forceinline__ unsigned xb_add(unsigned* p, unsigned v) { return __hip_atomic_fetch_add(p, v, __ATOMIC_RELAXED, __HIP_MEMORY_SCOPE_AGENT); }
__device__ __forceinline__ unsigned xb_xcc_id() { return (unsigned)__builtin_amdgcn_s_getreg((3 << 11) | 20) & 0xFu; }
#define XB_SPIN(cond, bar) do { unsigned _sp = 0; while (cond) { __builtin_amdgcn_s_sleep(1); \
    if ((++_sp & 255u) == 0u) { if (xb_ld(&(bar)[XB_TMO])) break; if (_sp > XB_SPIN_CAP) { atomicAdd(&(bar)[XB_TMO], 1u); break; } } } } while (0)
struct XcdBarrier { unsigned* bar; unsigned x; volatile LAS unsigned* st; };
__device__ __forceinline__ XcdBarrier xcd_barrier_post(unsigned* bar, volatile LAS unsigned* st) {
    XcdBarrier b; b.bar = bar; b.x = xb_xcc_id(); b.st = st;
    if (threadIdx.x == 0) (void)xb_add(&bar[XB_XCNT(b.x)], 1u);
    return b;
}
__device__ __forceinline__ void xcd_barrier_complete(unsigned* bar, unsigned x, unsigned& nloc, unsigned& nx) {
    const unsigned G = gridDim.x * gridDim.y * gridDim.z;
    unsigned sum, cnt, mine, sp = 0u;
    for (;;) {
        sum = 0u; cnt = 0u; mine = 0u;
#pragma unroll
        for (unsigned j = 0; j < 16; ++j) { const unsigned c = xb_ld(&bar[XB_XCNT(j)]); sum += c; cnt += (c > 0u) ? 1u : 0u; mine = (j == x) ? c : mine; }
        if (sum == G) break;
        __builtin_amdgcn_s_sleep(1);
        if ((++sp & 255u) == 0u) { if (xb_ld(&bar[XB_TMO])) break; if (sp > XB_SPIN_CAP) { atomicAdd(&bar[XB_TMO], 1u); break; } }
    }
    nloc = mine > 0u ? mine : 1u; nx = cnt > 0u ? cnt : 1u;
}
__device__ __forceinline__ void xcd_barrier(const XcdBarrier& b) {
    asm volatile("s_waitcnt vmcnt(0)" ::: "memory");
    __syncthreads();
    if (TIDX == 0) {
        unsigned* bar = b.bar;
        __builtin_amdgcn_s_waitcnt(0);
        unsigned nloc = b.st[0], nx = b.st[1];
        if (nloc == 0u) { xcd_barrier_complete(bar, b.x, nloc, nx); b.st[0] = nloc; b.st[1] = nx; }
        const unsigned old = xb_add(&bar[XB_XSUB(b.x)], 1u);
        const unsigned gen = old / nloc;
        if (old + 1u == (gen + 1u) * nloc) {
            __builtin_amdgcn_fence(__ATOMIC_RELEASE, "agent");
            asm volatile("s_waitcnt vmcnt(0)" ::: "memory");
            const unsigned og = xb_add(&bar[XB_TOP], 1u);
            const unsigned tg = og / nx;
            if (og + 1u == (tg + 1u) * nx) xb_add(&bar[XB_TOPGEN], 1u);
            else XB_SPIN(xb_ld(&bar[XB_TOPGEN]) == tg, bar);
            __builtin_amdgcn_fence(__ATOMIC_ACQUIRE, "agent");
            xb_add(&bar[XB_XGEN(b.x)], 1u);
            asm volatile("s_waitcnt vmcnt(0)" ::: "memory");
        } else {
            XB_SPIN(xb_ld(&bar[XB_XGEN(b.x)]) == gen, bar);
            __builtin_amdgcn_fence(__ATOMIC_ACQUIRE, "agent");
            asm volatile("s_waitcnt vmcnt(0)" ::: "memory");
        }
    }
    __syncthreads();
}


constexpr int MIXALL_UNITS = 576;
__device__ __forceinline__ void phase_mix_all(PR p, int layer, int rep, int bid, int nb, char* smem) {
  volatile LAS unsigned* bc = (volatile LAS unsigned*)(smem + SMEM_BYTES - 32);
  unsigned* ctr = p.bar + XCD_BAR_WORDS + layer + 8 * rep;
  for (int first = 1;; first = 0) {
    int u = bid;
    if (!first) {
      __syncthreads();
      if (TIDX == 0) *bc = atomicAdd(ctr, 1u) + (unsigned)nb;
      __syncthreads();
      u = (int)*bc;
    }
    if (u >= MIXALL_UNITS) break;
    int kind, a0 = 0, a1 = 0, a2 = 0;
    if (u < 128) { int v = u & 63; a0 = 16 + (v >> 5); a1 = (v >> 2) & 7; a2 = v & 3; kind = u < 64 ? 0 : 1; }
    else if (u < 192) { kind = 2; a0 = 1; a1 = u - 128; }
    else if (u < 320) { int v = (u - 192) & 127; a0 = v >> 3; a1 = (v >> 2) & 1; a2 = v & 3; kind = 0; }
    else if (u < 448) { kind = 2; a0 = 0; a1 = u - 320; }
    else { int v = (u - 448) & 127; a0 = v >> 3; a1 = (v >> 2) & 1; a2 = v & 3; kind = 1; }
    for (int rr = 0; rr < ((kind == PROBE_KIND) ? 2 : 1); rr++) {
    if (kind == 0) mix_unit<true>(p, layer, a0, a1, a2, smem);
    else if (kind == 1) mix_unit<false>(p, layer, a0, a1, a2, smem);
    else hyena_unit(p, layer, a0, a1, smem);
    }
  }
}


__device__ __forceinline__ void phase_prologue(PR p, char* smem) {
  volatile LAS unsigned* bc = (volatile LAS unsigned*)(smem + SMEM_BYTES - 32);
  unsigned* ctr = p.bar + XCD_BAR_WORDS + 40;
  constexpr int NF = DEPTH * 80, NM = DEPTH * 48, NR = 8, NTR = DEPTH * TR_L, NU = NF + NM + NR + NTR, FSTEP = 10;
  static_assert((NF - 1) * FSTEP < NU, "filter slots");
  for (int first = 1;; first = 0) {
    int u = (int)blockIdx.x;
    if (!first) {
      __syncthreads();
      if (TIDX == 0) *bc = atomicAdd(ctr, 1u) + gridDim.x;
      __syncthreads();
      u = (int)*bc;
    }
    if (u >= NU) break;
    const int fs = u / FSTEP;
    if (u - fs * FSTEP == 0 && fs < NF) { phase_filt(p, fs, 1 << 30, smem); continue; }
    const int v = u - (fs + 1 < NF ? fs + 1 : NF);
    if (v < NM) phase_mod(p, v, 1 << 30, smem);
    else if (v < NM + NR) phase_rope(p, v - NM, NR);
    else phase_transpose(p, v - NM - NR, 1 << 30, smem);
  }
}

enum { PH_TRANSPOSE = 0, PH_MOD, PH_ROPE, PH_FILT, PH_S0, PH_INPROJ, PH_RET, PH_ML, PH_RETST, PH_MLST, PH_HY1, PH_HY2A, PH_HY2B, PH_OUTPROJ, PH_S1, PH_UP, PH_ACT, PH_DOWN, PH_MIXF, PH_MIXALL, PH_OUTPROJ_F, PH_DOWN_F };

template <int ph>
__device__ __forceinline__ void run_phase(PR p, int layer, int bid, int nb, char* smem) {
  switch (ph) {
    case PH_TRANSPOSE: phase_transpose(p, bid, nb, smem); break;
    case PH_MOD: phase_mod(p, bid, nb, smem); break;
    case PH_ROPE: phase_rope(p, bid, nb); break;
    case PH_FILT: phase_filt(p, bid, nb, smem); break;
    case PH_S0: phase_rowpass(p, layer, 0, bid, nb); break;
    case PH_S1: phase_rowpass(p, layer, 1, bid, nb); break;
    case PH_INPROJ: {
      unsigned* flg = p.bar + XCD_BAR_WORDS + 64;
      EpiProj e{p.proj, p.ktr, p.vtr, p.ktm, p.vtm, p.hyt, p.gates, SEAMS && layer > 0 ? flg : (unsigned*)nullptr, (unsigned)(2 * layer), flg + 8 * 32 * 16, SEAMS && layer == 0 ? p.bar + S0F_OFF : (const unsigned*)nullptr};
      phase_gemm<192, 256, USE_GLDS, EpiProj>(p.hbuf, p.wt_in + (size_t)layer * INWP * D, T, INWP, D, bid, nb, smem, e);
    } break;
    case PH_MIXALL: phase_mix_all(p, layer & 7, layer >> 3, bid, nb, smem); break;
    case PH_OUTPROJ: {
      EpiF32 e{p.raw, D};
      phase_gemm<192, 128, USE_GLDS, EpiF32>(p.mixed, p.wt_out + (size_t)layer * D * D, T, D, D, bid, nb, smem, e);
    } break;
    case PH_OUTPROJ_F: {
      const int slotid = layer * 2;
      EpiRow e{(const bf16_t*)p.xbuf, (void*)p.x1buf, false, p.hbuf, p.mod + (size_t)layer * 3 * 6144, 2 * 1024, p.norm_mix_post + layer * D,
               p.mod + (size_t)layer * 3 * 6144, 3 * 1024, p.norm_ffn_pre + layer * D,
               SEAMS ? p.bar + XCD_BAR_WORDS + 64 : (unsigned*)nullptr, (const unsigned*)nullptr, 0u, p.rstats, (unsigned)(slotid + 1), p.bar + XCD_BAR_WORDS + 64 + 8 * 32 * 16};
      phase_gemm<192, 128, 2, EpiRow>(p.mixed, p.wt_out + (size_t)layer * D * D, T, D, D, bid, nb, smem, e);
    } break;
    case PH_DOWN_F: {
      const int slotid = layer * 2 + 1;
      const bool last = layer + 1 >= DEPTH;
      const int ln = last ? layer : layer + 1;
      EpiRow e{(const bf16_t*)p.x1buf, last ? (void*)p.out : (void*)p.xbuf, last, last ? (bf16_t*)nullptr : p.hbuf, p.mod + (size_t)layer * 3 * 6144, 5 * 1024, p.norm_ffn_post + layer * D,
               p.mod + (size_t)ln * 3 * 6144, 0, p.norm_mix_pre + ln * D,
               SEAMS && !last ? p.bar + XCD_BAR_WORDS + 64 : (unsigned*)nullptr, SEAMS ? p.bar + XCD_BAR_WORDS + 64 + 8 * 32 * 16 + 16 : (const unsigned*)nullptr, (unsigned)(layer + 1),
               p.rstats, (unsigned)(slotid + 1), p.bar + XCD_BAR_WORDS + 64 + 8 * 32 * 16};
      phase_gemm<192, 128, 2, EpiRow>(p.ubuf, p.wt_down + (size_t)layer * D * DFF, T, D, DFF, bid, nb, smem, e);
    } break;
    case PH_UP: {
      unsigned* flg = p.bar + XCD_BAR_WORDS + 64;
      EpiUp e{SEAMS ? flg : (unsigned*)nullptr, (unsigned)(2 * layer + 1), flg + 8 * 32 * 16, SEAMS ? flg + 8 * 32 * 16 + 16 : (unsigned*)nullptr, (unsigned)(layer + 1), p.ubuf, p.hbuf, p.wt_up + (size_t)layer * 2 * DFF * D, p.ffn_conv_w + (size_t)layer * 3 * DFF, p.ffn_conv_b + (size_t)layer * DFF};
#if UP8
      gemm_up8(p.hbuf, p.wt_up + (size_t)layer * 2 * DFF * D, bid, nb, smem, e);
#else
      phase_gemm<256, 256, USE_GLDS, EpiUp>(p.hbuf, p.wt_up + (size_t)layer * 2 * DFF * D, T, 2 * DFF, D, bid, nb, smem, e);
#endif
    } break;
    case PH_DOWN: {
      EpiF32 e{p.raw, D};
      phase_gemm<192, 128, USE_GLDS, EpiF32>(p.ubuf, p.wt_down + (size_t)layer * D * DFF, T, D, DFF, bid, nb, smem, e);
    } break;
  }
}

#ifndef MULTI_LAUNCH
#define MULTI_LAUNCH 0
#endif
__global__ void __launch_bounds__(NT) k_mega(Params p_) {
  extern __shared__ __attribute__((aligned(16))) char smem[];
  const int bid = blockIdx.x, nb = gridDim.x;
  volatile LAS unsigned* st = (volatile LAS unsigned*)(smem + SMEM_BYTES - 16);
  if (TIDX == 0) { st[0] = 0u; st[1] = 0u; st[2] = 0u; st[3] = 0u; }
  __syncthreads();
  (void)xcd_barrier_post(get_params()->bar, st);
#define BAR() { XcdBarrier xb_; xb_.bar = get_params()->bar; xb_.x = xb_xcc_id(); xb_.st = st; xcd_barrier(xb_); }
  phase_prologue(*get_params(), smem);
  BAR();
  run_phase<PH_S0>(*get_params(), 0, bid, nb, smem);
  if (!SEAMS) BAR();
  for (int l = 0; l < DEPTH; l++) {
    for (int rep = 0; rep < REP_G1; rep++) { run_phase<PH_INPROJ>(*get_params(), l, bid, nb, smem); BAR(); }
    for (int rep = 0; rep < REP_MIX; rep++) { run_phase<PH_MIXALL>(*get_params(), l + 8 * rep, bid, nb, smem); BAR(); }
    for (int rep = 0; rep < REP_BAR; rep++) BAR();
    for (int rep = 0; rep < REP_G2; rep++) { run_phase<PH_OUTPROJ_F>(*get_params(), l, bid, nb, smem); if (!SEAMS || rep + 1 < REP_G2) BAR(); }
    for (int rep = 0; rep < REP_G3; rep++) { run_phase<PH_UP>(*get_params(), l, bid, nb, smem); if (!SEAMS || rep + 1 < REP_G3) BAR(); }
    for (int rep = 0; rep < REP_G4; rep++) { run_phase<PH_DOWN_F>(*get_params(), l, bid, nb, smem); if (rep + 1 < REP_G4) BAR(); }
    if (!SEAMS && l + 1 < DEPTH) BAR();
  }
}

static inline size_t align_up(size_t x) { return (x + 255) & ~(size_t)255; }

extern "C" void kernel_launch(void* const* d_in, const int* in_sizes, int n_in, void* d_out, int out_size, void* d_ws, size_t ws_size, hipStream_t stream) {
  Params p{};
  const float* const* in = (const float* const*)d_in;
  p.x_prompt = in[0]; p.x_sample = in[1]; p.c = in[2]; p.state_ret = in[3]; p.state_c = in[4]; p.state_n = in[5]; p.state_m = in[6]; p.c_ctx = in[7];
  p.norm_mix_pre = in[8]; p.norm_mix_post = in[9]; p.norm_ffn_pre = in[10]; p.norm_ffn_post = in[11]; p.w_mod = in[12]; p.b_mod = in[13]; p.w_in = in[14]; p.w_out = in[15];
  p.ret_decay_logit = in[16]; p.ret_norm_g = in[17]; p.hy_conv_w = in[18]; p.hy_conv_b = in[19]; p.hy_f_w1 = in[20]; p.hy_f_b1 = in[21]; p.hy_f_w2 = in[22]; p.hy_f_b2 = in[23];
  p.hy_f_w3 = in[24]; p.hy_f_b3 = in[25]; p.hy_sin_freq = in[26]; p.hy_bias = in[27]; p.ml_gate_bias = in[28]; p.ml_norm_g = in[29];
  p.w_up = in[30]; p.ffn_conv_w = in[31]; p.ffn_conv_b = in[32]; p.w_down = in[33];
  p.out = (float*)d_out;
  char* w = (char*)d_ws; size_t off = 0;
  auto take = [&](size_t bytes) { char* r = w + off; off = align_up(off + bytes); return r; };
  p.wt_in = (bf16_t*)take((size_t)DEPTH * INWP * D * 2);
  p.wt_out = (bf16_t*)take((size_t)DEPTH * D * D * 2);
  p.wt_up = (bf16_t*)take((size_t)DEPTH * 2 * DFF * D * 2);
  p.wt_down = (bf16_t*)take((size_t)DEPTH * D * DFF * 2);
  p.mod = (float*)take((size_t)DEPTH * 3 * 6144 * 4);
  p.rope_cos = (float*)take(1024 * 48 * 4); p.rope_sin = (float*)take(1024 * 48 * 4);
  p.rope_cosT = (float*)take(1024 * 48 * 4); p.rope_sinT = (float*)take(1024 * 48 * 4);
  p.xbuf = (float*)take((size_t)T * D * 4); p.x1buf = (float*)take((size_t)T * D * 4); p.raw = (float*)take((size_t)T * D * 4);
  p.hbuf = (bf16_t*)take((size_t)T * D * 2);
  p.ubuf = (bf16_t*)take((size_t)T * DFF * 2);
  p.proj = (bf16_t*)take((size_t)T * INW * 2);
  p.ktr = (bf16_t*)take((size_t)384 * T * 2); p.vtr = (bf16_t*)take((size_t)384 * T * 2);
  p.ktm = (bf16_t*)take((size_t)384 * T * 2); p.vtm = (bf16_t*)take((size_t)384 * T * 2);
  p.hyt = (bf16_t*)take((size_t)768 * T * 2);
  p.mixed = (bf16_t*)take((size_t)T * D * 2);
  p.gates = (float*)take((size_t)T * 16 * 4);
  p.ft = (bf16_t*)take((size_t)DEPTH * (2 * 256 * 2 * 512 + 2 * 256 * 2 * 2048) * 2);
  p.bar = (unsigned*)take((XCD_BAR_WORDS + 64 + 8 * 32 * 16 + 16 + 1024) * 4);
  p.rstats = (unsigned long long*)take((size_t)8 * 32 * 192 * 8 * 2 * 8);
  if (off > ws_size) { fprintf(stderr, "workspace too small: need %zu have %zu\n", off, ws_size); return; }

  {
    static int grid = 0;
    if (grid == 0) {
      int dev = 0, cus = 0;
      if (hipGetDevice(&dev) != hipSuccess || hipDeviceGetAttribute(&cus, hipDeviceAttributeMultiprocessorCount, dev) != hipSuccess || cus <= 0) { fprintf(stderr, "device query failed\n"); grid = -1; return; }
      if (hipFuncSetAttribute((const void*)k_mega, hipFuncAttributeMaxDynamicSharedMemorySize, SMEM_BYTES) != hipSuccess) { fprintf(stderr, "hipFuncSetAttribute failed\n"); grid = -1; return; }
      grid = cus;
    }
    if (grid < 0) return;
    if (hipMemsetAsync(p.bar, 0, (XCD_BAR_WORDS + 64 + 8 * 32 * 16 + 16 + 1024) * 4, stream) != hipSuccess) { fprintf(stderr, "memset failed\n"); return; }
    p.fuse_rows = 1; p.pad_ = 0;
    if (grid < 256) { fprintf(stderr, "this kernel needs >= 256 CUs (one resident workgroup per column tile of the fused residual epilogues)\n"); return; }
    hipLaunchKernelGGL(k_mega, dim3(grid), dim3(NT), SMEM_BYTES, stream, p);
  }
}
```
